# Optimizing an MI355X kernel written in HIP

```python
import math
import jax, jax.numpy as jnp
from jax import lax
import numpy as np


D_MODEL = 1024
BATCH = 16
SEQ = 2048
DEPTH = 4

CTX_LEN = 256
GRID_W = 64
W_BRANCH = 512
N_BRANCH = 3
N_HEADS = 8
N_KV_HEADS = 2
GROUP = N_HEADS // N_KV_HEADS
HEAD_DIM = 64
ROPE_FREQS = HEAD_DIM // 4
ROPE_BASE = 10000.0
Q_BLOCK = 128
ATTN_SCALE = HEAD_DIM ** -0.5
HYENA_ORDER = 2
FILTER_EMB = 33
FILTER_BANDS = (FILTER_EMB - 1) // 2
FILTER_HIDDEN = 64
HYENA_TARGET = 1e-2
FAST_DECAY_PCT = 0.3
SLOW_DECAY_PCT = 1.5
MIN_DECAY = math.log(HYENA_TARGET) / SLOW_DECAY_PCT
MAX_DECAY = math.log(HYENA_TARGET) / FAST_DECAY_PCT
EPS = 1e-6

A_COLS = 4 * W_BRANCH
H_COLS = 4 * W_BRANCH
Q_COLS = N_HEADS * HEAD_DIM
KV_COLS = N_KV_HEADS * HEAD_DIM
H_OFF = A_COLS
C_OFF = H_OFF + H_COLS
K_OFF = C_OFF + Q_COLS
V_OFF = K_OFF + KV_COLS
Z_OFF = V_OFF + KV_COLS
G_OFF = Z_OFF + W_BRANCH
IN_COLS = G_OFF + N_BRANCH * D_MODEL

kernel_name = 'hybrid_conv_hyena_gqa_dit_block'


def _rms_norm(x, g):
    xf = x.astype(jnp.float32)
    y = xf * lax.rsqrt(jnp.mean(xf * xf, axis=-1, keepdims=True) + EPS)
    return (y * g.astype(jnp.float32)).astype(x.dtype)


def _short_conv(u, w):
    up = jnp.pad(u, ((0, 0), (1, 1), (0, 0)))
    return up[:, :-2] * w[0] + up[:, 1:-1] * w[1] + up[:, 2:] * w[2]


def _rope_tables(L):
    rows = L // GRID_W
    row = jnp.repeat(jnp.arange(rows, dtype=jnp.float32), GRID_W)
    col = jnp.tile(jnp.arange(GRID_W, dtype=jnp.float32), rows)
    inv = ROPE_BASE ** (-jnp.arange(ROPE_FREQS, dtype=jnp.float32) / ROPE_FREQS)
    ang = jnp.stack([row[:, None] * inv, col[:, None] * inv], axis=1)
    return jnp.cos(ang)[:, None], jnp.sin(ang)[:, None]


def _apply_rope(x, cos, sin):
    B_, L, H, _ = x.shape
    xf = x.astype(jnp.float32).reshape(B_, L, H, 2, 2, ROPE_FREQS)
    x1, x2 = xf[..., 0, :], xf[..., 1, :]
    out = jnp.stack([x1 * cos - x2 * sin, x2 * cos + x1 * sin], axis=-2)
    return out.reshape(x.shape).astype(x.dtype)


def _hyena_kernels_f(L, w1, b1, w2, b2, w3, b3, freq):
    f32 = jnp.float32
    t = jnp.linspace(0.0, 1.0, L, dtype=f32)[:, None]
    bands = jnp.linspace(1e-4, FILTER_BANDS - 1, FILTER_BANDS, dtype=f32)
    w = (2.0 * math.pi / L) * jnp.arange(L, dtype=f32)[:, None]
    feats = jnp.concatenate([t, jnp.cos(w * bands), jnp.sin(w * bands)], axis=-1)
    h = jnp.sin(freq[0].astype(f32) * (feats @ w1.astype(f32) + b1.astype(f32)))
    h = jnp.sin(freq[1].astype(f32) * (h @ w2.astype(f32) + b2.astype(f32)))
    h = (h @ w3.astype(f32) + b3.astype(f32)).reshape(L, HYENA_ORDER, 2, W_BRANCH)
    deltas = jnp.abs(jnp.linspace(MIN_DECAY, MAX_DECAY, W_BRANCH, dtype=f32))
    h = h * jnp.exp(-t[:, :, None, None] * deltas)
    kern = jnp.concatenate([h[:, :, 0], jnp.zeros((1, HYENA_ORDER, W_BRANCH), f32),
                            h[:0:-1, :, 1]], axis=0)
    kern = kern / jnp.sum(jnp.abs(kern), axis=0, keepdims=True)
    return jnp.fft.rfft(kern, axis=0)


def _long_conv(u, kf, bias):
    L = u.shape[1]
    uf = u.astype(jnp.float32)
    U = jnp.fft.rfft(uf, n=2 * L, axis=1)
    y = jnp.fft.irfft(U * kf, n=2 * L, axis=1)[:, :L]
    return (y + uf * bias.astype(jnp.float32)).astype(u.dtype)


def _q_heads(p, q_g):
    B_, L, _ = p.shape
    return _rms_norm(p[..., C_OFF:K_OFF].reshape(B_, L, N_HEADS, HEAD_DIM), q_g)


def _kv_heads(pkv, k_g):
    B_, L, _ = pkv.shape
    k = _rms_norm(pkv[..., :KV_COLS].reshape(B_, L, N_KV_HEADS, HEAD_DIM), k_g)
    v = pkv[..., KV_COLS:].reshape(B_, L, N_KV_HEADS, HEAD_DIM)
    return k, v


def _gqa(q, keys, vals):
    B_, Q, _, _ = q.shape
    qg = q.reshape(B_, Q, N_KV_HEADS, GROUP, HEAD_DIM)
    s = jnp.einsum('bqkgd,bskd->bkgqs', qg, keys).astype(jnp.float32) * ATTN_SCALE
    p = jax.nn.softmax(s, axis=-1).astype(vals.dtype)
    o = jnp.einsum('bkgqs,bskd->bqkgd', p, vals)
    return o.reshape(B_, Q, N_HEADS * HEAD_DIM)


def _latent_attention(q, k, v, k_c, v_c):
    B_, S, H, Dh = q.shape
    keys = jnp.concatenate([k_c, k], axis=1)
    vals = jnp.concatenate([v_c, v], axis=1)
    qb = q.reshape(B_, S // Q_BLOCK, Q_BLOCK, H, Dh).swapaxes(0, 1)
    o = lax.map(lambda qblk: _gqa(qblk, keys, vals), qb)
    return o.swapaxes(0, 1).reshape(B_, S, H * Dh)


def _mixer(p, attn_out, conv_a, conv_h, kern_f, hyena_bias, w_branch, w_out):
    B_, L, _ = p.shape
    xa, ba, ca, za = jnp.split(p[..., :A_COLS], 4, axis=-1)
    y_a = ba * _short_conv(ca * xa, conv_a) * jax.nn.silu(za)
    v, x1, x2 = jnp.split(_short_conv(p[..., H_OFF:H_OFF + 3 * W_BRANCH], conv_h), 3, axis=-1)
    z = x1 * _long_conv(v, kern_f[:, 0], hyena_bias[0])
    z = x2 * _long_conv(z, kern_f[:, 1], hyena_bias[1])
    y_b = z * jax.nn.silu(p[..., H_OFF + 3 * W_BRANCH:C_OFF])
    y_c = attn_out * jax.nn.silu(p[..., Z_OFF:G_OFF])
    gates = jax.nn.sigmoid(p[..., G_OFF:].astype(jnp.float32)).reshape(B_, L, N_BRANCH, D_MODEL)
    proj = jnp.einsum('blnw,nwd->blnd', jnp.stack([y_a, y_b, y_c], axis=2), w_branch)
    merged = jnp.sum(gates * proj.astype(jnp.float32), axis=2).astype(p.dtype)
    return merged @ w_out


def setup_inputs(seed: int = 0) -> dict:
    key = jax.random.key(seed)
    ks = jax.random.split(key, 22)
    f32 = jnp.float32
    nrm = lambda k, shape, s: jax.random.normal(k, shape, f32) * s
    return {
        'x': nrm(ks[0], (BATCH, SEQ, D_MODEL), 1.0),
        'c': nrm(ks[1], (BATCH, D_MODEL), 1.0),
        'ctx': nrm(ks[2], (BATCH, CTX_LEN, D_MODEL), 1.0),
        'c_ctx': nrm(ks[3], (D_MODEL,), 1.0),
        'norm_g': 1.0 + nrm(ks[4], (DEPTH, D_MODEL), 0.02),
        'w_mod': nrm(ks[5], (DEPTH, D_MODEL, 3 * D_MODEL), 0.5 * D_MODEL ** -0.5),
        'b_mod': nrm(ks[6], (DEPTH, 3 * D_MODEL), 0.02),
        'w_in': nrm(ks[7], (DEPTH, D_MODEL, IN_COLS), D_MODEL ** -0.5),
        'conv_a': nrm(ks[8], (DEPTH, 3, W_BRANCH), 3 ** -0.5),
        'conv_h': nrm(ks[9], (DEPTH, 3, 3 * W_BRANCH), 3 ** -0.5),
        'filt_w1': nrm(ks[10], (DEPTH, FILTER_EMB, FILTER_HIDDEN), FILTER_EMB ** -0.5),
        'filt_b1': nrm(ks[11], (DEPTH, FILTER_HIDDEN), 0.02),
        'filt_w2': nrm(ks[12], (DEPTH, FILTER_HIDDEN, FILTER_HIDDEN), FILTER_HIDDEN ** -0.5),
        'filt_b2': nrm(ks[13], (DEPTH, FILTER_HIDDEN), 0.02),
        'filt_w3': nrm(ks[14], (DEPTH, FILTER_HIDDEN, HYENA_ORDER * 2 * W_BRANCH), FILTER_HIDDEN ** -0.5),
        'filt_b3': nrm(ks[15], (DEPTH, HYENA_ORDER * 2 * W_BRANCH), 0.02),
        'filt_freq': 1.0 + nrm(ks[16], (DEPTH, 2, FILTER_HIDDEN), 0.1),
        'hyena_bias': nrm(ks[17], (DEPTH, HYENA_ORDER, W_BRANCH), 0.5),
        'q_norm_g': 1.0 + nrm(ks[18], (DEPTH, HEAD_DIM), 0.02),
        'k_norm_g': 1.0 + nrm(ks[19], (DEPTH, HEAD_DIM), 0.02),
        'w_branch': nrm(ks[20], (DEPTH, N_BRANCH, W_BRANCH, D_MODEL), W_BRANCH ** -0.5),
        'w_out': nrm(ks[21], (DEPTH, D_MODEL, D_MODEL), D_MODEL ** -0.5),
    }


def reference(x, c, ctx, c_ctx, norm_g, w_mod, b_mod, w_in, conv_a, conv_h, filt_w1, filt_b1,
              filt_w2, filt_b2, filt_w3, filt_b3, filt_freq, hyena_bias, q_norm_g, k_norm_g,
              w_branch, w_out):
    S = x.shape[1]
    C_L = ctx.shape[1]
    cos, sin = _rope_tables(S)
    for i in range(DEPTH):
        last = i == DEPTH - 1
        filt = (filt_w1[i], filt_b1[i], filt_w2[i], filt_b2[i], filt_w3[i], filt_b3[i], filt_freq[i])
        sh, sc, gt = jnp.split(jax.nn.silu(c) @ w_mod[i] + b_mod[i], 3, axis=-1)
        sh_c, sc_c, gt_c = jnp.split(jax.nn.silu(c_ctx) @ w_mod[i] + b_mod[i], 3, axis=-1)
        h = _rms_norm(x, norm_g[i]) * (1.0 + sc[:, None]) + sh[:, None]
        hc = _rms_norm(ctx, norm_g[i]) * (1.0 + sc_c) + sh_c
        if last:
            k_c, v_c = _kv_heads(hc @ w_in[i][:, K_OFF:Z_OFF], k_norm_g[i])
        else:
            pc = hc @ w_in[i]
            k_c, v_c = _kv_heads(pc[..., K_OFF:Z_OFF], k_norm_g[i])
            attn_c = _gqa(_q_heads(pc, q_norm_g[i]), k_c, v_c)
            out_c = _mixer(pc, attn_c, conv_a[i], conv_h[i], _hyena_kernels_f(C_L, *filt),
                           hyena_bias[i], w_branch[i], w_out[i])
            ctx_next = ctx + gt_c * out_c
        p = h @ w_in[i]
        q = _apply_rope(_q_heads(p, q_norm_g[i]), cos, sin)
        k, v = _kv_heads(p[..., K_OFF:Z_OFF], k_norm_g[i])
        k = _apply_rope(k, cos, sin)
        attn = _latent_attention(q, k, v, k_c, v_c)
        out = _mixer(p, attn, conv_a[i], conv_h[i], _hyena_kernels_f(S, *filt),
                     hyena_bias[i], w_branch[i], w_out[i])
        x = x + gt[:, None] * out
        if not last:
            ctx = ctx_next
    return x
```

```cpp
#include <hip/hip_runtime.h>
#include <hip/hip_cooperative_groups.h>
#include <cstdio>
namespace cg = cooperative_groups;

#ifndef PER_PHASE_LAUNCH
#define PER_PHASE_LAUNCH 1
#endif

typedef _Float16 h16;
typedef _Float16 half8 __attribute__((ext_vector_type(8)));
typedef _Float16 half4 __attribute__((ext_vector_type(4)));
typedef float f32x16 __attribute__((ext_vector_type(16)));
typedef float f32x4 __attribute__((ext_vector_type(4)));
typedef unsigned u32x4 __attribute__((ext_vector_type(4)));
#define DI __device__ __forceinline__

constexpr int D = 1024, NBATCH = 16, SEQ = 2048, CTXL = 256, DEPTH = 4, WB = 512;
constexpr int T_LAT = NBATCH * SEQ, T_CTX = NBATCH * CTXL, T_ALL = T_LAT + T_CTX;
constexpr int IN_COLS = 8448, H_OFF = 2048, C_OFF = 4096, K_OFF = 4608, Z_OFF = 4864, G_OFF = 5376;
constexpr int SKV = CTXL + SEQ;
constexpr int KLEN_L = 2 * SEQ + 256, KOFF_L = SEQ + 64;
constexpr int KLEN_C = 2 * CTXL + 256, KOFF_C = CTXL + 64;
constexpr int NPH_LAYER = 9;
constexpr int NPHASES = 1 + DEPTH * NPH_LAYER;
constexpr int LDS_BYTES = 8 * KLEN_L * 2 + 65536;

constexpr size_t al(size_t x) { return (x + 255) & ~size_t(255); }
constexpr size_t WS_CTXW = 0;
constexpr size_t WS_MODS = WS_CTXW + al((size_t)T_CTX * D * 4);
constexpr size_t WS_ROPE = WS_MODS + al((size_t)DEPTH * 17 * 3072 * 4);
constexpr size_t WS_WINT = WS_ROPE + al((size_t)SEQ * 32 * 8);
constexpr size_t WS_WBRT = WS_WINT + al((size_t)IN_COLS * D * 2);
constexpr size_t WS_WOUTT = WS_WBRT + al((size_t)3 * D * WB * 2);
constexpr size_t WS_H2 = WS_WOUTT + al((size_t)D * D * 2);
constexpr size_t WS_KRL = WS_H2 + al((size_t)(SEQ + CTXL) * 64 * 4);
constexpr size_t WS_KRC = WS_KRL + al((size_t)2 * WB * KLEN_L * 2);
constexpr size_t WS_INVS = WS_KRC + al((size_t)2 * WB * KLEN_C * 2);
constexpr size_t WS_H16 = WS_INVS + al((size_t)2 * 2 * WB * 4);
constexpr size_t WS_R1 = WS_H16 + al((size_t)T_ALL * D * 2);
constexpr size_t WS_R2 = WS_R1 + al((size_t)T_ALL * 2048 * 2);
constexpr size_t WS_YB = WS_R2 + al((size_t)T_ALL * WB * 2);
constexpr size_t WS_Q = WS_YB + al((size_t)T_ALL * WB * 2);
constexpr size_t WS_K = WS_Q + al((size_t)T_ALL * WB * 2);
constexpr size_t WS_VT = WS_K + al((size_t)NBATCH * 2 * SKV * 64 * 2);
constexpr size_t WS_ZS = WS_VT + al((size_t)NBATCH * 2 * SKV * 64 * 2);
constexpr size_t WS_END = WS_ZS + al((size_t)T_ALL * WB * 2);
constexpr size_t HTC_OFF = (size_t)NBATCH * 2048 * SEQ;
constexpr size_t Z1C_OFF = (size_t)NBATCH * WB * SEQ;

struct Params {
  const float *x, *c, *ctx, *c_ctx, *norm_g, *w_mod, *b_mod, *w_in, *conv_a, *conv_h, *fw1, *fb1, *fw2, *fb2, *fw3, *fb3,
      *ffreq, *hbias, *qg, *kg, *w_branch, *w_out;
  float* out;
  char* ws;
  int ph_lo, ph_hi;
};

DI float silu_f(float x) { return x / (1.f + __expf(-x)); }
DI float sigmoid_f(float x) { return 1.f / (1.f + __expf(-x)); }
DI half4 cvt4(float a, float b, float c, float d) { half4 r; r[0] = (h16)a; r[1] = (h16)b; r[2] = (h16)c; r[3] = (h16)d; return r; }
DI void wait_vm0() { asm volatile("s_waitcnt vmcnt(0)" ::: "memory"); }
DI int otid() { int t = threadIdx.x; asm volatile("" : "+v"(t)); return t; }

template <int MB, bool SWAP>
DI void gemm_kloop(f32x16 (&acc)[MB][2], const h16* __restrict__ A, int lda, const h16* __restrict__ B, int ldb, int K, char* lds) {
  constexpr int A_BYTES = 64 * MB * 128, B_BYTES = 256 * 128, STAGE = A_BYTES + B_BYTES;
  const int tid = otid(), w = tid >> 6, lane = tid & 63;
  const int wr = w >> 2, wc = w & 3;
  const int lrow = w * 8 + (lane >> 3), pch = lane & 7;
  const int gch = pch ^ ((lrow >> 1) & 7);
  const h16* ga = A + (size_t)lrow * lda + gch * 8;
  const h16* gb = B + (size_t)lrow * ldb + gch * 8;
  const int lofs = lrow * 128 + pch * 16;
  const int r32 = lane & 31, hh = lane >> 5, sw = (r32 >> 1) & 7;
  const int a_rd = (wr * 32 * MB + r32) * 128;
  const int b_rd = A_BYTES + (wc * 64 + r32) * 128;
  const int nk = K >> 6;

  auto stage = [&](int kt, int buf) {
    char* s = lds + buf * STAGE;
#pragma unroll
    for (int j = 0; j < MB; ++j)
      __builtin_amdgcn_global_load_lds((const unsigned*)(ga + (size_t)j * 64 * lda + kt * 64), (unsigned*)(s + j * 8192 + lofs), 16, 0, 0);
#pragma unroll
    for (int j = 0; j < 4; ++j)
      __builtin_amdgcn_global_load_lds((const unsigned*)(gb + (size_t)j * 64 * ldb + kt * 64), (unsigned*)(s + A_BYTES + j * 8192 + lofs), 16, 0, 0);
  };
  stage(0, 0);
  wait_vm0();
  __syncthreads();
  for (int kt = 0; kt < nk; ++kt) {
    if (kt + 1 < nk) stage(kt + 1, (kt + 1) & 1);
    const char* s = lds + (kt & 1) * STAGE;
#pragma unroll
    for (int ks = 0; ks < 4; ++ks) {
      const int co = ((2 * ks + hh) ^ sw) * 16;
      half8 af[MB], bf[2];
#pragma unroll
      for (int mb = 0; mb < MB; ++mb) af[mb] = *(const half8*)(s + a_rd + mb * 4096 + co);
#pragma unroll
      for (int nb = 0; nb < 2; ++nb) bf[nb] = *(const half8*)(s + b_rd + nb * 4096 + co);
#pragma unroll
      for (int mb = 0; mb < MB; ++mb)
#pragma unroll
        for (int nb = 0; nb < 2; ++nb)
          acc[mb][nb] = SWAP ? __builtin_amdgcn_mfma_f32_32x32x16_f16(bf[nb], af[mb], acc[mb][nb], 0, 0, 0)
                             : __builtin_amdgcn_mfma_f32_32x32x16_f16(af[mb], bf[nb], acc[mb][nb], 0, 0, 0);
      __builtin_amdgcn_sched_barrier(0);
    }
    wait_vm0();
    __syncthreads();
  }
}

template <int MB>
DI void zero_acc(f32x16 (&acc)[MB][2]) {
#pragma unroll
  for (int mb = 0; mb < MB; ++mb)
#pragma unroll
    for (int nb = 0; nb < 2; ++nb)
#pragma unroll
      for (int v = 0; v < 16; ++v) acc[mb][nb][v] = 0.f;
}

DI void phase_prep(const Params& P, char* smem) {
  const int tid = otid();
  float* mods = (float*)(P.ws + WS_MODS);
  float2* rope = (float2*)(P.ws + WS_ROPE);
  for (int task = blockIdx.x; task < 208; task += gridDim.x) {
    if (task < 192) {
      const int layer = task / 48, n0 = (task % 48) * 64;
      float* s = (float*)smem;
      float* red = s + 17 * 1024;
      for (int i = tid; i < 17 * 1024; i += 512) {
        const int r = i >> 10, k = i & 1023;
        const float v = (r < 16) ? P.c[r * 1024 + k] : P.c_ctx[k];
        s[i] = silu_f(v);
      }
      __syncthreads();
      const int nl = tid & 63, ks = tid >> 6;
      float acc[17];
#pragma unroll
      for (int r = 0; r < 17; ++r) acc[r] = 0.f;
      const float* wp = P.w_mod + ((size_t)layer * 1024 + ks * 128) * 3072 + n0 + nl;
      for (int k = 0; k < 128; ++k) {
        const float wv = wp[(size_t)k * 3072];
#pragma unroll
        for (int r = 0; r < 17; ++r) acc[r] += s[r * 1024 + ks * 128 + k] * wv;
      }
#pragma unroll
      for (int r = 0; r < 17; ++r) red[(ks * 17 + r) * 64 + nl] = acc[r];
      __syncthreads();
      for (int o = tid; o < 17 * 64; o += 512) {
        const int r = o >> 6, n = o & 63;
        float v = P.b_mod[layer * 3072 + n0 + n];
#pragma unroll
        for (int k2 = 0; k2 < 8; ++k2) v += red[(k2 * 17 + r) * 64 + n];
        mods[(layer * 17 + r) * 3072 + n0 + n] = v;
      }
      __syncthreads();
    } else {
      const int base = ((task - 192) * 512 + tid) * 8;
#pragma unroll 1
      for (int e = 0; e < 8; ++e) {
        const int ent = base + e;
        const int t = ent >> 5, a = (ent >> 4) & 1, f = ent & 15;
        const float pos = (float)(a ? (t & 63) : (t >> 6));
        const float inv = powf(10000.f, -(float)f / 16.f);
        float sn, cs;
        sincosf(pos * inv, &sn, &cs);
        rope[ent] = make_float2(cs, sn);
      }
    }
  }
}

DI void cvt_tile(const float* __restrict__ src, int ldn, h16* __restrict__ dst, int ldk, int k0, int n0, float* t) {
  const int tid = otid();
  {
    const int r = tid >> 4, c4 = tid & 15;
#pragma unroll
    for (int i = 0; i < 2; ++i) {
      const int k = r + 32 * i;
      const float4 v = *(const float4*)(src + (size_t)(k0 + k) * ldn + n0 + c4 * 4);
      t[k * 65 + c4 * 4 + 0] = v.x; t[k * 65 + c4 * 4 + 1] = v.y; t[k * 65 + c4 * 4 + 2] = v.z; t[k * 65 + c4 * 4 + 3] = v.w;
    }
  }
  __syncthreads();
  {
    const int n = tid >> 3, kc = tid & 7;
    half8 o;
#pragma unroll
    for (int j = 0; j < 8; ++j) o[j] = (h16)t[(kc * 8 + j) * 65 + n];
    *(half8*)(dst + (size_t)(n0 + n) * ldk + k0 + kc * 8) = o;
  }
  __syncthreads();
}

DI void phase_norm(const Params& P, int layer, char* smem) {
  const int tid = otid(), w = tid >> 6, lane = tid & 63;
  h16* winT = (h16*)(P.ws + WS_WINT);
  h16* wbrT = (h16*)(P.ws + WS_WBRT);
  h16* woutT = (h16*)(P.ws + WS_WOUTT);
  for (int t = blockIdx.x; t < 2112 + 384 + 256; t += gridDim.x) {
    if (t < 2112) {
      cvt_tile(P.w_in + (size_t)layer * D * IN_COLS, IN_COLS, winT, D, (t & 15) * 64, (t >> 4) * 64, (float*)smem);
    } else if (t < 2112 + 384) {
      const int u = t - 2112, br = u >> 7, v = u & 127;
      cvt_tile(P.w_branch + ((size_t)layer * 3 + br) * WB * D, D, wbrT + (size_t)br * D * WB, WB, (v & 7) * 64, (v >> 3) * 64, (float*)smem);
    } else {
      const int u = t - 2112 - 384;
      cvt_tile(P.w_out + (size_t)layer * D * D, D, woutT, D, (u & 15) * 64, (u >> 4) * 64, (float*)smem);
    }
  }
  const int gw = blockIdx.x * 8 + w, nw = gridDim.x * 8;
  const float* mods = (const float*)(P.ws + WS_MODS) + (size_t)layer * 17 * 3072;
  const float* ng = P.norm_g + layer * D;
  h16* hb = (h16*)(P.ws + WS_H16);
  for (int row = gw; row < T_ALL; row += nw) {
    const float* src;
    int b;
    if (row < T_LAT) { src = (layer == 0 ? P.x : P.out) + (size_t)row * D; b = row >> 11; }
    else { const int rc = row - T_LAT; src = (layer == 0 ? P.ctx : (const float*)(P.ws + WS_CTXW)) + (size_t)rc * D; b = 16; }
    const float* md = mods + b * 3072;
    float4 xv[4];
    float ss = 0.f;
#pragma unroll
    for (int j = 0; j < 4; ++j) {
      xv[j] = *(const float4*)(src + j * 256 + lane * 4);
      ss += xv[j].x * xv[j].x + xv[j].y * xv[j].y + xv[j].z * xv[j].z + xv[j].w * xv[j].w;
    }
#pragma unroll
    for (int m = 32; m >= 1; m >>= 1) ss += __shfl_xor(ss, m);
    const float rstd = rsqrtf(ss * (1.f / 1024.f) + 1e-6f);
#pragma unroll
    for (int j = 0; j < 4; ++j) {
      const int k = j * 256 + lane * 4;
      const float4 g = *(const float4*)(ng + k);
      const float4 sh = *(const float4*)(md + k);
      const float4 sc = *(const float4*)(md + 1024 + k);
      *(half4*)(hb + (size_t)row * D + k) = cvt4(xv[j].x * rstd * g.x * (1.f + sc.x) + sh.x, xv[j].y * rstd * g.y * (1.f + sc.y) + sh.y,
                                                  xv[j].z * rstd * g.z * (1.f + sc.z) + sh.z, xv[j].w * rstd * g.w * (1.f + sc.w) + sh.w);
    }
  }
  float* h2 = (float*)(P.ws + WS_H2);
  const float* w1 = P.fw1 + layer * 33 * 64;
  const float* w2 = P.fw2 + layer * 64 * 64;
  const float f0 = P.ffreq[layer * 128 + lane], f1 = P.ffreq[layer * 128 + 64 + lane];
  const float b1 = P.fb1[layer * 64 + lane], b2 = P.fb2[layer * 64 + lane];
  for (int p = gw; p < SEQ + CTXL; p += nw) {
    const int L = p >= SEQ ? CTXL : SEQ, tau = p >= SEQ ? p - SEQ : p;
    const float tt = (float)tau / (float)(L - 1);
    const float wv = (6.283185307179586f / (float)L) * (float)tau;
    float feat = 0.f;
    if (lane == 0) feat = tt;
    else if (lane <= 16) feat = cosf(wv * (1e-4f + (float)(lane - 1) * ((15.f - 1e-4f) / 15.f)));
    else if (lane <= 32) feat = sinf(wv * (1e-4f + (float)(lane - 17) * ((15.f - 1e-4f) / 15.f)));
    float a1 = b1;
    for (int e = 0; e < 33; ++e) a1 += __shfl(feat, e) * w1[e * 64 + lane];
    const float h1 = sinf(f0 * a1);
    float a2 = b2;
    for (int k = 0; k < 64; ++k) a2 += __shfl(h1, k) * w2[k * 64 + lane];
    h2[(size_t)p * 64 + lane] = sinf(f1 * a2);
  }
}

DI void filt2_task(const Params& P, int layer, int set, int o, int cg16, char* smem) {
  const int tid = otid();
  const int L = set ? CTXL : SEQ, KLEN = set ? KLEN_C : KLEN_L, OFF = set ? KOFF_C : KOFF_L;
  h16* krb = (h16*)(P.ws + (set ? WS_KRC : WS_KRL));
  const float* h2 = (const float*)(P.ws + WS_H2) + (set ? (size_t)SEQ * 64 : 0);
  float* invS = (float*)(P.ws + WS_INVS);
  const int c0 = cg16 * 16;
  float* w3s = (float*)smem;
  float* part = w3s + 2048;
  for (int i = tid; i < 2048; i += 512) {
    const int k = i >> 5, d = (i >> 4) & 1, cc = i & 15;
    w3s[i] = P.fw3[((size_t)layer * 64 + k) * 2048 + (o * 2 + d) * 512 + c0 + cc];
  }
  __syncthreads();
  const int cc = tid & 15, sl = tid >> 4, c = c0 + cc;
  const float b30 = P.fb3[layer * 2048 + (o * 2 + 0) * 512 + c], b31 = P.fb3[layer * 2048 + (o * 2 + 1) * 512 + c];
  const float MIN_DECAY = -3.0701134573253940f, MAX_DECAY = -15.350567286626974f;
  const float delta = fabsf(MIN_DECAY + (float)c * ((MAX_DECAY - MIN_DECAY) / 511.f));
  h16* kr = krb + (size_t)(o * 512 + c) * KLEN;
  const int nper = L >> 5;
  float sum = 0.f;
  for (int tau = sl * nper; tau < (sl + 1) * nper; ++tau) {
    const float4* hr = (const float4*)(h2 + (size_t)tau * 64);
    float v0 = b30, v1 = b31;
#pragma unroll
    for (int kc = 0; kc < 16; ++kc) {
      const float4 hv = hr[kc];
      v0 += hv.x * w3s[(kc * 4 + 0) * 32 + cc] + hv.y * w3s[(kc * 4 + 1) * 32 + cc] + hv.z * w3s[(kc * 4 + 2) * 32 + cc] + hv.w * w3s[(kc * 4 + 3) * 32 + cc];
      v1 += hv.x * w3s[(kc * 4 + 0) * 32 + 16 + cc] + hv.y * w3s[(kc * 4 + 1) * 32 + 16 + cc] + hv.z * w3s[(kc * 4 + 2) * 32 + 16 + cc] + hv.w * w3s[(kc * 4 + 3) * 32 + 16 + cc];
    }
    const float tt = (float)tau / (float)(L - 1);
    const float dec = expf(-tt * delta);
    v0 *= dec; v1 *= dec;
    kr[OFF - tau] = (h16)v0;
    sum += fabsf(v0);
    if (tau >= 1) { kr[OFF + tau] = (h16)v1; sum += fabsf(v1); }
  }
  for (int z = sl; z < 257; z += 32) {
    const int idx = z < 65 ? z : (OFF + L + (z - 65));
    kr[idx] = (h16)0.f;
  }
  part[sl * 16 + cc] = sum;
  __syncthreads();
  if (tid < 16) {
    float tot = 0.f;
    for (int s2 = 0; s2 < 32; ++s2) tot += part[s2 * 16 + tid];
    invS[(set * 2 + o) * 512 + c0 + tid] = 1.f / tot;
  }
  __syncthreads();
}

DI void phase_gemm_h(const Params& P, int layer, char* smem) {
  const bool last = layer == DEPTH - 1;
  const int nfilt = last ? 64 : 128;
  const int n_mt = last ? 128 : 144;
  const int total = nfilt + n_mt * 8;
  const h16* hb = (const h16*)(P.ws + WS_H16);
  const h16* winT = (const h16*)(P.ws + WS_WINT);
  h16* hT = (h16*)(P.ws + WS_R1);
  const int tid = otid(), lane = tid & 63, w = tid >> 6, wr = w >> 2, wc = w & 3, r32 = lane & 31, hh = lane >> 5;
  for (int item = blockIdx.x; item < total; item += gridDim.x) {
    if (item < nfilt) {
      const int set = item >> 6, id = item & 63;
      filt2_task(P, layer, set, id >> 5, id & 31, smem);
      continue;
    }
    const int t = item - nfilt, mt = t >> 3, nt = t & 7;
    f32x16 acc[4][2];
    zero_acc<4>(acc);
    gemm_kloop<4, false>(acc, hb + (size_t)mt * 256 * D, D, winT + (size_t)(H_OFF + nt * 256) * D, D, D, smem);
    const int row0 = mt * 256;
    const bool isctx = row0 >= T_LAT;
    const bool gate = nt >= 6;
#pragma unroll
    for (int mb = 0; mb < 4; ++mb)
#pragma unroll
      for (int nb = 0; nb < 2; ++nb) {
        const int col = nt * 256 + wc * 64 + nb * 32 + r32;
#pragma unroll
        for (int g = 0; g < 4; ++g) {
          const int grow = row0 + wr * 128 + mb * 32 + 8 * g + 4 * hh;
          float v0 = acc[mb][nb][4 * g], v1 = acc[mb][nb][4 * g + 1], v2 = acc[mb][nb][4 * g + 2], v3 = acc[mb][nb][4 * g + 3];
          if (gate) { v0 = silu_f(v0); v1 = silu_f(v1); v2 = silu_f(v2); v3 = silu_f(v3); }
          h16* dst;
          if (!isctx) { const int b = grow >> 11, tt = grow & 2047; dst = hT + ((size_t)(b * 2048 + col) * SEQ + tt); }
          else { const int rc = grow - T_LAT, b = rc >> 8, tt = rc & 255; dst = hT + HTC_OFF + ((size_t)(b * 2048 + col) * CTXL + tt); }
          *(half4*)dst = cvt4(v0, v1, v2, v3);
        }
      }
  }
}

DI void phase_shortconv(const Params& P, int layer, char* smem) {
  const bool last = layer == DEPTH - 1;
  const int tid = otid(), lane = tid & 63, w = tid >> 6;
  const int gw = blockIdx.x * 8 + w, nw = gridDim.x * 8;
  h16* hT = (h16*)(P.ws + WS_R1);
  const float* cw = P.conv_h + (size_t)layer * 3 * 1536;
  const int nrows_l = NBATCH * 1536;
  const int nrows = last ? nrows_l : 2 * nrows_l;
  for (int r = gw; r < nrows; r += nw) {
    if (r < nrows_l) {
      const int b = r / 1536, col = r % 1536;
      const float w0 = cw[col], w1 = cw[1536 + col], w2 = cw[3072 + col];
      h16* p = hT + (size_t)(b * 2048 + col) * SEQ;
      half8 v[4];
#pragma unroll
      for (int j = 0; j < 4; ++j) v[j] = *(const half8*)(p + j * 512 + lane * 8);
      float prev[4], next[4];
#pragma unroll
      for (int j = 0; j < 4; ++j) {
        const float lastv = (float)v[j][7], firstv = (float)v[j][0];
        float pu = __shfl_up(lastv, 1);
        float nd = __shfl_down(firstv, 1);
        prev[j] = pu; next[j] = nd;
      }
#pragma unroll
      for (int j = 0; j < 4; ++j) {
        const float l63 = (j > 0) ? __shfl((float)v[j > 0 ? j - 1 : 0][7], 63) : 0.f;
        const float f0 = (j < 3) ? __shfl((float)v[j < 3 ? j + 1 : 3][0], 0) : 0.f;
        if (lane == 0) prev[j] = l63;
        if (lane == 63) next[j] = f0;
      }
#pragma unroll
      for (int j = 0; j < 4; ++j) {
        half8 o;
#pragma unroll
        for (int e = 0; e < 8; ++e) {
          const float a = e == 0 ? prev[j] : (float)v[j][e > 0 ? e - 1 : 0];
          const float cc = (float)v[j][e];
          const float d = e == 7 ? next[j] : (float)v[j][e < 7 ? e + 1 : 7];
          o[e] = (h16)(w0 * a + w1 * cc + w2 * d);
        }
        *(half8*)(p + j * 512 + lane * 8) = o;
      }
    } else {
      const int r2 = r - nrows_l;
      const int b = r2 / 1536, col = r2 % 1536;
      const float w0 = cw[col], w1 = cw[1536 + col], w2 = cw[3072 + col];
      h16* p = hT + HTC_OFF + (size_t)(b * 2048 + col) * CTXL;
      const half4 v = *(const half4*)(p + lane * 4);
      float prev = __shfl_up((float)v[3], 1), next = __shfl_down((float)v[0], 1);
      if (lane == 0) prev = 0.f;
      if (lane == 63) next = 0.f;
      half4 o;
      o[0] = (h16)(w0 * prev + w1 * (float)v[0] + w2 * (float)v[1]);
      o[1] = (h16)(w0 * (float)v[0] + w1 * (float)v[1] + w2 * (float)v[2]);
      o[2] = (h16)(w0 * (float)v[1] + w1 * (float)v[2] + w2 * (float)v[3]);
      o[3] = (h16)(w0 * (float)v[2] + w1 * (float)v[3] + w2 * next);
      *(half4*)(p + lane * 4) = o;
    }
  }
}

template <int MODE>
DI void toeplitz_task(const Params& P, int layer, int set, int cg, int chunk, char* smem) {
  const int tid = otid(), w = tid >> 6, lane = tid & 63;
  const int L = set ? CTXL : SEQ, KLEN = set ? KLEN_C : KLEN_L, OFF = set ? KOFF_C : KOFF_L;
  const h16* krg = (const h16*)(P.ws + (set ? WS_KRC : WS_KRL)) + (size_t)(MODE * 512 + cg * 8) * KLEN;
  h16* krs = (h16*)smem;
  char* stg = smem + 8 * KLEN_L * 2;
  for (int i = tid; i < KLEN; i += 512) *(half8*)(krs + i * 8) = *(const half8*)(krg + i * 8);
  __syncthreads();
  const int c = cg * 8 + w;
  const int bb = lane & 15, kg = lane >> 4;
  const h16* hT = (const h16*)(P.ws + WS_R1) + (set ? HTC_OFF : 0);
  h16* z1T = (h16*)(P.ws + WS_R2) + (set ? Z1C_OFF : 0);
  const h16* Urow = (MODE == 0) ? hT + (size_t)(bb * 2048 + c) * L : z1T + (size_t)(bb * 512 + c) * L;
  const float invs = ((const float*)(P.ws + WS_INVS))[(set * 2 + MODE) * 512 + c];
  const float bias = P.hbias[(layer * 2 + MODE) * 512 + c];
  const int nsteps = (L >> 5) + 1;
  const int ngroups = (nsteps + 3) >> 2;
  const int npass = set ? 1 : 2;
  const h16* krw = krs + w * KLEN;
  for (int pass = 0; pass < npass; ++pass) {
    const int tb = chunk * 512 + pass * 256;
    f32x4 acc[2][8];
#pragma unroll
    for (int ta = 0; ta < 2; ++ta)
#pragma unroll
      for (int r = 0; r < 8; ++r) acc[ta][r] = f32x4{0.f, 0.f, 0.f, 0.f};
    u32x4 cur[8], nxt[8];
    auto load_group = [&](int g, u32x4 (&dst)[8]) {
#pragma unroll
      for (int q = 0; q < 4; ++q) {
        const int s = -32 + (g * 4 + q) * 32 + 8 * kg;
        u32x4 a = u32x4{0u, 0u, 0u, 0u}, b2 = u32x4{0u, 0u, 0u, 0u};
        if (s >= 0 && s < L) a = *(const u32x4*)(Urow + s);
        if (s + 8 >= 0 && s + 8 < L) b2 = *(const u32x4*)(Urow + s + 8);
        dst[2 * q] = a; dst[2 * q + 1] = b2;
      }
    };
    load_group(0, cur);
    const int abase = OFF - tb - 8 * ((lane & 15) - kg);
    for (int g = 0; g < ngroups; ++g) {
      if (g + 1 < ngroups) load_group(g + 1, nxt);
#pragma unroll
      for (int q = 0; q < 4; ++q) {
        const int s0 = -32 + (g * 4 + q) * 32;
        const half8 af0 = *(const half8*)(krw + abase + s0);
        const half8 af1 = *(const half8*)(krw + abase + s0 - 128);
        unsigned d[8];
#pragma unroll
        for (int e = 0; e < 4; ++e) { d[e] = cur[2 * q][e]; d[4 + e] = cur[2 * q + 1][e]; }
#pragma unroll
        for (int r = 0; r < 8; ++r) {
          u32x4 bw;
#pragma unroll
          for (int e = 0; e < 4; ++e)
            bw[e] = (r & 1) ? __builtin_amdgcn_alignbit(d[(r >> 1) + e + 1 > 7 ? 7 : (r >> 1) + e + 1], d[(r >> 1) + e], 16) : d[(r >> 1) + e];
          const half8 bfr = __builtin_bit_cast(half8, bw);
          acc[0][r] = __builtin_amdgcn_mfma_f32_16x16x32_f16(af0, bfr, acc[0][r], 0, 0, 0);
          acc[1][r] = __builtin_amdgcn_mfma_f32_16x16x32_f16(af1, bfr, acc[1][r], 0, 0, 0);
        }
      }
#pragma unroll
      for (int e = 0; e < 8; ++e) cur[e] = nxt[e];
    }
#pragma unroll
    for (int ta = 0; ta < 2; ++ta) {
      const int t0 = tb + 128 * ta + 32 * kg;
#pragma unroll
      for (int v = 0; v < 4; ++v) {
        const int t = t0 + 8 * v;
        if (MODE == 0) {
          const half8 x1 = *(const half8*)(hT + (size_t)(bb * 2048 + 512 + c) * L + t);
          const half8 uu = *(const half8*)(Urow + t);
          half8 o;
#pragma unroll
          for (int r = 0; r < 8; ++r) o[r] = (h16)((float)x1[r] * (acc[ta][r][v] * invs + (float)uu[r] * bias));
          *(half8*)(z1T + (size_t)(bb * 512 + c) * L + t) = o;
        } else {
          const half8 x2 = *(const half8*)(hT + (size_t)(bb * 2048 + 1024 + c) * L + t);
          const half8 gt = *(const half8*)(hT + (size_t)(bb * 2048 + 1536 + c) * L + t);
          const half8 uu = *(const half8*)(Urow + t);
#pragma unroll
          for (int r = 0; r < 8; ++r) {
            const float y = (float)x2[r] * (acc[ta][r][v] * invs + (float)uu[r] * bias) * (float)gt[r];
            const int tl = t - tb + r;
            *(h16*)(stg + ((tl * 16 + bb) * 8 + w) * 2) = (h16)y;
          }
        }
      }
    }
    if (MODE == 1) {
      __syncthreads();
      h16* yb = (h16*)(P.ws + WS_YB);
#pragma unroll
      for (int i = 0; i < 8; ++i) {
        const int item = tid + 512 * i;
        const int b = item >> 8, tl = item & 255;
        const size_t tok = set ? (size_t)T_LAT + b * CTXL + tb + tl : (size_t)b * SEQ + tb + tl;
        *(half8*)(yb + tok * WB + cg * 8) = *(const half8*)(stg + (tl * 16 + b) * 16);
      }
      __syncthreads();
    }
  }
  __syncthreads();
}

template <int MODE>
DI void phase_toeplitz(const Params& P, int layer, char* smem) {
  const bool last = layer == DEPTH - 1;
  const int total = last ? 256 : 320;
  for (int item = blockIdx.x; item < total; item += gridDim.x) {
    if (item < 256) toeplitz_task<MODE>(P, layer, 0, item >> 2, item & 3, smem);
    else toeplitz_task<MODE>(P, layer, 1, item - 256, 0, smem);
  }
}

DI void head_norm_rope(f32x16& a0, f32x16& a1, const float* __restrict__ gvec, bool do_rope, int t, const float2* __restrict__ rope, int hh) {
  float ss = 0.f;
#pragma unroll
  for (int v = 0; v < 16; ++v) ss += a0[v] * a0[v] + a1[v] * a1[v];
  ss += __shfl_xor(ss, 32);
  const float rstd = rsqrtf(ss * (1.f / 64.f) + 1e-6f);
#pragma unroll
  for (int g = 0; g < 4; ++g) {
    const float4 g0 = *(const float4*)(gvec + 8 * g + 4 * hh);
    const float4 g1 = *(const float4*)(gvec + 32 + 8 * g + 4 * hh);
    a0[4 * g] *= rstd * g0.x; a0[4 * g + 1] *= rstd * g0.y; a0[4 * g + 2] *= rstd * g0.z; a0[4 * g + 3] *= rstd * g0.w;
    a1[4 * g] *= rstd * g1.x; a1[4 * g + 1] *= rstd * g1.y; a1[4 * g + 2] *= rstd * g1.z; a1[4 * g + 3] *= rstd * g1.w;
  }
  if (do_rope) {
#pragma unroll
    for (int gl = 0; gl < 2; ++gl) {
      const float4* r0 = (const float4*)(rope + ((size_t)t * 2 + 0) * 16 + 8 * gl + 4 * hh);
      const float4* r1 = (const float4*)(rope + ((size_t)t * 2 + 1) * 16 + 8 * gl + 4 * hh);
      const float4 c0a = r0[0], c0b = r0[1], c1a = r1[0], c1b = r1[1];
      const float cs0[4] = {c0a.x, c0a.z, c0b.x, c0b.z}, sn0[4] = {c0a.y, c0a.w, c0b.y, c0b.w};
      const float cs1[4] = {c1a.x, c1a.z, c1b.x, c1b.z}, sn1[4] = {c1a.y, c1a.w, c1b.y, c1b.w};
#pragma unroll
      for (int e = 0; e < 4; ++e) {
        const float x1 = a0[4 * gl + e], x2 = a0[4 * (gl + 2) + e];
        a0[4 * gl + e] = x1 * cs0[e] - x2 * sn0[e];
        a0[4 * (gl + 2) + e] = x2 * cs0[e] + x1 * sn0[e];
        const float y1 = a1[4 * gl + e], y2 = a1[4 * (gl + 2) + e];
        a1[4 * gl + e] = y1 * cs1[e] - y2 * sn1[e];
        a1[4 * (gl + 2) + e] = y2 * cs1[e] + y1 * sn1[e];
      }
    }
  }
}

DI void phase_gemm_aq(const Params& P, int layer, char* smem) {
  const bool last = layer == DEPTH - 1;
  const int n_lat = 128 * 13;
  const int total = n_lat + (last ? 16 : 16 * 13);
  const h16* hb = (const h16*)(P.ws + WS_H16);
  const h16* winT = (const h16*)(P.ws + WS_WINT);
  h16* pa = (h16*)(P.ws + WS_R1);
  h16* qb = (h16*)(P.ws + WS_Q);
  h16* kb = (h16*)(P.ws + WS_K);
  h16* vT = (h16*)(P.ws + WS_VT);
  h16* zs = (h16*)(P.ws + WS_ZS);
  const float2* rope = (const float2*)(P.ws + WS_ROPE);
  const int tid = otid(), lane = tid & 63, w = tid >> 6, wr = w >> 2, wc = w & 3, r32 = lane & 31, hh = lane >> 5;
  for (int item = blockIdx.x; item < total; item += gridDim.x) {
    int mt, nt;
    if (item < n_lat) { mt = item / 13; nt = item % 13; }
    else { const int u = item - n_lat; if (last) { mt = 128 + u; nt = 10; } else { mt = 128 + u / 13; nt = u % 13; } }
    const int colbase = nt < 8 ? nt * 256 : C_OFF + (nt - 8) * 256;
    f32x16 acc[4][2];
    zero_acc<4>(acc);
    gemm_kloop<4, true>(acc, hb + (size_t)mt * 256 * D, D, winT + (size_t)colbase * D, D, D, smem);
    const int row0 = mt * 256;
    const bool isctx = row0 >= T_LAT;
#pragma unroll
    for (int mb = 0; mb < 4; ++mb) {
      const int row = row0 + wr * 128 + mb * 32 + r32;
      int b, t;
      if (!isctx) { b = row >> 11; t = row & 2047; } else { b = (row - T_LAT) >> 8; t = (row - T_LAT) & 255; }
      if (nt < 8) {
#pragma unroll
        for (int nb = 0; nb < 2; ++nb)
#pragma unroll
          for (int g = 0; g < 4; ++g) {
            float v0 = acc[mb][nb][4 * g], v1 = acc[mb][nb][4 * g + 1], v2 = acc[mb][nb][4 * g + 2], v3 = acc[mb][nb][4 * g + 3];
            if (nt >= 6) { v0 = silu_f(v0); v1 = silu_f(v1); v2 = silu_f(v2); v3 = silu_f(v3); }
            *(half4*)(pa + (size_t)row * 2048 + nt * 256 + wc * 64 + nb * 32 + 8 * g + 4 * hh) = cvt4(v0, v1, v2, v3);
          }
      } else if (nt < 10) {
        const int head = (nt - 8) * 4 + wc;
        head_norm_rope(acc[mb][0], acc[mb][1], P.qg + layer * 64, !isctx, t, rope, hh);
#pragma unroll
        for (int nb = 0; nb < 2; ++nb)
#pragma unroll
          for (int g = 0; g < 4; ++g)
            *(half4*)(qb + (size_t)row * 512 + head * 64 + nb * 32 + 8 * g + 4 * hh) =
                cvt4(acc[mb][nb][4 * g], acc[mb][nb][4 * g + 1], acc[mb][nb][4 * g + 2], acc[mb][nb][4 * g + 3]);
      } else if (nt == 10) {
        const int key = isctx ? t : CTXL + t;
        if (wc < 2) {
          head_norm_rope(acc[mb][0], acc[mb][1], P.kg + layer * 64, !isctx, t, rope, hh);
#pragma unroll
          for (int nb = 0; nb < 2; ++nb)
#pragma unroll
            for (int g = 0; g < 4; ++g)
              *(half4*)(kb + ((size_t)(b * 2 + wc) * SKV + key) * 64 + nb * 32 + 8 * g + 4 * hh) =
                  cvt4(acc[mb][nb][4 * g], acc[mb][nb][4 * g + 1], acc[mb][nb][4 * g + 2], acc[mb][nb][4 * g + 3]);
        } else {
#pragma unroll
          for (int nb = 0; nb < 2; ++nb)
#pragma unroll
            for (int v = 0; v < 16; ++v) {
              const int d = nb * 32 + 8 * (v >> 2) + 4 * hh + (v & 3);
              vT[((size_t)(b * 2 + (wc - 2)) * 64 + d) * SKV + key] = (h16)acc[mb][nb][v];
            }
        }
      } else {
#pragma unroll
        for (int nb = 0; nb < 2; ++nb)
#pragma unroll
          for (int g = 0; g < 4; ++g)
            *(half4*)(zs + (size_t)row * 512 + (nt - 11) * 256 + wc * 64 + nb * 32 + 8 * g + 4 * hh) =
                cvt4(silu_f(acc[mb][nb][4 * g]), silu_f(acc[mb][nb][4 * g + 1]), silu_f(acc[mb][nb][4 * g + 2]), silu_f(acc[mb][nb][4 * g + 3]));
      }
    }
  }
}

DI void attn_task(const Params& P, int set, int b, int kvh, int qt, char* smem) {
  const int tid = otid(), w = tid >> 6, lane = tid & 63, r32 = lane & 31, hh = lane >> 5;
  const int head = kvh * 4 + (w & 3), qsub = w >> 2;
  const int nkeys = set ? CTXL : SKV;
  const size_t row = (set ? (size_t)T_LAT + b * CTXL : (size_t)b * SEQ) + qt * 64 + qsub * 32 + r32;
  h16* qb = (h16*)(P.ws + WS_Q);
  const h16* zs = (const h16*)(P.ws + WS_ZS);
  const h16* kg = (const h16*)(P.ws + WS_K) + (size_t)(b * 2 + kvh) * SKV * 64;
  const h16* vg = (const h16*)(P.ws + WS_VT) + (size_t)(b * 2 + kvh) * 64 * SKV;
  half8 qf[4];
#pragma unroll
  for (int ds = 0; ds < 4; ++ds) qf[ds] = *(const half8*)(qb + row * 512 + head * 64 + 16 * ds + 8 * hh);
  const int srow = tid >> 3, sch = tid & 7, ssw = (srow >> 1) & 7;
  const int k_wr = srow * 128 + ((sch ^ ssw) * 16);
  const int u = sch >> 1, od = sch & 1;
  const int v_wr0 = 8192 + srow * 128 + (((2 * u) ^ ssw) * 16) + 8 * od;
  const int v_wr1 = 8192 + srow * 128 + (((2 * u + 1) ^ ssw) * 16) + 8 * od;
  const int sw = (r32 >> 1) & 7;
  const int ntile = nkeys >> 6;
  half8 kreg = *(const half8*)(kg + (size_t)srow * 64 + sch * 8);
  half8 vreg = *(const half8*)(vg + (size_t)srow * SKV + sch * 8);
  {
    char* s = smem;
    *(half8*)(s + k_wr) = kreg;
    half4 lo, hi;
    lo[0] = vreg[0]; lo[1] = vreg[1]; lo[2] = vreg[2]; lo[3] = vreg[3];
    hi[0] = vreg[4]; hi[1] = vreg[5]; hi[2] = vreg[6]; hi[3] = vreg[7];
    *(half4*)(s + v_wr0) = lo;
    *(half4*)(s + v_wr1) = hi;
  }
  __syncthreads();
  f32x16 o0, o1;
#pragma unroll
  for (int v = 0; v < 16; ++v) { o0[v] = 0.f; o1[v] = 0.f; }
  float m_run = -1e30f, l_run = 0.f;
  const float cscale = 0.125f * 1.4426950408889634f;
#pragma unroll 1
  for (int kt = 0; kt < ntile; ++kt) {
    if (kt + 1 < ntile) {
      kreg = *(const half8*)(kg + (size_t)((kt + 1) * 64 + srow) * 64 + sch * 8);
      vreg = *(const half8*)(vg + (size_t)srow * SKV + (kt + 1) * 64 + sch * 8);
    }
    const char* s = smem + (kt & 1) * 16384;
    f32x16 s0, s1;
#pragma unroll
    for (int v = 0; v < 16; ++v) { s0[v] = 0.f; s1[v] = 0.f; }
#pragma unroll
    for (int ds = 0; ds < 4; ++ds) {
      const int co = ((2 * ds + hh) ^ sw) * 16;
      const half8 k0 = *(const half8*)(s + r32 * 128 + co);
      const half8 k1 = *(const half8*)(s + (32 + r32) * 128 + co);
      s0 = __builtin_amdgcn_mfma_f32_32x32x16_f16(k0, qf[ds], s0, 0, 0, 0);
      s1 = __builtin_amdgcn_mfma_f32_32x32x16_f16(k1, qf[ds], s1, 0, 0, 0);
    }
    float mx = s0[0];
#pragma unroll
    for (int v = 0; v < 16; ++v) { mx = fmaxf(mx, s0[v]); mx = fmaxf(mx, s1[v]); }
    mx = fmaxf(mx, __shfl_xor(mx, 32));
    const float m_new = fmaxf(m_run, mx * cscale);
    const float alpha = exp2f(m_run - m_new);
    m_run = m_new;
    float ps = 0.f;
#pragma unroll
    for (int v = 0; v < 16; ++v) {
      s0[v] = exp2f(s0[v] * cscale - m_new); ps += s0[v];
      s1[v] = exp2f(s1[v] * cscale - m_new); ps += s1[v];
    }
    l_run = l_run * alpha + ps;
#pragma unroll
    for (int v = 0; v < 16; ++v) { o0[v] *= alpha; o1[v] *= alpha; }
#pragma unroll
    for (int uu = 0; uu < 4; ++uu) {
      half8 pf;
#pragma unroll
      for (int j = 0; j < 8; ++j) pf[j] = (h16)((uu < 2) ? s0[8 * (uu & 1) + j] : s1[8 * (uu & 1) + j]);
      const int co = ((2 * uu + hh) ^ sw) * 16;
      const half8 v0 = *(const half8*)(s + 8192 + r32 * 128 + co);
      const half8 v1 = *(const half8*)(s + 8192 + (32 + r32) * 128 + co);
      o0 = __builtin_amdgcn_mfma_f32_32x32x16_f16(v0, pf, o0, 0, 0, 0);
      o1 = __builtin_amdgcn_mfma_f32_32x32x16_f16(v1, pf, o1, 0, 0, 0);
    }
    if (kt + 1 < ntile) {
      char* s2 = smem + ((kt + 1) & 1) * 16384;
      *(half8*)(s2 + k_wr) = kreg;
      half4 lo, hi;
      lo[0] = vreg[0]; lo[1] = vreg[1]; lo[2] = vreg[2]; lo[3] = vreg[3];
      hi[0] = vreg[4]; hi[1] = vreg[5]; hi[2] = vreg[6]; hi[3] = vreg[7];
      *(half4*)(s2 + v_wr0) = lo;
      *(half4*)(s2 + v_wr1) = hi;
    }
    __syncthreads();
  }
  const float ltot = l_run + __shfl_xor(l_run, 32);
  const float inv = 1.f / ltot;
#pragma unroll
  for (int db = 0; db < 2; ++db)
#pragma unroll
    for (int g = 0; g < 4; ++g) {
      const size_t off = row * 512 + head * 64 + db * 32 + 8 * g + 4 * hh;
      const half4 z = *(const half4*)(zs + off);
      const f32x16& o = db ? o1 : o0;
      *(half4*)(qb + off) = cvt4(o[4 * g] * inv * (float)z[0], o[4 * g + 1] * inv * (float)z[1], o[4 * g + 2] * inv * (float)z[2], o[4 * g + 3] * inv * (float)z[3]);
    }
}

DI void phase_attn(const Params& P, int layer, char* smem) {
  const bool last = layer == DEPTH - 1;
  const int n_lat = NBATCH * 2 * 32;
  const int total = n_lat + (last ? 0 : NBATCH * 2 * 4);
  for (int item = blockIdx.x; item < total; item += gridDim.x) {
    if (item < n_lat) attn_task(P, 0, item >> 6, (item >> 5) & 1, item & 31, smem);
    else { const int u = item - n_lat; attn_task(P, 1, u >> 3, (u >> 2) & 1, u & 3, smem); }
  }
  const int tid = otid(), lane = tid & 63, w = tid >> 6;
  const int gw = blockIdx.x * 8 + w, nw = gridDim.x * 8;
  const h16* pa = (const h16*)(P.ws + WS_R1);
  h16* ya = (h16*)(P.ws + WS_R2);
  const int nitems = (last ? T_LAT : T_ALL) / 8;
  const float* cw = P.conv_a + (size_t)layer * 3 * 512 + lane * 8;
  float w0[8], w1[8], w2[8];
#pragma unroll
  for (int e = 0; e < 8; ++e) { w0[e] = cw[e]; w1[e] = cw[512 + e]; w2[e] = cw[1024 + e]; }
  for (int it = gw; it < nitems; it += nw) {
    const int tk0 = it * 8;
    int t0, L;
    if (tk0 < T_LAT) { t0 = tk0 & 2047; L = SEQ; } else { t0 = (tk0 - T_LAT) & 255; L = CTXL; }
    float up[8], uc[8], un[8];
    auto load_u = [&](int dt, float (&dst)[8]) {
      const int t = t0 + dt;
      if (t < 0 || t >= L) {
#pragma unroll
        for (int e = 0; e < 8; ++e) dst[e] = 0.f;
      } else {
        const h16* rp = pa + (size_t)(tk0 + dt) * 2048 + lane * 8;
        const half8 xa = *(const half8*)rp, ca = *(const half8*)(rp + 1024);
#pragma unroll
        for (int e = 0; e < 8; ++e) dst[e] = (float)xa[e] * (float)ca[e];
      }
    };
    load_u(-1, up);
    load_u(0, uc);
#pragma unroll 1
    for (int dt = 0; dt < 8; ++dt) {
      load_u(dt + 1, un);
      const h16* rp = pa + (size_t)(tk0 + dt) * 2048 + lane * 8;
      const half8 ba = *(const half8*)(rp + 512), za = *(const half8*)(rp + 1536);
      half8 o;
#pragma unroll
      for (int e = 0; e < 8; ++e) o[e] = (h16)((float)ba[e] * (w0[e] * up[e] + w1[e] * uc[e] + w2[e] * un[e]) * (float)za[e]);
      *(half8*)(ya + (size_t)(tk0 + dt) * 512 + lane * 8) = o;
#pragma unroll
      for (int e = 0; e < 8; ++e) { up[e] = uc[e]; uc[e] = un[e]; }
    }
  }
}

DI void phase_merge(const Params& P, int layer, char* smem) {
  const bool last = layer == DEPTH - 1;
  const int n_mt = (last ? T_LAT : T_ALL) / 128;
  const int total = n_mt * 4;
  const h16* hb = (const h16*)(P.ws + WS_H16);
  const h16* winT = (const h16*)(P.ws + WS_WINT);
  const h16* wbrT = (const h16*)(P.ws + WS_WBRT);
  h16* mg = (h16*)(P.ws + WS_R1);
  const int tid = otid(), lane = tid & 63, w = tid >> 6, wr = w >> 2, wc = w & 3, r32 = lane & 31, hh = lane >> 5;
  for (int item = blockIdx.x; item < total; item += gridDim.x) {
    const int mt = item >> 2, nt = item & 3;
    f32x16 macc[2][2];
    zero_acc<2>(macc);
#pragma unroll 1
    for (int n = 0; n < 3; ++n) {
      const h16* yn = (const h16*)(P.ws + (n == 0 ? WS_R2 : (n == 1 ? WS_YB : WS_Q)));
      f32x16 pa2[2][2];
      half8 gpk[2][2][2];
      zero_acc<2>(pa2);
      gemm_kloop<2, true>(pa2, hb + (size_t)mt * 128 * D, D, winT + (size_t)(G_OFF + n * 1024 + nt * 256) * D, D, D, smem);
#pragma unroll
      for (int mb = 0; mb < 2; ++mb)
#pragma unroll
        for (int nb = 0; nb < 2; ++nb)
#pragma unroll
          for (int v = 0; v < 16; ++v) gpk[mb][nb][v >> 3][v & 7] = (h16)sigmoid_f(pa2[mb][nb][v]);
      zero_acc<2>(pa2);
      gemm_kloop<2, true>(pa2, yn + (size_t)mt * 128 * WB, WB, wbrT + (size_t)(n * 1024 + nt * 256) * WB, WB, WB, smem);
#pragma unroll
      for (int mb = 0; mb < 2; ++mb)
#pragma unroll
        for (int nb = 0; nb < 2; ++nb)
#pragma unroll
          for (int v = 0; v < 16; ++v) macc[mb][nb][v] += (float)gpk[mb][nb][v >> 3][v & 7] * pa2[mb][nb][v];
    }
#pragma unroll
    for (int mb = 0; mb < 2; ++mb) {
      const size_t row = (size_t)mt * 128 + wr * 64 + mb * 32 + r32;
#pragma unroll
      for (int nb = 0; nb < 2; ++nb)
#pragma unroll
        for (int g = 0; g < 4; ++g)
          *(half4*)(mg + row * D + nt * 256 + wc * 64 + nb * 32 + 8 * g + 4 * hh) =
              cvt4(macc[mb][nb][4 * g], macc[mb][nb][4 * g + 1], macc[mb][nb][4 * g + 2], macc[mb][nb][4 * g + 3]);
    }
  }
}

DI void phase_out(const Params& P, int layer, char* smem) {
  const bool last = layer == DEPTH - 1;
  const int n_mt = (last ? T_LAT : T_ALL) / 128;
  const int total = n_mt * 4;
  const h16* mg = (const h16*)(P.ws + WS_R1);
  const h16* woutT = (const h16*)(P.ws + WS_WOUTT);
  const float* mods = (const float*)(P.ws + WS_MODS) + (size_t)layer * 17 * 3072;
  float* ctxw = (float*)(P.ws + WS_CTXW);
  const int tid = otid(), lane = tid & 63, w = tid >> 6, wr = w >> 2, wc = w & 3, r32 = lane & 31, hh = lane >> 5;
  for (int item = blockIdx.x; item < total; item += gridDim.x) {
    const int mt = item >> 2, nt = item & 3;
    f32x16 acc[2][2];
    zero_acc<2>(acc);
    gemm_kloop<2, true>(acc, mg + (size_t)mt * 128 * D, D, woutT + (size_t)(nt * 256) * D, D, D, smem);
#pragma unroll
    for (int mb = 0; mb < 2; ++mb) {
      const int row = mt * 128 + wr * 64 + mb * 32 + r32;
      const float* src; float* dst; int b;
      if (row < T_LAT) { b = row >> 11; src = (layer == 0 ? P.x : P.out) + (size_t)row * D; dst = P.out + (size_t)row * D; }
      else { const int rc = row - T_LAT; b = 16; src = (layer == 0 ? P.ctx : ctxw) + (size_t)rc * D; dst = ctxw + (size_t)rc * D; }
      const float* gt = mods + b * 3072 + 2048;
#pragma unroll
      for (int nb = 0; nb < 2; ++nb)
#pragma unroll
        for (int g = 0; g < 4; ++g) {
          const int col = nt * 256 + wc * 64 + nb * 32 + 8 * g + 4 * hh;
          const float4 xo = *(const float4*)(src + col);
          const float4 gv = *(const float4*)(gt + col);
          float4 r;
          r.x = xo.x + gv.x * acc[mb][nb][4 * g]; r.y = xo.y + gv.y * acc[mb][nb][4 * g + 1];
          r.z = xo.z + gv.z * acc[mb][nb][4 * g + 2]; r.w = xo.w + gv.w * acc[mb][nb][4 * g + 3];
          *(float4*)(dst + col) = r;
        }
    }
  }
}

__global__ void __launch_bounds__(512) mega_kernel(Params P) {
  extern __shared__ __attribute__((aligned(16))) char smem[];
  for (int ph = P.ph_lo; ph < P.ph_hi; ++ph) {
    if (ph == 0) phase_prep(P, smem);
    else {
      const int layer = (ph - 1) / NPH_LAYER, k = (ph - 1) % NPH_LAYER;
      switch (k) {
        case 0: phase_norm(P, layer, smem); break;
        case 1: phase_gemm_h(P, layer, smem); break;
        case 2: phase_shortconv(P, layer, smem); break;
        case 3: phase_toeplitz<0>(P, layer, smem); break;
        case 4: phase_toeplitz<1>(P, layer, smem); break;
        case 5: phase_gemm_aq(P, layer, smem); break;
        case 6: phase_attn(P, layer, smem); break;
        case 7: phase_merge(P, layer, smem); break;
        default: phase_out(P, layer, smem); break;
      }
    }
    if (ph + 1 < P.ph_hi) cg::this_grid().sync();
  }
}

extern "C" void kernel_launch(void* const* d_in, const int* in_sizes, int n_in, void* d_out, int out_size, void* d_ws, size_t ws_size,
                              hipStream_t stream) {
  static int grid = 0;
  if (grid == 0) {
    int dev = 0, cus = 0, per_cu = 0;
    hipGetDevice(&dev);
    hipDeviceGetAttribute(&cus, hipDeviceAttributeMultiprocessorCount, dev);
    if (hipFuncSetAttribute((const void*)mega_kernel, hipFuncAttributeMaxDynamicSharedMemorySize, LDS_BYTES) != hipSuccess) {
      fprintf(stderr, "hipFuncSetAttribute failed\n");
      grid = -1;
      return;
    }
    hipOccupancyMaxActiveBlocksPerMultiprocessor(&per_cu, (const void*)mega_kernel, 512, LDS_BYTES);
    if (per_cu < 1) per_cu = 1;
    grid = cus * per_cu;
    if (ws_size < WS_END || n_in != 22) { fprintf(stderr, "workspace too small: %zu < %zu\n", ws_size, (size_t)WS_END); grid = -1; }
  }
  if (grid < 0) return;
  Params p{};
  const float** f = (const float**)&p;
  for (int i = 0; i < 22; ++i) f[i] = (const float*)d_in[i];
  p.out = (float*)d_out;
  p.ws = (char*)d_ws;
#if PER_PHASE_LAUNCH
  for (int ph = 0; ph < NPHASES; ++ph) {
    p.ph_lo = ph; p.ph_hi = ph + 1;
    hipLaunchKernelGGL(mega_kernel, dim3(grid), dim3(512), LDS_BYTES, stream, p);
  }
#else
  p.ph_lo = 0; p.ph_hi = NPHASES;
  void* args[] = {&p};
  hipError_t e = hipLaunchCooperativeKernel((const void*)mega_kernel, dim3(grid), dim3(512), args, LDS_BYTES, stream);
  if (e != hipSuccess) fprintf(stderr, "cooperative launch failed: %s (grid %d)\n", hipGetErrorString(e), grid);
#endif
}
```

```cpp
#include <hip/hip_runtime.h>
#include <hip/hip_cooperative_groups.h>
#include <cstdio>
namespace cg = cooperative_groups;

#ifndef PER_PHASE_LAUNCH
#define PER_PHASE_LAUNCH 0
#endif

typedef _Float16 h16;
typedef _Float16 half8 __attribute__((ext_vector_type(8)));
typedef _Float16 half4 __attribute__((ext_vector_type(4)));
typedef float f32x16 __attribute__((ext_vector_type(16)));
typedef float f32x4 __attribute__((ext_vector_type(4)));
typedef unsigned u32x4 __attribute__((ext_vector_type(4)));
#define DI __device__ __forceinline__

constexpr int D = 1024, NBATCH = 16, SEQ = 2048, CTXL = 256, DEPTH = 4, WB = 512;
constexpr int T_LAT = NBATCH * SEQ, T_CTX = NBATCH * CTXL, T_ALL = T_LAT + T_CTX;
constexpr int IN_COLS = 8448, H_OFF = 2048, C_OFF = 4096, K_OFF = 4608, Z_OFF = 4864, G_OFF = 5376;
constexpr int SKV = CTXL + SEQ;
constexpr int KLEN_L = 2 * SEQ + 256, KOFF_L = SEQ + 64;
constexpr int KLEN_C = 2 * CTXL + 256, KOFF_C = CTXL + 64;
constexpr int LDH = 1088, LDY = 576;
constexpr int NPH_LAYER = 9;
constexpr int NPHASES = 1 + DEPTH * NPH_LAYER;
constexpr int LDS_BYTES = 3 * 49152;

constexpr size_t al(size_t x) { return (x + 255) & ~size_t(255); }
constexpr size_t WS_CTXW = 0;
constexpr size_t WS_MODS = WS_CTXW + al((size_t)T_CTX * D * 4);
constexpr size_t WS_ROPE = WS_MODS + al((size_t)DEPTH * 17 * 3072 * 4);
constexpr size_t WS_WINT = WS_ROPE + al((size_t)SEQ * 32 * 8);
constexpr size_t WS_WBRT = WS_WINT + al((size_t)IN_COLS * LDH * 2);
constexpr size_t WS_WOUTT = WS_WBRT + al((size_t)3 * D * LDY * 2);
constexpr size_t WS_H2 = WS_WOUTT + al((size_t)D * LDH * 2);
constexpr size_t WS_KRL = WS_H2 + al((size_t)(SEQ + CTXL) * 64 * 4);
constexpr size_t WS_KRC = WS_KRL + al((size_t)2 * WB * KLEN_L * 2);
constexpr size_t WS_INVS = WS_KRC + al((size_t)2 * WB * KLEN_C * 2);
constexpr size_t WS_H16 = WS_INVS + al((size_t)2 * 2 * WB * 4);
constexpr size_t WS_R1 = WS_H16 + al((size_t)T_ALL * LDH * 2);
constexpr size_t WS_R2 = WS_R1 + al((size_t)T_ALL * 2048 * 2);
constexpr size_t WS_YB = WS_R2 + al((size_t)T_ALL * LDY * 2);
constexpr size_t WS_Q = WS_YB + al((size_t)T_ALL * LDY * 2);
constexpr size_t WS_K = WS_Q + al((size_t)T_ALL * WB * 2);
constexpr size_t WS_VT = WS_K + al((size_t)NBATCH * 2 * SKV * 64 * 2);
constexpr size_t WS_ZS = WS_VT + al((size_t)NBATCH * 2 * SKV * 64 * 2);
constexpr size_t WS_YC = WS_ZS + al((size_t)T_ALL * WB * 2);
constexpr size_t WS_BAR = WS_YC + al((size_t)T_ALL * LDY * 2);
constexpr size_t WS_W1 = WS_BAR + 16384;
constexpr size_t WS_END = WS_W1 + (WS_H2 - WS_WINT);
constexpr size_t OFF_WBRT = WS_WBRT - WS_WINT, OFF_WOUTT = WS_WOUTT - WS_WINT;
constexpr size_t HTC_OFF = (size_t)NBATCH * 2048 * SEQ;
constexpr size_t Z1C_OFF = (size_t)NBATCH * WB * SEQ;

struct Params {
  const float *x, *c, *ctx, *c_ctx, *norm_g, *w_mod, *b_mod, *w_in, *conv_a, *conv_h, *fw1, *fb1, *fw2, *fb2, *fw3, *fb3,
      *ffreq, *hbias, *qg, *kg, *w_branch, *w_out;
  float* out;
  char* ws;
  int ph_lo, ph_hi;
};

DI size_t wbase(int layer) { return (layer & 1) ? WS_W1 : WS_WINT; }
DI float silu_f(float x) { return x / (1.f + __expf(-x)); }
DI float sigmoid_f(float x) { return 1.f / (1.f + __expf(-x)); }
DI half4 cvt4(float a, float b, float c, float d) { half4 r; r[0] = (h16)a; r[1] = (h16)b; r[2] = (h16)c; r[3] = (h16)d; return r; }
DI void wait_vm0() { asm volatile("s_waitcnt vmcnt(0)" ::: "memory"); }
DI int otid() { int t = threadIdx.x; asm volatile("" : "+v"(t)); return t; }

template <int MB, bool SWAP>
DI void gemm_kloop(f32x16 (&acc)[MB][2], const h16* __restrict__ A, int lda, const h16* __restrict__ B, int ldb, int K, char* lds) {
  constexpr int A_BYTES = 64 * MB * 128, B_BYTES = 256 * 128, STAGE = A_BYTES + B_BYTES;
  static_assert(3 * STAGE <= LDS_BYTES, "ring does not fit");
  const int tid = otid(), w = tid >> 6, lane = tid & 63;
  const int wr = w >> 2, wc = w & 3;
  const int lrow = w * 8 + (lane >> 3), pch = lane & 7;
  const int gch = pch ^ ((lrow >> 1) & 7);
  const unsigned voa = (unsigned)(lrow * lda + gch * 8) * 2u, vob = (unsigned)(lrow * ldb + gch * 8) * 2u;
  const int lofs = lrow * 128 + pch * 16;
  const int r32 = lane & 31, hh = lane >> 5, sw = (r32 >> 1) & 7;
  const int a_rd = (wr * 32 * MB + r32) * 128;
  const int b_rd = A_BYTES + (wc * 64 + r32) * 128;
  const int nk = K >> 6;
  constexpr int NP = MB + 4;
  auto piece = [&](int p, int kt, int buf) {
    char* s = lds + buf * STAGE;
    if (p < MB) __builtin_amdgcn_global_load_lds((const unsigned*)((const char*)(A + (size_t)p * 64 * lda + kt * 64) + voa), (unsigned*)(s + p * 8192 + lofs), 16, 0, 0);
    else __builtin_amdgcn_global_load_lds((const unsigned*)((const char*)(B + (size_t)(p - MB) * 64 * ldb + kt * 64) + vob), (unsigned*)(s + A_BYTES + (p - MB) * 8192 + lofs), 16, 0, 0);
  };
  wait_vm0();
#pragma unroll
  for (int p = 0; p < NP; ++p) piece(p, 0, 0);
#pragma unroll
  for (int p = 0; p < NP; ++p) piece(p, 1, 1);
  int cur = 0;
  for (int kt = 0; kt < nk; ++kt) {
    if (kt + 1 < nk) { if (MB == 2) asm volatile("s_waitcnt vmcnt(6)" ::: "memory"); else asm volatile("s_waitcnt vmcnt(5)" ::: "memory"); }
    else wait_vm0();
    __syncthreads();
    const char* s = lds + cur * STAGE;
    const int nbuf = cur == 0 ? 2 : cur - 1;
    const bool more = kt + 2 < nk;
    half8 af[2][MB], bf[2][2];
#pragma unroll
    for (int mb = 0; mb < MB; ++mb) af[0][mb] = *(const half8*)(s + a_rd + mb * 4096 + (((0 + hh) ^ sw) * 16));
#pragma unroll
    for (int nb = 0; nb < 2; ++nb) bf[0][nb] = *(const half8*)(s + b_rd + nb * 4096 + (((0 + hh) ^ sw) * 16));
#pragma unroll
    for (int ks = 0; ks < 4; ++ks) {
      if (ks < 3) {
#pragma unroll
        for (int mb = 0; mb < MB; ++mb) af[(ks + 1) & 1][mb] = *(const half8*)(s + a_rd + mb * 4096 + (((2 * (ks + 1) + hh) ^ sw) * 16));
#pragma unroll
        for (int nb = 0; nb < 2; ++nb) bf[(ks + 1) & 1][nb] = *(const half8*)(s + b_rd + nb * 4096 + (((2 * (ks + 1) + hh) ^ sw) * 16));
      }
      if (more) {
        if (2 * ks < NP) piece(2 * ks, kt + 2, nbuf);
        if (2 * ks + 1 < NP) piece(2 * ks + 1, kt + 2, nbuf);
      }
      __builtin_amdgcn_sched_barrier(0);
      __builtin_amdgcn_s_setprio(1);
#pragma unroll
      for (int mb = 0; mb < MB; ++mb)
#pragma unroll
        for (int nb = 0; nb < 2; ++nb)
          acc[mb][nb] = SWAP ? __builtin_amdgcn_mfma_f32_32x32x16_f16(bf[ks & 1][nb], af[ks & 1][mb], acc[mb][nb], 0, 0, 0)
                             : __builtin_amdgcn_mfma_f32_32x32x16_f16(af[ks & 1][mb], bf[ks & 1][nb], acc[mb][nb], 0, 0, 0);
      __builtin_amdgcn_s_setprio(0);
      __builtin_amdgcn_sched_barrier(0);
    }
    cur = cur == 2 ? 0 : cur + 1;
  }
  __syncthreads();
}

DI int lds_byte16(int r, int c) { const int st = (r >> 4) * 2 + (c >> 5), rr = r & 15, cc = c & 31, ob = rr * 64 + cc * 2; return st * 1024 + (ob ^ (((ob >> 9) & 1) << 5)); }
DI void stage_rc16(int b, int& R, int& C) { const int st = b / 1024, sb = b % 1024, swz = sb ^ (((sb >> 9) & 1) << 5); R = (st >> 1) * 16 + swz / 64; C = (st & 1) * 32 + (swz % 64) / 2; }
struct Unit2 { int pm, pn; };
template <bool HEADPERM, class Sched, class Epi>
DI void gemm256_stream(char* lds, const h16* __restrict__ Ab, int lda, const h16* __restrict__ Bb, int ldb, int K, const Sched& S, const Epi& E) {
  constexpr int HTB = 128 * 64 * 2;
  const int tid = otid(), wid = __builtin_amdgcn_readfirstlane(tid >> 6), lane = tid & 63, wr = wid >> 2, wc = wid & 3, fr = lane & 15, fq = lane >> 4;
  const int nt = K / 64;
  unsigned voffA[2], voffB0[2], voffB1[2];
#pragma unroll
  for (int i = 0; i < 2; ++i) {
    int R, C;
    stage_rc16(tid * 16 + i * 8192, R, C);
    voffA[i] = (unsigned)(R * lda + C) * 2u;
    if (HEADPERM) {
      const int rb = (R >> 5) * 64 + (R & 31);
      voffB0[i] = (unsigned)(rb * ldb + C) * 2u;
      voffB1[i] = (unsigned)((rb + 32) * ldb + C) * 2u;
    } else {
      const int rho = R & 31, rp = (R & ~31) + 8 * ((rho & 15) >> 2) + 4 * (rho >> 4) + (rho & 3);
      voffB0[i] = (unsigned)(rp * ldb + C) * 2u;
      voffB1[i] = (unsigned)((rp + 128) * ldb + C) * 2u;
    }
  }
  const size_t kstep = 128;
  const size_t hstepA = (size_t)128 * lda * 2;
  const size_t tstepA = 2 * hstepA, tstepB = (size_t)256 * ldb * 2;
  const unsigned ldsw = (unsigned)wid * 1024u;
  const int aoff = lds_byte16(wr * 64 + fr, fq * 8), boff = lds_byte16(wc * 32 + fr, fq * 8);
#define G8_SA(b, h) (((b) * 2 + (h)) * HTB)
#define G8_SB(b, h) ((4 + (b) * 2 + (h)) * HTB)
#define G8_STAGE(bufoff, gbase, voff) do { _Pragma("unroll") for (int _i = 0; _i < 2; ++_i) \
    __builtin_amdgcn_global_load_lds((const unsigned*)((const char*)(gbase) + (voff)[_i]), (unsigned*)(lds + (bufoff) + ldsw + _i * 8192 + lane * 16), 16, 0, 0); } while (0)
#define G8_LDA(dst, b, h) do { _Pragma("unroll") for (int m = 0; m < 4; ++m) _Pragma("unroll") for (int k = 0; k < 2; ++k) dst[m][k] = *(const half8*)(lds + G8_SA(b, h) + aoff + m * 2048 + k * 1024); } while (0)
#define G8_LDB(dst, b, h) do { _Pragma("unroll") for (int n = 0; n < 2; ++n) _Pragma("unroll") for (int k = 0; k < 2; ++k) dst[n][k] = *(const half8*)(lds + G8_SB(b, h) + boff + n * 2048 + k * 1024); } while (0)
#define G8_MMA(ai, bj, At, Bt) do { __builtin_amdgcn_s_setprio(1); _Pragma("unroll") for (int m = 0; m < 4; ++m) _Pragma("unroll") for (int n = 0; n < 2; ++n) _Pragma("unroll") for (int k = 0; k < 2; ++k) \
    acc[ai][bj][m][n] = __builtin_amdgcn_mfma_f32_16x16x32_f16(Bt[n][k], At[m][k], acc[ai][bj][m][n], 0, 0, 0); __builtin_amdgcn_s_setprio(0); } while (0)
#define G8_WAIT_V(n) asm volatile("s_waitcnt vmcnt(" #n ")" ::: "memory")
#define G8_WAIT_L(n) asm volatile("s_waitcnt lgkmcnt(" #n ")" ::: "memory")
#define G8_BAR __builtin_amdgcn_s_barrier()
#define G8_SCHED __builtin_amdgcn_sched_barrier(0)
  Unit2 cur, nxt;
  int ui = 0;
  if (!S.next(0, cur)) return;
  f32x4 acc[2][2][4][2];
#pragma unroll
  for (int a = 0; a < 2; ++a)
#pragma unroll
    for (int b = 0; b < 2; ++b)
#pragma unroll
      for (int m = 0; m < 4; ++m)
#pragma unroll
        for (int n = 0; n < 2; ++n) acc[a][b][m][n] = f32x4{0.f, 0.f, 0.f, 0.f};
  half8 At[4][2], B0[2][2], B1[2][2];
  const char* cA = (const char*)Ab + (size_t)cur.pm * tstepA;
  const char* cB = (const char*)Bb + (size_t)cur.pn * tstepB;
  G8_STAGE(G8_SB(0, 0), cB, voffB0); G8_STAGE(G8_SA(0, 0), cA, voffA); G8_STAGE(G8_SB(0, 1), cB, voffB1); G8_STAGE(G8_SA(0, 1), cA + hstepA, voffA);
  if (wr == 1) G8_BAR;
  G8_WAIT_V(4); G8_BAR;
  G8_STAGE(G8_SB(1, 0), cB + kstep, voffB0); G8_STAGE(G8_SA(1, 0), cA + kstep, voffA); G8_STAGE(G8_SB(1, 1), cB + kstep, voffB1);
  G8_WAIT_V(6); G8_BAR;
  for (;;) {
    const bool has_next = S.next(ui + 1, nxt);
    const char* nA = has_next ? (const char*)Ab + (size_t)nxt.pm * tstepA : cA;
    const char* nB = has_next ? (const char*)Bb + (size_t)nxt.pn * tstepB : cB;
    for (int t = 0; t < nt; t += 2) {
      const bool lastk = (t == nt - 2);
      const char* a1 = cA + (size_t)(t + 1) * kstep;
      const char* a2 = lastk ? nA : cA + (size_t)(t + 2) * kstep;
      const char* b2 = lastk ? nB : cB + (size_t)(t + 2) * kstep;
      const char* a3 = a2 + kstep;
      const char* b3 = b2 + kstep;
      G8_LDB(B0, 0, 0); G8_SCHED; G8_LDA(At, 0, 0); G8_STAGE(G8_SA(1, 1), a1 + hstepA, voffA);
      G8_WAIT_L(8); G8_BAR; G8_WAIT_L(0); G8_MMA(0, 0, At, B0); G8_BAR; G8_SCHED;
      G8_LDB(B1, 0, 1); G8_STAGE(G8_SB(0, 0), b2, voffB0);
      G8_BAR; G8_WAIT_L(0); G8_MMA(0, 1, At, B1); G8_BAR;
      G8_LDA(At, 0, 1); G8_STAGE(G8_SA(0, 0), a2, voffA);
      G8_BAR; G8_WAIT_L(0); G8_MMA(1, 0, At, B0); G8_BAR; G8_SCHED;
      G8_STAGE(G8_SB(0, 1), b2, voffB1);
      G8_WAIT_V(6); G8_BAR; G8_MMA(1, 1, At, B1); G8_BAR;
      G8_LDB(B0, 1, 0); G8_SCHED; G8_LDA(At, 1, 0); G8_STAGE(G8_SA(0, 1), a2 + hstepA, voffA);
      G8_WAIT_L(8); G8_BAR; G8_WAIT_L(0); G8_MMA(0, 0, At, B0); G8_BAR; G8_SCHED;
      G8_LDB(B1, 1, 1); G8_STAGE(G8_SB(1, 0), b3, voffB0);
      G8_BAR; G8_WAIT_L(0); G8_MMA(0, 1, At, B1); G8_BAR;
      G8_LDA(At, 1, 1); G8_STAGE(G8_SA(1, 0), a3, voffA);
      G8_BAR; G8_WAIT_L(0); G8_MMA(1, 0, At, B0); G8_BAR; G8_SCHED;
      G8_STAGE(G8_SB(1, 1), b3, voffB1);
      G8_WAIT_V(6); G8_BAR; G8_MMA(1, 1, At, B1); G8_BAR;
    }
    E(acc, cur, wr, wc, fr, fq);
    if (!has_next) break;
#pragma unroll
    for (int a = 0; a < 2; ++a)
#pragma unroll
      for (int b = 0; b < 2; ++b)
#pragma unroll
        for (int m = 0; m < 4; ++m)
#pragma unroll
          for (int n = 0; n < 2; ++n) acc[a][b][m][n] = f32x4{0.f, 0.f, 0.f, 0.f};
    cur = nxt; cA = nA; cB = nB; ++ui;
  }
  G8_WAIT_V(0);
  if (wr == 0) G8_BAR;
  G8_BAR;
#undef G8_SA
#undef G8_SB
#undef G8_STAGE
#undef G8_LDA
#undef G8_LDB
#undef G8_MMA
#undef G8_WAIT_V
#undef G8_WAIT_L
#undef G8_BAR
#undef G8_SCHED
}
struct XcdSched {
  int total, per, nxb, xcd, j;
  DI void init(int total_) { total = total_; const int G = gridDim.x; if (G & 7) { per = total; nxb = G; xcd = 0; j = blockIdx.x; } else { per = (total + 7) >> 3; nxb = G >> 3; xcd = blockIdx.x & 7; j = blockIdx.x >> 3; } }
  DI int item(int i) const { const int li = j + i * nxb; if (li >= per) return -1; const int lin = xcd * per + li; return lin < total ? lin : -1; }
};

template <class F>
DI void for_items_xcd(int total, F f) {
  const int G = gridDim.x;
  if (G & 7) { for (int it = blockIdx.x; it < total; it += G) f(it); return; }
  const int nxb = G >> 3, xcd = blockIdx.x & 7, j = blockIdx.x >> 3, per = (total + 7) >> 3;
  for (int i = j; i < per; i += nxb) { const int lin = xcd * per + i; if (lin < total) f(lin); }
}

template <int MB>
DI void zero_acc(f32x16 (&acc)[MB][2]) {
#pragma unroll
  for (int mb = 0; mb < MB; ++mb)
#pragma unroll
    for (int nb = 0; nb < 2; ++nb)
#pragma unroll
      for (int v = 0; v < 16; ++v) acc[mb][nb][v] = 0.f;
}

DI void phase_prep(const Params& P, char* smem) {
  const int tid = otid();
  float* mods = (float*)(P.ws + WS_MODS);
  float2* rope = (float2*)(P.ws + WS_ROPE);
  for (int task = blockIdx.x; task < 208; task += gridDim.x) {
    if (task < 192) {
      const int layer = task / 48, n0 = (task % 48) * 64;
      float* s = (float*)smem;
      float* red = s + 17 * 1024;
      for (int i = tid; i < 17 * 1024; i += 512) {
        const int r = i >> 10, k = i & 1023;
        const float v = (r < 16) ? P.c[r * 1024 + k] : P.c_ctx[k];
        s[i] = silu_f(v);
      }
      __syncthreads();
      const int nl = tid & 63, ks = tid >> 6;
      float acc[17];
#pragma unroll
      for (int r = 0; r < 17; ++r) acc[r] = 0.f;
      const float* wp = P.w_mod + ((size_t)layer * 1024 + ks * 128) * 3072 + n0 + nl;
      for (int k = 0; k < 128; ++k) {
        const float wv = wp[(size_t)k * 3072];
#pragma unroll
        for (int r = 0; r < 17; ++r) acc[r] += s[r * 1024 + ks * 128 + k] * wv;
      }
#pragma unroll
      for (int r = 0; r < 17; ++r) red[(ks * 17 + r) * 64 + nl] = acc[r];
      __syncthreads();
      for (int o = tid; o < 17 * 64; o += 512) {
        const int r = o >> 6, n = o & 63;
        float v = P.b_mod[layer * 3072 + n0 + n];
#pragma unroll
        for (int k2 = 0; k2 < 8; ++k2) v += red[(k2 * 17 + r) * 64 + n];
        mods[(layer * 17 + r) * 3072 + n0 + n] = v;
      }
      __syncthreads();
    } else {
      const int base = ((task - 192) * 512 + tid) * 8;
#pragma unroll 1
      for (int e = 0; e < 8; ++e) {
        const int ent = base + e;
        const int t = ent >> 5, a = (ent >> 4) & 1, f = ent & 15;
        const float pos = (float)(a ? (t & 63) : (t >> 6));
        const float inv = powf(10000.f, -(float)f / 16.f);
        float sn, cs;
        sincosf(pos * inv, &sn, &cs);
        rope[ent] = make_float2(cs, sn);
      }
    }
  }
}

DI void cvt_tile(const float* __restrict__ src, int ldn, h16* __restrict__ dst, int ldk, int k0, int n0, float* t) {
  const int tid = otid();
  {
    const int r = tid >> 4, c4 = tid & 15;
#pragma unroll
    for (int i = 0; i < 2; ++i) {
      const int k = r + 32 * i;
      const float4 v = *(const float4*)(src + (size_t)(k0 + k) * ldn + n0 + c4 * 4);
      t[k * 65 + c4 * 4 + 0] = v.x; t[k * 65 + c4 * 4 + 1] = v.y; t[k * 65 + c4 * 4 + 2] = v.z; t[k * 65 + c4 * 4 + 3] = v.w;
    }
  }
  __syncthreads();
  {
    const int n = tid >> 3, kc = tid & 7;
    half8 o;
#pragma unroll
    for (int j = 0; j < 8; ++j) o[j] = (h16)t[(kc * 8 + j) * 65 + n];
    *(half8*)(dst + (size_t)(n0 + n) * ldk + k0 + kc * 8) = o;
  }
  __syncthreads();
}

DI void cvt_layer_weights(const Params& P, int layer, int t0, int step, char* smem) {
  h16* winT = (h16*)(P.ws + wbase(layer));
  h16* wbrT = (h16*)(P.ws + wbase(layer) + OFF_WBRT);
  h16* woutT = (h16*)(P.ws + wbase(layer) + OFF_WOUTT);
  for (int t = t0; t < 2112 + 384 + 256; t += step) {
    if (t < 2112) {
      cvt_tile(P.w_in + (size_t)layer * D * IN_COLS, IN_COLS, winT, LDH, (t & 15) * 64, (t >> 4) * 64, (float*)smem);
    } else if (t < 2112 + 384) {
      const int u = t - 2112, br = u >> 7, v = u & 127;
      cvt_tile(P.w_branch + ((size_t)layer * 3 + br) * WB * D, D, wbrT + (size_t)br * D * LDY, LDY, (v & 7) * 64, (v >> 3) * 64, (float*)smem);
    } else {
      const int u = t - 2112 - 384;
      cvt_tile(P.w_out + (size_t)layer * D * D, D, woutT, LDH, (u & 15) * 64, (u >> 4) * 64, (float*)smem);
    }
  }
}

DI void phase_norm(const Params& P, int layer, char* smem) {
  const int tid = otid(), w = tid >> 6, lane = tid & 63;
  if (layer == 0) cvt_layer_weights(P, 0, blockIdx.x, gridDim.x, smem);
  const int gw = blockIdx.x * 8 + w, nw = gridDim.x * 8;
  const float* mods = (const float*)(P.ws + WS_MODS) + (size_t)layer * 17 * 3072;
  const float* ng = P.norm_g + layer * D;
  h16* hb = (h16*)(P.ws + WS_H16);
  for (int row = gw; row < T_ALL; row += nw) {
    const float* src;
    int b;
    if (row < T_LAT) { src = (layer == 0 ? P.x : P.out) + (size_t)row * D; b = row >> 11; }
    else { const int rc = row - T_LAT; src = (layer == 0 ? P.ctx : (const float*)(P.ws + WS_CTXW)) + (size_t)rc * D; b = 16; }
    const float* md = mods + b * 3072;
    float4 xv[4];
    float ss = 0.f;
#pragma unroll
    for (int j = 0; j < 4; ++j) {
      xv[j] = *(const float4*)(src + j * 256 + lane * 4);
      ss += xv[j].x * xv[j].x + xv[j].y * xv[j].y + xv[j].z * xv[j].z + xv[j].w * xv[j].w;
    }
#pragma unroll
    for (int m = 32; m >= 1; m >>= 1) ss += __shfl_xor(ss, m);
    const float rstd = rsqrtf(ss * (1.f / 1024.f) + 1e-6f);
#pragma unroll
    for (int j = 0; j < 4; ++j) {
      const int k = j * 256 + lane * 4;
      const float4 g = *(const float4*)(ng + k);
      const float4 sh = *(const float4*)(md + k);
      const float4 sc = *(const float4*)(md + 1024 + k);
      *(half4*)(hb + (size_t)row * LDH + k) = cvt4(xv[j].x * rstd * g.x * (1.f + sc.x) + sh.x, xv[j].y * rstd * g.y * (1.f + sc.y) + sh.y,
                                                  xv[j].z * rstd * g.z * (1.f + sc.z) + sh.z, xv[j].w * rstd * g.w * (1.f + sc.w) + sh.w);
    }
  }
  float* h2 = (float*)(P.ws + WS_H2);
  const float* w1 = P.fw1 + layer * 33 * 64;
  const float* w2 = P.fw2 + layer * 64 * 64;
  const float f0 = P.ffreq[layer * 128 + lane], f1 = P.ffreq[layer * 128 + 64 + lane];
  const float b1 = P.fb1[layer * 64 + lane], b2 = P.fb2[layer * 64 + lane];
  for (int p = gw; p < SEQ + CTXL; p += nw) {
    const int L = p >= SEQ ? CTXL : SEQ, tau = p >= SEQ ? p - SEQ : p;
    const float tt = (float)tau / (float)(L - 1);
    const float wv = (6.283185307179586f / (float)L) * (float)tau;
    float feat = 0.f;
    if (lane == 0) feat = tt;
    else if (lane <= 16) feat = cosf(wv * (1e-4f + (float)(lane - 1) * ((15.f - 1e-4f) / 15.f)));
    else if (lane <= 32) feat = sinf(wv * (1e-4f + (float)(lane - 17) * ((15.f - 1e-4f) / 15.f)));
    float a1 = b1;
    for (int e = 0; e < 33; ++e) a1 += __shfl(feat, e) * w1[e * 64 + lane];
    const float h1 = sinf(f0 * a1);
    float a2 = b2;
    for (int k = 0; k < 64; ++k) a2 += __shfl(h1, k) * w2[k * 64 + lane];
    h2[(size_t)p * 64 + lane] = sinf(f1 * a2);
  }
}

DI void filt2_task(const Params& P, int layer, int set, int o, int cg16, char* smem) {
  const int tid = otid();
  const int L = set ? CTXL : SEQ, KLEN = set ? KLEN_C : KLEN_L, OFF = set ? KOFF_C : KOFF_L;
  h16* krb = (h16*)(P.ws + (set ? WS_KRC : WS_KRL));
  const float* h2 = (const float*)(P.ws + WS_H2) + (set ? (size_t)SEQ * 64 : 0);
  float* invS = (float*)(P.ws + WS_INVS);
  const int c0 = cg16 * 16;
  float* w3s = (float*)smem;
  float* part = w3s + 2048;
  for (int i = tid; i < 2048; i += 512) {
    const int k = i >> 5, d = (i >> 4) & 1, cc = i & 15;
    w3s[i] = P.fw3[((size_t)layer * 64 + k) * 2048 + (o * 2 + d) * 512 + c0 + cc];
  }
  __syncthreads();
  const int cc = tid & 15, sl = tid >> 4, c = c0 + cc;
  const float b30 = P.fb3[layer * 2048 + (o * 2 + 0) * 512 + c], b31 = P.fb3[layer * 2048 + (o * 2 + 1) * 512 + c];
  const float MIN_DECAY = -3.0701134573253940f, MAX_DECAY = -15.350567286626974f;
  const float delta = fabsf(MIN_DECAY + (float)c * ((MAX_DECAY - MIN_DECAY) / 511.f));
  h16* kr = krb + (size_t)(o * 512 + c) * KLEN;
  const int nper = L >> 5;
  float sum = 0.f;
  for (int tau = sl * nper; tau < (sl + 1) * nper; ++tau) {
    const float4* hr = (const float4*)(h2 + (size_t)tau * 64);
    float v0 = b30, v1 = b31;
#pragma unroll
    for (int kc = 0; kc < 16; ++kc) {
      const float4 hv = hr[kc];
      v0 += hv.x * w3s[(kc * 4 + 0) * 32 + cc] + hv.y * w3s[(kc * 4 + 1) * 32 + cc] + hv.z * w3s[(kc * 4 + 2) * 32 + cc] + hv.w * w3s[(kc * 4 + 3) * 32 + cc];
      v1 += hv.x * w3s[(kc * 4 + 0) * 32 + 16 + cc] + hv.y * w3s[(kc * 4 + 1) * 32 + 16 + cc] + hv.z * w3s[(kc * 4 + 2) * 32 + 16 + cc] + hv.w * w3s[(kc * 4 + 3) * 32 + 16 + cc];
    }
    const float tt = (float)tau / (float)(L - 1);
    const float dec = expf(-tt * delta);
    v0 *= dec; v1 *= dec;
    kr[OFF - tau] = (h16)v0;
    sum += fabsf(v0);
    if (tau >= 1) { kr[OFF + tau] = (h16)v1; sum += fabsf(v1); }
  }
  for (int z = sl; z < 257; z += 32) {
    const int idx = z < 65 ? z : (OFF + L + (z - 65));
    kr[idx] = (h16)0.f;
  }
  part[sl * 16 + cc] = sum;
  __syncthreads();
  if (tid < 16) {
    float tot = 0.f;
    for (int s2 = 0; s2 < 32; ++s2) tot += part[s2 * 16 + tid];
    invS[(set * 2 + o) * 512 + c0 + tid] = 1.f / tot;
  }
  __syncthreads();
}

struct SchedH {
  XcdSched xs;
  DI bool next(int i, Unit2& u) const { const int it = xs.item(i); if (it < 0) return false; u.pm = (it & 31) >> 2; u.pn = (it >> 5) * 4 + (it & 3); return true; }
};
struct EpiH {
  h16* hT;
  DI void operator()(const f32x4 (&acc)[2][2][4][2], const Unit2& u, int wr_, int wc_, int fr_, int fq_) const {
    const int tid2 = otid(), wid2 = tid2 >> 6, wr = wid2 >> 2, wc = wid2 & 3, fr = tid2 & 15, fq = (tid2 >> 4) & 3;
    const bool gate = u.pm >= 6;
    const int tok0 = u.pn * 256;
    const bool isctx = tok0 >= T_LAT;
#pragma unroll
    for (int ai = 0; ai < 2; ++ai)
#pragma unroll
      for (int m = 0; m < 4; ++m) {
        const int col = u.pm * 256 + ai * 128 + wr * 64 + m * 16 + fr;
#pragma unroll
        for (int bj = 0; bj < 2; ++bj) {
          const int grow = tok0 + bj * 128 + wc * 32 + 8 * fq;
          half8 o;
#pragma unroll
          for (int n = 0; n < 2; ++n)
#pragma unroll
            for (int v = 0; v < 4; ++v) { float x = acc[ai][bj][m][n][v]; if (gate) x = silu_f(x); o[4 * n + v] = (h16)x; }
          h16* dst;
          if (!isctx) { const int b = grow >> 11, tt = grow & 2047; dst = hT + ((size_t)(b * 2048 + col) * SEQ + tt); }
          else { const int rc = grow - T_LAT, b = rc >> 8, tt = rc & 255; dst = hT + HTC_OFF + ((size_t)(b * 2048 + col) * CTXL + tt); }
          *(half8*)dst = o;
        }
      }
  }
};
DI void phase_gemm_h(const Params& P, int layer, char* smem) {
  const bool last = layer == DEPTH - 1;
  const int n_mt = last ? 128 : 144;
  {
    const int nfilt = last ? 64 : 128;
    const int G = gridDim.x, first = G - (G >> 1);
    for (int item = (int)blockIdx.x - first; item >= 0 && item < nfilt; item += (G >> 1)) {
      const int id = nfilt - 1 - item;
      filt2_task(P, layer, id >> 6, (id & 63) >> 5, id & 31, smem);
    }
  }
  SchedH S; S.xs.init(n_mt * 8);
  EpiH E; E.hT = (h16*)(P.ws + WS_R1);
  gemm256_stream<false>(smem, (const h16*)(P.ws + wbase(layer)) + (size_t)H_OFF * LDH, LDH, (const h16*)(P.ws + WS_H16), LDH, D, S, E);
}

DI void phase_shortconv(const Params& P, int layer, char* smem) {
  const bool last = layer == DEPTH - 1;
  const int tid = otid(), lane = tid & 63, w = tid >> 6;
  const int gw = blockIdx.x * 8 + w, nw = gridDim.x * 8;
  h16* hT = (h16*)(P.ws + WS_R1);
  const float* cw = P.conv_h + (size_t)layer * 3 * 1536;
  const int nrows_l = NBATCH * 1536;
  const int nrows = last ? nrows_l : 2 * nrows_l;
  for (int r = gw; r < nrows; r += nw) {
    if (r < nrows_l) {
      const int b = r / 1536, col = r % 1536;
      const float w0 = cw[col], w1 = cw[1536 + col], w2 = cw[3072 + col];
      h16* p = hT + (size_t)(b * 2048 + col) * SEQ;
      half8 v[4];
#pragma unroll
      for (int j = 0; j < 4; ++j) v[j] = *(const half8*)(p + j * 512 + lane * 8);
      float prev[4], next[4];
#pragma unroll
      for (int j = 0; j < 4; ++j) {
        const float lastv = (float)v[j][7], firstv = (float)v[j][0];
        float pu = __shfl_up(lastv, 1);
        float nd = __shfl_down(firstv, 1);
        prev[j] = pu; next[j] = nd;
      }
#pragma unroll
      for (int j = 0; j < 4; ++j) {
        const float l63 = (j > 0) ? __shfl((float)v[j > 0 ? j - 1 : 0][7], 63) : 0.f;
        const float f0 = (j < 3) ? __shfl((float)v[j < 3 ? j + 1 : 3][0], 0) : 0.f;
        if (lane == 0) prev[j] = l63;
        if (lane == 63) next[j] = f0;
      }
#pragma unroll
      for (int j = 0; j < 4; ++j) {
        half8 o;
#pragma unroll
        for (int e = 0; e < 8; ++e) {
          const float a = e == 0 ? prev[j] : (float)v[j][e > 0 ? e - 1 : 0];
          const float cc = (float)v[j][e];
          const float d = e == 7 ? next[j] : (float)v[j][e < 7 ? e + 1 : 7];
          o[e] = (h16)(w0 * a + w1 * cc + w2 * d);
        }
        *(half8*)(p + j * 512 + lane * 8) = o;
      }
    } else {
      const int r2 = r - nrows_l;
      const int b = r2 / 1536, col = r2 % 1536;
      const float w0 = cw[col], w1 = cw[1536 + col], w2 = cw[3072 + col];
      h16* p = hT + HTC_OFF + (size_t)(b * 2048 + col) * CTXL;
      const half4 v = *(const half4*)(p + lane * 4);
      float prev = __shfl_up((float)v[3], 1), next = __shfl_down((float)v[0], 1);
      if (lane == 0) prev = 0.f;
      if (lane == 63) next = 0.f;
      half4 o;
      o[0] = (h16)(w0 * prev + w1 * (float)v[0] + w2 * (float)v[1]);
      o[1] = (h16)(w0 * (float)v[0] + w1 * (float)v[1] + w2 * (float)v[2]);
      o[2] = (h16)(w0 * (float)v[1] + w1 * (float)v[2] + w2 * (float)v[3]);
      o[3] = (h16)(w0 * (float)v[2] + w1 * (float)v[3] + w2 * next);
      *(half4*)(p + lane * 4) = o;
    }
  }
}

template <int MODE>
DI void toeplitz_task(const Params& P, int layer, int set, int cg, int chunk, char* smem) {
  const int tid = otid(), w = tid >> 6, lane = tid & 63;
  const int L = set ? CTXL : SEQ, KLEN = set ? KLEN_C : KLEN_L, OFF = set ? KOFF_C : KOFF_L;
  const h16* krg = (const h16*)(P.ws + (set ? WS_KRC : WS_KRL)) + (size_t)(MODE * 512 + cg * 8) * KLEN;
  h16* krs = (h16*)smem;
  char* stg = smem + 8 * KLEN_L * 2;
  for (int i = tid; i < KLEN; i += 512) *(half8*)(krs + i * 8) = *(const half8*)(krg + i * 8);
  __syncthreads();
  const int c = cg * 8 + w;
  const int bb = lane & 15, kg = lane >> 4;
  const h16* hT = (const h16*)(P.ws + WS_R1) + (set ? HTC_OFF : 0);
  h16* z1T = (h16*)(P.ws + WS_R2) + (set ? Z1C_OFF : 0);
  const h16* Urow = (MODE == 0) ? hT + (size_t)(bb * 2048 + c) * L : z1T + (size_t)(bb * 512 + c) * L;
  const float invs = ((const float*)(P.ws + WS_INVS))[(set * 2 + MODE) * 512 + c];
  const float bias = P.hbias[(layer * 2 + MODE) * 512 + c];
  const int nsteps = (L >> 5) + 1;
  constexpr int GS = 5;
  const int ngroups = (nsteps + GS - 1) / GS;
  const int npass = set ? 1 : 2;
  const h16* krw = krs + w * KLEN;
  for (int pass = 0; pass < npass; ++pass) {
    const int tb = chunk * 512 + pass * 256;
    f32x4 acc[2][8];
#pragma unroll
    for (int ta = 0; ta < 2; ++ta)
#pragma unroll
      for (int r = 0; r < 8; ++r) acc[ta][r] = f32x4{0.f, 0.f, 0.f, 0.f};
    u32x4 cur[2 * GS], nxt[2 * GS];
    auto load_group = [&](int g, u32x4 (&dst)[2 * GS]) {
#pragma unroll
      for (int q = 0; q < GS; ++q) {
        const int s = -32 + (g * GS + q) * 32 + 8 * kg;
        const int s2 = s + 8;
        const int sc = min(max(s, 0), L - 8), sc2 = min(max(s2, 0), L - 8);
        dst[2 * q] = *(const u32x4*)(Urow + sc);
        dst[2 * q + 1] = *(const u32x4*)(Urow + sc2);
      }
    };
    load_group(0, cur);
    const int abase = OFF - tb - 8 * ((lane & 15) - kg);
    half8 afn0 = *(const half8*)(krw + abase - 32), afn1 = *(const half8*)(krw + abase - 32 - 128);
    for (int g = 0; g < ngroups; ++g) {
      load_group(g + 1 < ngroups ? g + 1 : g, nxt);
      __builtin_amdgcn_sched_barrier(0);
#pragma unroll
      for (int q = 0; q < GS; ++q) {
        const int s0 = -32 + (g * GS + q) * 32;
        const half8 af0 = afn0, af1 = afn1;
        afn0 = *(const half8*)(krw + abase + s0 + 32);
        afn1 = *(const half8*)(krw + abase + s0 + 32 - 128);
        unsigned d[8];
        {
          const int sw0 = s0 + 8 * kg, sw1 = sw0 + 8;
          const bool va = (sw0 >= 0) && (sw0 < L), vb = (sw1 >= 0) && (sw1 < L);
#pragma unroll
          for (int e = 0; e < 4; ++e) { d[e] = va ? cur[2 * q][e] : 0u; d[4 + e] = vb ? cur[2 * q + 1][e] : 0u; }
        }
#pragma unroll
        for (int r = 0; r < 8; ++r) {
          u32x4 bw;
#pragma unroll
          for (int e = 0; e < 4; ++e)
            bw[e] = (r & 1) ? __builtin_amdgcn_alignbit(d[(r >> 1) + e + 1 > 7 ? 7 : (r >> 1) + e + 1], d[(r >> 1) + e], 16) : d[(r >> 1) + e];
          const half8 bfr = __builtin_bit_cast(half8, bw);
          acc[0][r] = __builtin_amdgcn_mfma_f32_16x16x32_f16(af0, bfr, acc[0][r], 0, 0, 0);
          acc[1][r] = __builtin_amdgcn_mfma_f32_16x16x32_f16(af1, bfr, acc[1][r], 0, 0, 0);
        }
      }
#pragma unroll
      for (int e = 0; e < 2 * GS; ++e) cur[e] = nxt[e];
    }
#pragma unroll
    for (int ta = 0; ta < 2; ++ta) {
      const int t0 = tb + 128 * ta + 32 * kg;
#pragma unroll
      for (int v = 0; v < 4; ++v) {
        const int t = t0 + 8 * v;
        if (MODE == 0) {
          const half8 x1 = *(const half8*)(hT + (size_t)(bb * 2048 + 512 + c) * L + t);
          const half8 uu = *(const half8*)(Urow + t);
          half8 o;
#pragma unroll
          for (int r = 0; r < 8; ++r) o[r] = (h16)((float)x1[r] * (acc[ta][r][v] * invs + (float)uu[r] * bias));
          *(half8*)(z1T + (size_t)(bb * 512 + c) * L + t) = o;
        } else {
          const half8 x2 = *(const half8*)(hT + (size_t)(bb * 2048 + 1024 + c) * L + t);
          const half8 gt = *(const half8*)(hT + (size_t)(bb * 2048 + 1536 + c) * L + t);
          const half8 uu = *(const half8*)(Urow + t);
#pragma unroll
          for (int r = 0; r < 8; ++r) {
            const float y = (float)x2[r] * (acc[ta][r][v] * invs + (float)uu[r] * bias) * (float)gt[r];
            const int tl = t - tb + r;
            *(h16*)(stg + ((tl * 16 + bb) * 8 + w) * 2) = (h16)y;
          }
        }
      }
    }
    if (MODE == 1) {
      __syncthreads();
      h16* yb = (h16*)(P.ws + WS_YB);
#pragma unroll
      for (int i = 0; i < 8; ++i) {
        const int item = tid + 512 * i;
        const int b = item >> 8, tl = item & 255;
        const size_t tok = set ? (size_t)T_LAT + b * CTXL + tb + tl : (size_t)b * SEQ + tb + tl;
        *(half8*)(yb + tok * LDY + cg * 8) = *(const half8*)(stg + (tl * 16 + b) * 16);
      }
      __syncthreads();
    }
  }
  __syncthreads();
}

template <int MODE>
DI void phase_toeplitz(const Params& P, int layer, char* smem) {
  const bool last = layer == DEPTH - 1;
  const int total = last ? 256 : 320;
  for (int item = blockIdx.x; item < total; item += gridDim.x) {
    if (item < 256) toeplitz_task<MODE>(P, layer, 0, item >> 2, item & 3, smem);
    else toeplitz_task<MODE>(P, layer, 1, item - 256, 0, smem);
  }
}

struct SchedAQ {
  XcdSched xs; bool last;
  DI bool next(int i, Unit2& u) const {
    const int it = xs.item(i); if (it < 0) return false;
    int mt, nt;
    if (last && it >= 128 * 13) { mt = 128 + (it - 128 * 13); nt = 10; }
    else { const int g = it / 52, rem = it % 52; nt = rem >> 2; mt = g * 4 + (rem & 3); }
    u.pm = mt; u.pn = nt < 8 ? nt : nt + 8;
    return true;
  }
};
struct EpiAQ {
  h16 *pa, *qb, *kb, *vT, *zs;
  const float *qg, *kg;
  const float2* rope;
  DI void norm_rope(f32x4 (&x)[2][2], const float* gvec, bool do_rope, int t, int fq) const {
    float ss = 0.f;
#pragma unroll
    for (int bj = 0; bj < 2; ++bj)
#pragma unroll
      for (int n = 0; n < 2; ++n)
#pragma unroll
        for (int v = 0; v < 4; ++v) ss += x[bj][n][v] * x[bj][n][v];
    ss += __shfl_xor(ss, 16);
    ss += __shfl_xor(ss, 32);
    const float rstd = rsqrtf(ss * (1.f / 64.f) + 1e-6f);
#pragma unroll
    for (int bj = 0; bj < 2; ++bj)
#pragma unroll
      for (int n = 0; n < 2; ++n) {
        const float4 g = *(const float4*)(gvec + bj * 32 + n * 16 + 4 * fq);
        x[bj][n][0] *= rstd * g.x; x[bj][n][1] *= rstd * g.y; x[bj][n][2] *= rstd * g.z; x[bj][n][3] *= rstd * g.w;
      }
    if (do_rope) {
#pragma unroll
      for (int bj = 0; bj < 2; ++bj) {
        const float4* rp = (const float4*)(rope + ((size_t)t * 2 + bj) * 16 + 4 * fq);
        const float4 ca = rp[0], cb = rp[1];
        const float cs[4] = {ca.x, ca.z, cb.x, cb.z}, sn[4] = {ca.y, ca.w, cb.y, cb.w};
#pragma unroll
        for (int v = 0; v < 4; ++v) {
          const float x1 = x[bj][0][v], x2 = x[bj][1][v];
          x[bj][0][v] = x1 * cs[v] - x2 * sn[v];
          x[bj][1][v] = x2 * cs[v] + x1 * sn[v];
        }
      }
    }
  }
  DI void operator()(const f32x4 (&acc)[2][2][4][2], const Unit2& u, int wr_, int wc_, int fr_, int fq_) const {
    const int tid2 = otid(), wid2 = tid2 >> 6, wr = wid2 >> 2, wc = wid2 & 3, fr = tid2 & 15, fq = (tid2 >> 4) & 3;
    const int row0 = u.pm * 256;
    const bool isctx = row0 >= T_LAT;
    const int pn = u.pn;
#pragma unroll
    for (int ai = 0; ai < 2; ++ai)
#pragma unroll
      for (int m = 0; m < 4; ++m) {
        const int row = row0 + ai * 128 + wr * 64 + m * 16 + fr;
        int b, t;
        if (!isctx) { b = row >> 11; t = row & 2047; } else { b = (row - T_LAT) >> 8; t = (row - T_LAT) & 255; }
        f32x4 x[2][2];
#pragma unroll
        for (int bj = 0; bj < 2; ++bj)
#pragma unroll
          for (int n = 0; n < 2; ++n) x[bj][n] = acc[ai][bj][m][n];
        if (pn < 8) {
#pragma unroll
          for (int bj = 0; bj < 2; ++bj)
#pragma unroll
            for (int n = 0; n < 2; ++n) {
              f32x4 v = x[bj][n];
              if (pn >= 6) { v[0] = silu_f(v[0]); v[1] = silu_f(v[1]); v[2] = silu_f(v[2]); v[3] = silu_f(v[3]); }
              *(half4*)(pa + (size_t)row * 2048 + pn * 256 + wc * 64 + bj * 32 + n * 16 + 4 * fq) = cvt4(v[0], v[1], v[2], v[3]);
            }
        } else if (pn < 18) {
          const int head = (pn - 16) * 4 + wc;
          norm_rope(x, qg, !isctx, t, fq);
#pragma unroll
          for (int bj = 0; bj < 2; ++bj)
#pragma unroll
            for (int n = 0; n < 2; ++n)
              *(half4*)(qb + (size_t)row * 512 + head * 64 + bj * 32 + n * 16 + 4 * fq) = cvt4(x[bj][n][0], x[bj][n][1], x[bj][n][2], x[bj][n][3]);
        } else if (pn == 18) {
          const int key = isctx ? t : CTXL + t;
          if (wc < 2) {
            norm_rope(x, kg, !isctx, t, fq);
#pragma unroll
            for (int bj = 0; bj < 2; ++bj)
#pragma unroll
              for (int n = 0; n < 2; ++n)
                *(half4*)(kb + ((size_t)(b * 2 + wc) * SKV + key) * 64 + bj * 32 + n * 16 + 4 * fq) = cvt4(x[bj][n][0], x[bj][n][1], x[bj][n][2], x[bj][n][3]);
          } else {
#pragma unroll
            for (int bj = 0; bj < 2; ++bj)
#pragma unroll
              for (int n = 0; n < 2; ++n)
#pragma unroll
                for (int v = 0; v < 4; ++v) vT[((size_t)(b * 2 + (wc - 2)) * 64 + bj * 32 + n * 16 + 4 * fq + v) * SKV + key] = (h16)x[bj][n][v];
          }
        } else {
#pragma unroll
          for (int bj = 0; bj < 2; ++bj)
#pragma unroll
            for (int n = 0; n < 2; ++n)
              *(half4*)(zs + (size_t)row * 512 + (pn - 19) * 256 + wc * 64 + bj * 32 + n * 16 + 4 * fq) =
                  cvt4(silu_f(x[bj][n][0]), silu_f(x[bj][n][1]), silu_f(x[bj][n][2]), silu_f(x[bj][n][3]));
        }
      }
  }
};
DI void phase_gemm_aq(const Params& P, int layer, char* smem) {
  const bool last = layer == DEPTH - 1;
  SchedAQ S; S.last = last; S.xs.init(128 * 13 + (last ? 16 : 16 * 13));
  EpiAQ E;
  E.pa = (h16*)(P.ws + WS_R1); E.qb = (h16*)(P.ws + WS_Q); E.kb = (h16*)(P.ws + WS_K); E.vT = (h16*)(P.ws + WS_VT); E.zs = (h16*)(P.ws + WS_ZS);
  E.qg = P.qg + layer * 64; E.kg = P.kg + layer * 64; E.rope = (const float2*)(P.ws + WS_ROPE);
  if (!last) {
    const int G = gridDim.x;
    if ((G & 7) == 0) {
      const int nxb = G >> 3, per = (128 * 13 + 16 * 13 + 7) >> 3, nlong = per - (per / nxb) * nxb;
      const int j = blockIdx.x >> 3, xcd = blockIdx.x & 7;
      if (j >= nlong) cvt_layer_weights(P, layer + 1, (j - nlong) * 8 + xcd, (nxb - nlong) * 8, smem);
    } else cvt_layer_weights(P, layer + 1, blockIdx.x, G, smem);
  }
  gemm256_stream<true>(smem, (const h16*)(P.ws + WS_H16), LDH, (const h16*)(P.ws + wbase(layer)), LDH, D, S, E);
}

DI void attn_task(const Params& P, int set, int b, int kvh, int qt, char* smem) {
  const int tid = otid(), w = tid >> 6, lane = tid & 63, r32 = lane & 31, hh = lane >> 5;
  const int head = kvh * 4 + (w & 3), qsub = w >> 2;
  const int nkeys = set ? CTXL : SKV;
  const size_t row = (set ? (size_t)T_LAT + b * CTXL : (size_t)b * SEQ) + qt * 64 + qsub * 32 + r32;
  const h16* qb = (const h16*)(P.ws + WS_Q);
  h16* yc = (h16*)(P.ws + WS_YC);
  const h16* zs = (const h16*)(P.ws + WS_ZS);
  const h16* kg = (const h16*)(P.ws + WS_K) + (size_t)(b * 2 + kvh) * SKV * 64;
  const h16* vg = (const h16*)(P.ws + WS_VT) + (size_t)(b * 2 + kvh) * 64 * SKV;
  half8 qf[4];
#pragma unroll
  for (int ds = 0; ds < 4; ++ds) qf[ds] = *(const half8*)(qb + row * 512 + head * 64 + 16 * ds + 8 * hh);
  const int srow = tid >> 3, sch = tid & 7, ssw = (srow >> 1) & 7;
  const int k_wr = srow * 128 + ((sch ^ ssw) * 16);
  const int u = sch >> 1, od = sch & 1;
  const int v_wr0 = 8192 + srow * 128 + (((2 * u) ^ ssw) * 16) + 8 * od;
  const int v_wr1 = 8192 + srow * 128 + (((2 * u + 1) ^ ssw) * 16) + 8 * od;
  const int sw = (r32 >> 1) & 7;
  const int ntile = nkeys >> 6;
  half8 kreg = *(const half8*)(kg + (size_t)srow * 64 + sch * 8);
  half8 vreg = *(const half8*)(vg + (size_t)srow * SKV + sch * 8);
  {
    char* s = smem;
    *(half8*)(s + k_wr) = kreg;
    half4 lo, hi;
    lo[0] = vreg[0]; lo[1] = vreg[1]; lo[2] = vreg[2]; lo[3] = vreg[3];
    hi[0] = vreg[4]; hi[1] = vreg[5]; hi[2] = vreg[6]; hi[3] = vreg[7];
    *(half4*)(s + v_wr0) = lo;
    *(half4*)(s + v_wr1) = hi;
  }
  __syncthreads();
  f32x16 o0, o1;
#pragma unroll
  for (int v = 0; v < 16; ++v) { o0[v] = 0.f; o1[v] = 0.f; }
  float m_run = -1e30f, l_run = 0.f;
  const float cscale = 0.125f * 1.4426950408889634f;
  asm volatile("" : "+v"(qf[0]), "+v"(qf[1]), "+v"(qf[2]), "+v"(qf[3]));
#pragma unroll 1
  for (int kt = 0; kt < ntile; ++kt) {
    if (kt + 1 < ntile) {
      kreg = *(const half8*)(kg + (size_t)((kt + 1) * 64 + srow) * 64 + sch * 8);
      vreg = *(const half8*)(vg + (size_t)srow * SKV + (kt + 1) * 64 + sch * 8);
    }
    const char* s = smem + (kt & 1) * 16384;
    f32x16 s0, s1;
#pragma unroll
    for (int v = 0; v < 16; ++v) { s0[v] = 0.f; s1[v] = 0.f; }
#pragma unroll
    for (int ds = 0; ds < 4; ++ds) {
      const int co = ((2 * ds + hh) ^ sw) * 16;
      const half8 k0 = *(const half8*)(s + r32 * 128 + co);
      const half8 k1 = *(const half8*)(s + (32 + r32) * 128 + co);
      s0 = __builtin_amdgcn_mfma_f32_32x32x16_f16(k0, qf[ds], s0, 0, 0, 0);
      s1 = __builtin_amdgcn_mfma_f32_32x32x16_f16(k1, qf[ds], s1, 0, 0, 0);
    }
    float mx = s0[0];
#pragma unroll
    for (int v = 0; v < 16; ++v) { mx = fmaxf(mx, s0[v]); mx = fmaxf(mx, s1[v]); }
    mx = fmaxf(mx, __shfl_xor(mx, 32));
    const float m_new = fmaxf(m_run, mx * cscale);
    const float alpha = __builtin_amdgcn_exp2f(m_run - m_new);
    m_run = m_new;
    float ps = 0.f;
#pragma unroll
    for (int v = 0; v < 16; ++v) {
      s0[v] = __builtin_amdgcn_exp2f(s0[v] * cscale - m_new); ps += s0[v];
      s1[v] = __builtin_amdgcn_exp2f(s1[v] * cscale - m_new); ps += s1[v];
    }
    l_run = l_run * alpha + ps;
#pragma unroll
    for (int v = 0; v < 16; ++v) { o0[v] *= alpha; o1[v] *= alpha; }
#pragma unroll
    for (int uu = 0; uu < 4; ++uu) {
      half8 pf;
#pragma unroll
      for (int j = 0; j < 8; ++j) pf[j] = (h16)((uu < 2) ? s0[8 * (uu & 1) + j] : s1[8 * (uu & 1) + j]);
      const int co = ((2 * uu + hh) ^ sw) * 16;
      const half8 v0 = *(const half8*)(s + 8192 + r32 * 128 + co);
      const half8 v1 = *(const half8*)(s + 8192 + (32 + r32) * 128 + co);
      o0 = __builtin_amdgcn_mfma_f32_32x32x16_f16(v0, pf, o0, 0, 0, 0);
      o1 = __builtin_amdgcn_mfma_f32_32x32x16_f16(v1, pf, o1, 0, 0, 0);
    }
    if (kt + 1 < ntile) {
      char* s2 = smem + ((kt + 1) & 1) * 16384;
      *(half8*)(s2 + k_wr) = kreg;
      half4 lo, hi;
      lo[0] = vreg[0]; lo[1] = vreg[1]; lo[2] = vreg[2]; lo[3] = vreg[3];
      hi[0] = vreg[4]; hi[1] = vreg[5]; hi[2] = vreg[6]; hi[3] = vreg[7];
      *(half4*)(s2 + v_wr0) = lo;
      *(half4*)(s2 + v_wr1) = hi;
    }
    __syncthreads();
  }
  const float ltot = l_run + __shfl_xor(l_run, 32);
  const float inv = 1.f / ltot;
#pragma unroll
  for (int db = 0; db < 2; ++db)
#pragma unroll
    for (int g = 0; g < 4; ++g) {
      const size_t off = row * 512 + head * 64 + db * 32 + 8 * g + 4 * hh;
      const half4 z = *(const half4*)(zs + off);
      const f32x16& o = db ? o1 : o0;
      *(half4*)(yc + row * LDY + head * 64 + db * 32 + 8 * g + 4 * hh) = cvt4(o[4 * g] * inv * (float)z[0], o[4 * g + 1] * inv * (float)z[1], o[4 * g + 2] * inv * (float)z[2], o[4 * g + 3] * inv * (float)z[3]);
    }
}

DI void phase_attn(const Params& P, int layer, char* smem) {
  const bool last = layer == DEPTH - 1;
  const int n_lat = NBATCH * 2 * 32;
  const int total = n_lat + (last ? 0 : NBATCH * 2 * 4);
  for (int item = blockIdx.x; item < total; item += gridDim.x) {
    if (item < n_lat) attn_task(P, 0, item >> 6, (item >> 5) & 1, item & 31, smem);
    else { const int u = item - n_lat; attn_task(P, 1, u >> 3, (u >> 2) & 1, u & 3, smem); }
  }
  const int tid = otid(), lane = tid & 63, w = tid >> 6;
  const int gw = blockIdx.x * 8 + w, nw = gridDim.x * 8;
  const h16* pa = (const h16*)(P.ws + WS_R1);
  h16* ya = (h16*)(P.ws + WS_R2);
  const int nitems = (last ? T_LAT : T_ALL) / 8;
  const float* cw = P.conv_a + (size_t)layer * 3 * 512 + lane * 8;
  float w0[8], w1[8], w2[8];
#pragma unroll
  for (int e = 0; e < 8; ++e) { w0[e] = cw[e]; w1[e] = cw[512 + e]; w2[e] = cw[1024 + e]; }
  for (int it = gw; it < nitems; it += nw) {
    const int tk0 = it * 8;
    int t0, L;
    if (tk0 < T_LAT) { t0 = tk0 & 2047; L = SEQ; } else { t0 = (tk0 - T_LAT) & 255; L = CTXL; }
    float up[8], uc[8], un[8];
    auto load_u = [&](int dt, float (&dst)[8]) {
      const int t = t0 + dt;
      if (t < 0 || t >= L) {
#pragma unroll
        for (int e = 0; e < 8; ++e) dst[e] = 0.f;
      } else {
        const h16* rp = pa + (size_t)(tk0 + dt) * 2048 + lane * 8;
        const half8 xa = *(const half8*)rp, ca = *(const half8*)(rp + 1024);
#pragma unroll
        for (int e = 0; e < 8; ++e) dst[e] = (float)xa[e] * (float)ca[e];
      }
    };
    load_u(-1, up);
    load_u(0, uc);
#pragma unroll 1
    for (int dt = 0; dt < 8; ++dt) {
      load_u(dt + 1, un);
      const h16* rp = pa + (size_t)(tk0 + dt) * 2048 + lane * 8;
      const half8 ba = *(const half8*)(rp + 512), za = *(const half8*)(rp + 1536);
      half8 o;
#pragma unroll
      for (int e = 0; e < 8; ++e) o[e] = (h16)((float)ba[e] * (w0[e] * up[e] + w1[e] * uc[e] + w2[e] * un[e]) * (float)za[e]);
      *(half8*)(ya + (size_t)(tk0 + dt) * LDY + lane * 8) = o;
#pragma unroll
      for (int e = 0; e < 8; ++e) { up[e] = uc[e]; uc[e] = un[e]; }
    }
  }
}

template <int MB>
DI void merge_tile(const Params& P, int layer, size_t row0, int nt, char* smem) {
  const h16* hb = (const h16*)(P.ws + WS_H16);
  const h16* winT = (const h16*)(P.ws + wbase(layer));
  const h16* wbrT = (const h16*)(P.ws + wbase(layer) + OFF_WBRT);
  h16* mg = (h16*)(P.ws + WS_R1);
  f32x16 macc[MB][2];
  zero_acc<MB>(macc);
#pragma unroll 1
  for (int n = 0; n < 3; ++n) {
    const h16* yn = (const h16*)(P.ws + (n == 0 ? WS_R2 : (n == 1 ? WS_YB : WS_YC)));
    f32x16 pa2[MB][2];
    half8 gpk[MB][2][2];
    zero_acc<MB>(pa2);
    gemm_kloop<MB, true>(pa2, hb + row0 * LDH, LDH, winT + (size_t)(G_OFF + n * 1024 + nt * 256) * LDH, LDH, D, smem);
#pragma unroll
    for (int mb = 0; mb < MB; ++mb)
#pragma unroll
      for (int nb = 0; nb < 2; ++nb)
#pragma unroll
        for (int v = 0; v < 16; ++v) gpk[mb][nb][v >> 3][v & 7] = (h16)sigmoid_f(pa2[mb][nb][v]);
    zero_acc<MB>(pa2);
    gemm_kloop<MB, true>(pa2, yn + row0 * LDY, LDY, wbrT + (size_t)(n * 1024 + nt * 256) * LDY, LDY, WB, smem);
#pragma unroll
    for (int mb = 0; mb < MB; ++mb)
#pragma unroll
      for (int nb = 0; nb < 2; ++nb)
#pragma unroll
        for (int v = 0; v < 16; ++v) macc[mb][nb][v] += (float)gpk[mb][nb][v >> 3][v & 7] * pa2[mb][nb][v];
  }
  const int tid = otid(), lane = tid & 63, w = tid >> 6, wr = w >> 2, wc = w & 3, r32 = lane & 31, hh = lane >> 5;
#pragma unroll
  for (int mb = 0; mb < MB; ++mb) {
    const size_t row = row0 + wr * 32 * MB + mb * 32 + r32;
#pragma unroll
    for (int nb = 0; nb < 2; ++nb)
#pragma unroll
      for (int g = 0; g < 4; ++g)
        *(half4*)(mg + row * LDH + nt * 256 + wc * 64 + nb * 32 + 8 * g + 4 * hh) =
            cvt4(macc[mb][nb][4 * g], macc[mb][nb][4 * g + 1], macc[mb][nb][4 * g + 2], macc[mb][nb][4 * g + 3]);
  }
}
DI void split_rounds(int total, int& nfull, int& nhalf) {
  const int G = gridDim.x;
  nfull = (total / G) * G;
  const int rem = total - nfull;
  if (rem > 0 && 2 * rem <= G) nhalf = 2 * rem; else { nfull = total; nhalf = 0; }
}
DI void phase_merge(const Params& P, int layer, char* smem) {
  const bool last = layer == DEPTH - 1;
  const int total = (last ? T_LAT : T_ALL) / 128 * 4;
  int nfull, nhalf;
  split_rounds(total, nfull, nhalf);
  for_items_xcd(nfull, [&](int item) {
    const int mt = (item >> 5) * 8 + (item & 7), nt = (item & 31) >> 3;
    merge_tile<2>(P, layer, (size_t)mt * 128, nt, smem);
  });
  for_items_xcd(nhalf, [&](int h) {
    const int item = nfull + (h >> 1);
    const int mt = (item >> 5) * 8 + (item & 7), nt = (item & 31) >> 3;
    merge_tile<1>(P, layer, (size_t)mt * 128 + (h & 1) * 64, nt, smem);
  });
}

template <int MB>
DI void out_tile(const Params& P, int layer, int row0, int nt, char* smem) {
  const h16* mg = (const h16*)(P.ws + WS_R1);
  const h16* woutT = (const h16*)(P.ws + wbase(layer) + OFF_WOUTT);
  const float* mods = (const float*)(P.ws + WS_MODS) + (size_t)layer * 17 * 3072;
  float* ctxw = (float*)(P.ws + WS_CTXW);
  f32x16 acc[MB][2];
  zero_acc<MB>(acc);
  gemm_kloop<MB, true>(acc, mg + (size_t)row0 * LDH, LDH, woutT + (size_t)(nt * 256) * LDH, LDH, D, smem);
  const int tid = otid(), lane = tid & 63, w = tid >> 6, wr = w >> 2, wc = w & 3, r32 = lane & 31, hh = lane >> 5;
#pragma unroll
  for (int mb = 0; mb < MB; ++mb) {
    const int row = row0 + wr * 32 * MB + mb * 32 + r32;
    const float* src; float* dst; int b;
    if (row < T_LAT) { b = row >> 11; src = (layer == 0 ? P.x : P.out) + (size_t)row * D; dst = P.out + (size_t)row * D; }
    else { const int rc = row - T_LAT; b = 16; src = (layer == 0 ? P.ctx : ctxw) + (size_t)rc * D; dst = ctxw + (size_t)rc * D; }
    const float* gt = mods + b * 3072 + 2048;
#pragma unroll
    for (int nb = 0; nb < 2; ++nb)
#pragma unroll
      for (int g = 0; g < 4; ++g) {
        const int col = nt * 256 + wc * 64 + nb * 32 + 8 * g + 4 * hh;
        const float4 xo = *(const float4*)(src + col);
        const float4 gv = *(const float4*)(gt + col);
        float4 r;
        r.x = xo.x + gv.x * acc[mb][nb][4 * g]; r.y = xo.y + gv.y * acc[mb][nb][4 * g + 1];
        r.z = xo.z + gv.z * acc[mb][nb][4 * g + 2]; r.w = xo.w + gv.w * acc[mb][nb][4 * g + 3];
        *(float4*)(dst + col) = r;
      }
  }
}
DI void phase_out(const Params& P, int layer, char* smem) {
  const bool last = layer == DEPTH - 1;
  const int total = (last ? T_LAT : T_ALL) / 128 * 4;
  int nfull, nhalf;
  split_rounds(total, nfull, nhalf);
  for_items_xcd(nfull, [&](int item) {
    const int mt = (item >> 5) * 8 + (item & 7), nt = (item & 31) >> 3;
    out_tile<2>(P, layer, mt * 128, nt, smem);
  });
  for_items_xcd(nhalf, [&](int h) {
    const int item = nfull + (h >> 1);
    const int mt = (item >> 5) * 8 + (item & 7), nt = (item & 31) >> 3;
    out_tile<1>(P, layer, mt * 128 + (h & 1) * 64, nt, smem);
  });
}

#define XB_TMO      128
#define XB_XCNT(j)  (256  + 64 * (j))
#define XB_XSUB(j)  (1280 + 64 * (j))
#define XB_XGEN(j)  (2304 + 64 * (j))
#define XB_TOP      3328
#define XB_TOPGEN   3392
#define XCD_BAR_WORDS 3456
#define XB_SPIN_CAP (1u << 20)
#define LAS __attribute__((address_space(3)))
DI unsigned xb_ld(unsigned* p) { return __hip_atomic_load(p, __ATOMIC_RELAXED, __HIP_MEMORY_SCOPE_AGENT); }
DI unsigned xb_add(unsigned* p, unsigned v) { return __hip_atomic_fetch_add(p, v, __ATOMIC_RELAXED, __HIP_MEMORY_SCOPE_AGENT); }
DI unsigned xb_xcc_id() { return (unsigned)__builtin_amdgcn_s_getreg((3 << 11) | 20) & 0xFu; }
#define XB_SPIN(cond, bar) do { unsigned _sp = 0; while (cond) { __builtin_amdgcn_s_sleep(1); \
    if ((++_sp & 255u) == 0u) { if (xb_ld(&(bar)[XB_TMO])) break; if (_sp > XB_SPIN_CAP) { atomicAdd(&(bar)[XB_TMO], 1u); break; } } } } while (0)
struct XcdBarrier { unsigned* bar; unsigned x; volatile LAS unsigned* st; };
DI XcdBarrier xcd_barrier_post(unsigned* bar, volatile LAS unsigned* st) {
  XcdBarrier b; b.bar = bar; b.x = xb_xcc_id(); b.st = st;
  if (threadIdx.x == 0) (void)xb_add(&bar[XB_XCNT(b.x)], 1u);
  return b;
}
DI void xcd_barrier_complete(unsigned* bar, unsigned x, unsigned& nloc, unsigned& nx) {
  const unsigned G = gridDim.x;
  unsigned sum, cnt, mine, sp = 0u;
  for (;;) {
    sum = 0u; cnt = 0u; mine = 0u;
#pragma unroll
    for (unsigned j = 0; j < 16; ++j) { const unsigned c = xb_ld(&bar[XB_XCNT(j)]); sum += c; cnt += (c > 0u) ? 1u : 0u; mine = (j == x) ? c : mine; }
    if (sum == G) break;
    __builtin_amdgcn_s_sleep(1);
    if ((++sp & 255u) == 0u) { if (xb_ld(&bar[XB_TMO])) break; if (sp > XB_SPIN_CAP) { atomicAdd(&bar[XB_TMO], 1u); break; } }
  }
  nloc = mine > 0u ? mine : 1u; nx = cnt > 0u ? cnt : 1u;
}
DI void xcd_barrier(const XcdBarrier& b) {
  asm volatile("s_waitcnt vmcnt(0)" ::: "memory");
  __syncthreads();
  if (threadIdx.x == 0) {
    unsigned* bar = b.bar;
    asm volatile("" : "+s"(bar));
    __builtin_amdgcn_s_waitcnt(0);
    unsigned nloc = b.st[0], nx = b.st[1];
    if (nloc == 0u) { xcd_barrier_complete(bar, b.x, nloc, nx); b.st[0] = nloc; b.st[1] = nx; }
    const unsigned old = xb_add(&bar[XB_XSUB(b.x)], 1u);
    const unsigned gen = old / nloc;
    if (old + 1u == (gen + 1u) * nloc) {
      __builtin_amdgcn_fence(__ATOMIC_RELEASE, "agent");
      asm volatile("s_waitcnt vmcnt(0)" ::: "memory");
      const unsigned og = xb_add(&bar[XB_TOP], 1u);
      const unsigned tg = og / nx;
      if (og + 1u == (tg + 1u) * nx) xb_add(&bar[XB_TOPGEN], 1u);
      else XB_SPIN(xb_ld(&bar[XB_TOPGEN]) == tg, bar);
      __builtin_amdgcn_fence(__ATOMIC_ACQUIRE, "agent");
      xb_add(&bar[XB_XGEN(b.x)], 1u);
      asm volatile("s_waitcnt vmcnt(0)" ::: "memory");
    } else {
      XB_SPIN(xb_ld(&bar[XB_XGEN(b.x)]) == gen, bar);
      __builtin_amdgcn_fence(__ATOMIC_ACQUIRE, "agent");
      asm volatile("s_waitcnt vmcnt(0)" ::: "memory");
    }
  }
  __syncthreads();
}

__global__ void __launch_bounds__(512) mega_kernel(Params P) {
  extern __shared__ __attribute__((aligned(16))) char smem[];
  volatile LAS unsigned* xst = (volatile LAS unsigned*)(smem + LDS_BYTES);
  if (threadIdx.x == 0) { xst[0] = 0u; xst[1] = 0u; }
  __syncthreads();
  const XcdBarrier xb = xcd_barrier_post((unsigned*)(P.ws + WS_BAR), xst);
  for (int ph = P.ph_lo; ph < P.ph_hi; ++ph) {
    if (ph == 0) phase_prep(P, smem);
    else {
      const int layer = (ph - 1) / NPH_LAYER, k = (ph - 1) % NPH_LAYER;
#ifndef PROBE_REP
#define PROBE_REP -1
#endif
      const int nrep = (k == PROBE_REP) ? 2 : 1;
      for (int rep = 0; rep < nrep; ++rep) {
      switch (k) {
        case 0: { int lo = layer; asm volatile("" : "+s"(lo)); phase_norm(P, lo, smem); } break;
        case 1: { int lo = layer; asm volatile("" : "+s"(lo)); phase_gemm_h(P, lo, smem); } break;
        case 2: { int lo = layer; asm volatile("" : "+s"(lo)); phase_shortconv(P, lo, smem); } break;
        case 3: { int lo = layer; asm volatile("" : "+s"(lo)); phase_toeplitz<0>(P, lo, smem); } break;
        case 4: { int lo = layer; asm volatile("" : "+s"(lo)); phase_toeplitz<1>(P, lo, smem); } break;
        case 5: { int lo = layer; asm volatile("" : "+s"(lo)); phase_gemm_aq(P, lo, smem); } break;
        case 6: { int lo = layer; asm volatile("" : "+s"(lo)); phase_attn(P, lo, smem); } break;
        case 7: { int lo = layer; asm volatile("" : "+s"(lo)); phase_merge(P, lo, smem); } break;
        default: { int lo = layer; asm volatile("" : "+s"(lo)); phase_out(P, lo, smem); } break;
      }
      if (rep + 1 < nrep) cg::this_grid().sync();
      }
    }
    if (ph + 1 < P.ph_hi) {
      if (ph == P.ph_lo) cg::this_grid().sync();
      else xcd_barrier(xb);
    }
  }
}

extern "C" void kernel_launch(void* const* d_in, const int* in_sizes, int n_in, void* d_out, int out_size, void* d_ws, size_t ws_size,
                              hipStream_t stream) {
  static int grid = 0;
  if (grid == 0) {
    int dev = 0, cus = 0, per_cu = 0;
    hipGetDevice(&dev);
    hipDeviceGetAttribute(&cus, hipDeviceAttributeMultiprocessorCount, dev);
    if (hipFuncSetAttribute((const void*)mega_kernel, hipFuncAttributeMaxDynamicSharedMemorySize, LDS_BYTES + 16) != hipSuccess) {
      fprintf(stderr, "hipFuncSetAttribute failed\n");
      grid = -1;
      return;
    }
    hipOccupancyMaxActiveBlocksPerMultiprocessor(&per_cu, (const void*)mega_kernel, 512, LDS_BYTES + 16);
    if (per_cu < 1) per_cu = 1;
    grid = cus * per_cu;
    if (ws_size < WS_END || n_in != 22) { fprintf(stderr, "workspace too small: %zu < %zu\n", ws_size, (size_t)WS_END); grid = -1; }
  }
  if (grid < 0) return;
  Params p{};
  const float** f = (const float**)&p;
  for (int i = 0; i < 22; ++i) f[i] = (const float*)d_in[i];
  p.out = (float*)d_out;
  p.ws = (char*)d_ws;
#if PER_PHASE_LAUNCH
  for (int ph = 0; ph < NPHASES; ++ph) {
    p.ph_lo = ph; p.ph_hi = ph + 1;
    hipLaunchKernelGGL(mega_kernel, dim3(grid), dim3(512), LDS_BYTES + 16, stream, p);
  }
#else
  p.ph_lo = 0; p.ph_hi = NPHASES;
  if (hipMemsetAsync((char*)d_ws + WS_BAR, 0, XCD_BAR_WORDS * 4, stream) != hipSuccess) { fprintf(stderr, "memset of barrier word failed\n"); return; }
  void* args[] = {&p};
  hipError_t e = hipLaunchCooperativeKernel((const void*)mega_kernel, dim3(grid), dim3(512), args, LDS_BYTES + 16, stream);
  if (e != hipSuccess) fprintf(stderr, "cooperative launch failed: %s (grid %d)\n", hipGetErrorString(e), grid);
#endif
}
```

```cpp
#include <hip/hip_runtime.h>
#include <hip/hip_cooperative_groups.h>
#include <cstdio>
namespace cg = cooperative_groups;

#ifndef PER_PHASE_LAUNCH
#define PER_PHASE_LAUNCH 0
#endif

typedef _Float16 h16;
typedef _Float16 half8 __attribute__((ext_vector_type(8)));
typedef _Float16 half4 __attribute__((ext_vector_type(4)));
typedef float f32x16 __attribute__((ext_vector_type(16)));
typedef float f32x4 __attribute__((ext_vector_type(4)));
typedef unsigned u32x4 __attribute__((ext_vector_type(4)));
#define DI __device__ __forceinline__

constexpr int D = 1024, NBATCH = 16, SEQ = 2048, CTXL = 256, DEPTH = 4, WB = 512;
constexpr int T_LAT = NBATCH * SEQ, T_CTX = NBATCH * CTXL, T_ALL = T_LAT + T_CTX;
constexpr int IN_COLS = 8448, H_OFF = 2048, C_OFF = 4096, K_OFF = 4608, Z_OFF = 4864, G_OFF = 5376;
constexpr int SKV = CTXL + SEQ;
constexpr int KLEN_L = 2 * SEQ + 256, KOFF_L = SEQ + 64;
constexpr int KLEN_C = 2 * CTXL + 256, KOFF_C = CTXL + 64;
constexpr int LDH = 1088, LDY = 576;
constexpr int NPH_LAYER = 9;
constexpr int NPHASES = 1 + DEPTH * NPH_LAYER;
constexpr int LDS_BYTES = 3 * 49152;

constexpr size_t al(size_t x) { return (x + 255) & ~size_t(255); }
constexpr size_t WS_CTXW = 0;
constexpr size_t WS_MODS = WS_CTXW + al((size_t)T_CTX * D * 4);
constexpr size_t WS_ROPE = WS_MODS + al((size_t)DEPTH * 17 * 3072 * 4);
constexpr size_t WS_WINT = WS_ROPE + al((size_t)SEQ * 32 * 8);
constexpr size_t WS_WBRT = WS_WINT + al((size_t)IN_COLS * LDH * 2);
constexpr size_t WS_WOUTT = WS_WBRT + al((size_t)3 * D * LDY * 2);
constexpr size_t WS_H2 = WS_WOUTT + al((size_t)D * LDH * 2);
constexpr size_t WS_KRL = WS_H2 + al((size_t)(SEQ + CTXL) * 64 * 4);
constexpr size_t WS_KRC = WS_KRL + al((size_t)2 * WB * KLEN_L * 2);
constexpr size_t WS_INVS = WS_KRC + al((size_t)2 * WB * KLEN_C * 2);
constexpr size_t WS_H16 = WS_INVS + al((size_t)2 * 2 * WB * 4);
constexpr size_t WS_R1 = WS_H16 + al((size_t)T_ALL * LDH * 2);
constexpr size_t WS_R2 = WS_R1 + al((size_t)T_ALL * 2048 * 2);
constexpr size_t WS_YB = WS_R2 + al((size_t)T_ALL * LDY * 2);
constexpr size_t WS_Q = WS_YB + al((size_t)T_ALL * LDY * 2);
constexpr size_t WS_K = WS_Q + al((size_t)T_ALL * WB * 2);
constexpr size_t WS_VT = WS_K + al((size_t)NBATCH * 2 * SKV * 64 * 2);
constexpr size_t WS_ZS = WS_VT + al((size_t)NBATCH * 2 * SKV * 64 * 2);
constexpr size_t WS_YC = WS_ZS + al((size_t)T_ALL * WB * 2);
constexpr size_t WS_BAR = WS_YC + al((size_t)T_ALL * LDY * 2);
constexpr size_t WS_W1 = WS_BAR + 16384;
constexpr size_t WS_END = WS_W1 + (WS_H2 - WS_WINT);
constexpr size_t OFF_WBRT = WS_WBRT - WS_WINT, OFF_WOUTT = WS_WOUTT - WS_WINT;
constexpr size_t HTC_OFF = (size_t)NBATCH * 2048 * SEQ;
constexpr size_t Z1C_OFF = (size_t)NBATCH * WB * SEQ;

struct Params {
  const float *x, *c, *ctx, *c_ctx, *norm_g, *w_mod, *b_mod, *w_in, *conv_a, *conv_h, *fw1, *fb1, *fw2, *fb2, *fw3, *fb3,
      *ffreq, *hbias, *qg, *kg, *w_branch, *w_out;
  float* out;
  char* ws;
  int ph_lo, ph_hi;
};

DI size_t wbase(int layer) { return (layer & 1) ? WS_W1 : WS_WINT; }
DI float silu_f(float x) { return x / (1.f + __expf(-x)); }
DI float sigmoid_f(float x) { return 1.f / (1.f + __expf(-x)); }
DI half4 cvt4(float a, float b, float c, float d) { half4 r; r[0] = (h16)a; r[1] = (h16)b; r[2] = (h16)c; r[3] = (h16)d; return r; }
DI void wait_vm0() { asm volatile("s_waitcnt vmcnt(0)" ::: "memory"); }
DI int otid() { int t = threadIdx.x; asm volatile("" : "+v"(t)); return t; }

template <int MB, bool SWAP>
DI void gemm_kloop(f32x16 (&acc)[MB][2], const h16* __restrict__ A, int lda, const h16* __restrict__ B, int ldb, int K, char* lds) {
  constexpr int A_BYTES = 64 * MB * 128, B_BYTES = 256 * 128, STAGE = A_BYTES + B_BYTES;
  static_assert(3 * STAGE <= LDS_BYTES, "ring does not fit");
  const int tid = otid(), w = tid >> 6, lane = tid & 63;
  const int wr = w >> 2, wc = w & 3;
  const int lrow = w * 8 + (lane >> 3), pch = lane & 7;
  const int gch = pch ^ ((lrow >> 1) & 7);
  const unsigned voa = (unsigned)(lrow * lda + gch * 8) * 2u, vob = (unsigned)(lrow * ldb + gch * 8) * 2u;
  const int lofs = lrow * 128 + pch * 16;
  const int r32 = lane & 31, hh = lane >> 5, sw = (r32 >> 1) & 7;
  const int a_rd = (wr * 32 * MB + r32) * 128;
  const int b_rd = A_BYTES + (wc * 64 + r32) * 128;
  const int nk = K >> 6;
  constexpr int NP = MB + 4;
  auto piece = [&](int p, int kt, int buf) {
    char* s = lds + buf * STAGE;
    if (p < MB) __builtin_amdgcn_global_load_lds((const unsigned*)((const char*)(A + (size_t)p * 64 * lda + kt * 64) + voa), (unsigned*)(s + p * 8192 + lofs), 16, 0, 0);
    else __builtin_amdgcn_global_load_lds((const unsigned*)((const char*)(B + (size_t)(p - MB) * 64 * ldb + kt * 64) + vob), (unsigned*)(s + A_BYTES + (p - MB) * 8192 + lofs), 16, 0, 0);
  };
  wait_vm0();
#pragma unroll
  for (int p = 0; p < NP; ++p) piece(p, 0, 0);
#pragma unroll
  for (int p = 0; p < NP; ++p) piece(p, 1, 1);
  int cur = 0;
  for (int kt = 0; kt < nk; ++kt) {
    if (kt + 1 < nk) { if (MB == 2) asm volatile("s_waitcnt vmcnt(6)" ::: "memory"); else asm volatile("s_waitcnt vmcnt(5)" ::: "memory"); }
    else wait_vm0();
    __syncthreads();
    const char* s = lds + cur * STAGE;
    const int nbuf = cur == 0 ? 2 : cur - 1;
    const bool more = kt + 2 < nk;
    half8 af[2][MB], bf[2][2];
#pragma unroll
    for (int mb = 0; mb < MB; ++mb) af[0][mb] = *(const half8*)(s + a_rd + mb * 4096 + (((0 + hh) ^ sw) * 16));
#pragma unroll
    for (int nb = 0; nb < 2; ++nb) bf[0][nb] = *(const half8*)(s + b_rd + nb * 4096 + (((0 + hh) ^ sw) * 16));
#pragma unroll
    for (int ks = 0; ks < 4; ++ks) {
      if (ks < 3) {
#pragma unroll
        for (int mb = 0; mb < MB; ++mb) af[(ks + 1) & 1][mb] = *(const half8*)(s + a_rd + mb * 4096 + (((2 * (ks + 1) + hh) ^ sw) * 16));
#pragma unroll
        for (int nb = 0; nb < 2; ++nb) bf[(ks + 1) & 1][nb] = *(const half8*)(s + b_rd + nb * 4096 + (((2 * (ks + 1) + hh) ^ sw) * 16));
      }
      if (more) {
        if (2 * ks < NP) piece(2 * ks, kt + 2, nbuf);
        if (2 * ks + 1 < NP) piece(2 * ks + 1, kt + 2, nbuf);
      }
      __builtin_amdgcn_sched_barrier(0);
      __builtin_amdgcn_s_setprio(1);
#pragma unroll
      for (int mb = 0; mb < MB; ++mb)
#pragma unroll
        for (int nb = 0; nb < 2; ++nb)
          acc[mb][nb] = SWAP ? __builtin_amdgcn_mfma_f32_32x32x16_f16(bf[ks & 1][nb], af[ks & 1][mb], acc[mb][nb], 0, 0, 0)
                             : __builtin_amdgcn_mfma_f32_32x32x16_f16(af[ks & 1][mb], bf[ks & 1][nb], acc[mb][nb], 0, 0, 0);
      __builtin_amdgcn_s_setprio(0);
      __builtin_amdgcn_sched_barrier(0);
    }
    cur = cur == 2 ? 0 : cur + 1;
  }
  __syncthreads();
}

DI int lds_byte16(int r, int c) { const int st = (r >> 4) * 2 + (c >> 5), rr = r & 15, cc = c & 31, ob = rr * 64 + cc * 2; return st * 1024 + (ob ^ (((ob >> 9) & 1) << 5)); }
DI void stage_rc16(int b, int& R, int& C) { const int st = b / 1024, sb = b % 1024, swz = sb ^ (((sb >> 9) & 1) << 5); R = (st >> 1) * 16 + swz / 64; C = (st & 1) * 32 + (swz % 64) / 2; }
struct Unit2 { int pm, pn; };
template <bool HEADPERM, class Sched, class Epi>
DI void gemm256_stream(char* lds, const h16* __restrict__ Ab, int lda, const h16* __restrict__ Bb, int ldb, int K, const Sched& S, const Epi& E) {
  constexpr int HTB = 128 * 64 * 2;
  const int tid = otid(), wid = __builtin_amdgcn_readfirstlane(tid >> 6), lane = tid & 63, wr = wid >> 2, wc = wid & 3, fr = lane & 15, fq = lane >> 4;
  const int nt = K / 64;
  unsigned voffA[2], voffB0[2], voffB1[2];
#pragma unroll
  for (int i = 0; i < 2; ++i) {
    int R, C;
    stage_rc16(tid * 16 + i * 8192, R, C);
    voffA[i] = (unsigned)(R * lda + C) * 2u;
    if (HEADPERM) {
      const int rb = (R >> 5) * 64 + (R & 31);
      voffB0[i] = (unsigned)(rb * ldb + C) * 2u;
      voffB1[i] = (unsigned)((rb + 32) * ldb + C) * 2u;
    } else {
      voffB0[i] = (unsigned)(R * ldb + C) * 2u;
      voffB1[i] = (unsigned)((R + 128) * ldb + C) * 2u;
    }
  }
  const size_t kstep = 128;
  const size_t hstepA = (size_t)128 * lda * 2;
  const size_t tstepA = 2 * hstepA, tstepB = (size_t)256 * ldb * 2;
  const unsigned ldsw = (unsigned)wid * 1024u;
  const int aoff = lds_byte16(wr * 64 + fr, fq * 8), boff = lds_byte16(wc * 32 + fr, fq * 8);
#define G8_SA(b, h) (((b) * 2 + (h)) * HTB)
#define G8_SB(b, h) ((4 + (b) * 2 + (h)) * HTB)
#define G8_STAGE(bufoff, gbase, voff) do { _Pragma("unroll") for (int _i = 0; _i < 2; ++_i) \
    __builtin_amdgcn_global_load_lds((const unsigned*)((const char*)(gbase) + (voff)[_i]), (unsigned*)(lds + (bufoff) + ldsw + _i * 8192 + lane * 16), 16, 0, 0); } while (0)
#define G8_LDA(dst, b, h) do { _Pragma("unroll") for (int m = 0; m < 4; ++m) _Pragma("unroll") for (int k = 0; k < 2; ++k) dst[m][k] = *(const half8*)(lds + G8_SA(b, h) + aoff + m * 2048 + k * 1024); } while (0)
#define G8_LDB(dst, b, h) do { _Pragma("unroll") for (int n = 0; n < 2; ++n) _Pragma("unroll") for (int k = 0; k < 2; ++k) dst[n][k] = *(const half8*)(lds + G8_SB(b, h) + boff + n * 2048 + k * 1024); } while (0)
#define G8_MMA(ai, bj, At, Bt) do { __builtin_amdgcn_s_setprio(1); _Pragma("unroll") for (int m = 0; m < 4; ++m) _Pragma("unroll") for (int n = 0; n < 2; ++n) _Pragma("unroll") for (int k = 0; k < 2; ++k) \
    acc[ai][bj][m][n] = __builtin_amdgcn_mfma_f32_16x16x32_f16(Bt[n][k], At[m][k], acc[ai][bj][m][n], 0, 0, 0); __builtin_amdgcn_s_setprio(0); } while (0)
#define G8_WAIT_V(n) asm volatile("s_waitcnt vmcnt(" #n ")" ::: "memory")
#define G8_WAIT_L(n) asm volatile("s_waitcnt lgkmcnt(" #n ")" ::: "memory")
#define G8_BAR __builtin_amdgcn_s_barrier()
#define G8_SCHED __builtin_amdgcn_sched_barrier(0)
  Unit2 cur, nxt;
  int ui = 0;
  if (!S.next(0, cur)) return;
  f32x4 acc[2][2][4][2];
#pragma unroll
  for (int a = 0; a < 2; ++a)
#pragma unroll
    for (int b = 0; b < 2; ++b)
#pragma unroll
      for (int m = 0; m < 4; ++m)
#pragma unroll
        for (int n = 0; n < 2; ++n) acc[a][b][m][n] = f32x4{0.f, 0.f, 0.f, 0.f};
  half8 At[4][2], B0[2][2], B1[2][2];
  const char* cA = (const char*)Ab + (size_t)cur.pm * tstepA;
  const char* cB = (const char*)Bb + (size_t)cur.pn * tstepB;
  G8_STAGE(G8_SB(0, 0), cB, voffB0); G8_STAGE(G8_SA(0, 0), cA, voffA); G8_STAGE(G8_SB(0, 1), cB, voffB1); G8_STAGE(G8_SA(0, 1), cA + hstepA, voffA);
  if (wr == 1) G8_BAR;
  G8_WAIT_V(4); G8_BAR;
  G8_STAGE(G8_SB(1, 0), cB + kstep, voffB0); G8_STAGE(G8_SA(1, 0), cA + kstep, voffA); G8_STAGE(G8_SB(1, 1), cB + kstep, voffB1);
  G8_WAIT_V(6); G8_BAR;
  for (;;) {
    const bool has_next = S.next(ui + 1, nxt);
    const char* nA = has_next ? (const char*)Ab + (size_t)nxt.pm * tstepA : cA;
    const char* nB = has_next ? (const char*)Bb + (size_t)nxt.pn * tstepB : cB;
    for (int t = 0; t < nt; t += 2) {
      const bool lastk = (t == nt - 2);
      const char* a1 = cA + (size_t)(t + 1) * kstep;
      const char* a2 = lastk ? nA : cA + (size_t)(t + 2) * kstep;
      const char* b2 = lastk ? nB : cB + (size_t)(t + 2) * kstep;
      const char* a3 = a2 + kstep;
      const char* b3 = b2 + kstep;
      G8_LDB(B0, 0, 0); G8_SCHED; G8_LDA(At, 0, 0); G8_STAGE(G8_SA(1, 1), a1 + hstepA, voffA);
      G8_WAIT_L(8); G8_BAR; G8_WAIT_L(0); G8_MMA(0, 0, At, B0); G8_BAR; G8_SCHED;
      G8_LDB(B1, 0, 1); G8_STAGE(G8_SB(0, 0), b2, voffB0);
      G8_BAR; G8_WAIT_L(0); G8_MMA(0, 1, At, B1); G8_BAR;
      G8_LDA(At, 0, 1); G8_STAGE(G8_SA(0, 0), a2, voffA);
      G8_BAR; G8_WAIT_L(0); G8_MMA(1, 0, At, B0); G8_BAR; G8_SCHED;
      G8_STAGE(G8_SB(0, 1), b2, voffB1);
      G8_WAIT_V(6); G8_BAR; G8_MMA(1, 1, At, B1); G8_BAR;
      G8_LDB(B0, 1, 0); G8_SCHED; G8_LDA(At, 1, 0); G8_STAGE(G8_SA(0, 1), a2 + hstepA, voffA);
      G8_WAIT_L(8); G8_BAR; G8_WAIT_L(0); G8_MMA(0, 0, At, B0); G8_BAR; G8_SCHED;
      G8_LDB(B1, 1, 1); G8_STAGE(G8_SB(1, 0), b3, voffB0);
      G8_BAR; G8_WAIT_L(0); G8_MMA(0, 1, At, B1); G8_BAR;
      G8_LDA(At, 1, 1); G8_STAGE(G8_SA(1, 0), a3, voffA);
      G8_BAR; G8_WAIT_L(0); G8_MMA(1, 0, At, B0); G8_BAR; G8_SCHED;
      G8_STAGE(G8_SB(1, 1), b3, voffB1);
      G8_WAIT_V(6); G8_BAR; G8_MMA(1, 1, At, B1); G8_BAR;
    }
    E(acc, cur, wr, wc, fr, fq);
    if (!has_next) break;
#pragma unroll
    for (int a = 0; a < 2; ++a)
#pragma unroll
      for (int b = 0; b < 2; ++b)
#pragma unroll
        for (int m = 0; m < 4; ++m)
#pragma unroll
          for (int n = 0; n < 2; ++n) acc[a][b][m][n] = f32x4{0.f, 0.f, 0.f, 0.f};
    cur = nxt; cA = nA; cB = nB; ++ui;
  }
  G8_WAIT_V(0);
  if (wr == 0) G8_BAR;
  G8_BAR;
#undef G8_SA
#undef G8_SB
#undef G8_STAGE
#undef G8_LDA
#undef G8_LDB
#undef G8_MMA
#undef G8_WAIT_V
#undef G8_WAIT_L
#undef G8_BAR
#undef G8_SCHED
}
struct XcdSched {
  int total, per, nxb, xcd, j;
  DI void init(int total_) { total = total_; const int G = gridDim.x; if (G & 7) { per = total; nxb = G; xcd = 0; j = blockIdx.x; } else { per = (total + 7) >> 3; nxb = G >> 3; xcd = blockIdx.x & 7; j = blockIdx.x >> 3; } }
  DI int item(int i) const { const int li = j + i * nxb; if (li >= per) return -1; const int lin = xcd * per + li; return lin < total ? lin : -1; }
};

template <class F>
DI void for_items_xcd(int total, F f) {
  const int G = gridDim.x;
  if (G & 7) { for (int it = blockIdx.x; it < total; it += G) f(it); return; }
  const int nxb = G >> 3, xcd = blockIdx.x & 7, j = blockIdx.x >> 3, per = (total + 7) >> 3;
  for (int i = j; i < per; i += nxb) { const int lin = xcd * per + i; if (lin < total) f(lin); }
}

template <int MB>
DI void zero_acc(f32x16 (&acc)[MB][2]) {
#pragma unroll
  for (int mb = 0; mb < MB; ++mb)
#pragma unroll
    for (int nb = 0; nb < 2; ++nb)
#pragma unroll
      for (int v = 0; v < 16; ++v) acc[mb][nb][v] = 0.f;
}

DI void phase_prep(const Params& P, char* smem) {
  const int tid = otid();
  float* mods = (float*)(P.ws + WS_MODS);
  float2* rope = (float2*)(P.ws + WS_ROPE);
  for (int task = blockIdx.x; task < 208; task += gridDim.x) {
    if (task < 192) {
      const int layer = task / 48, n0 = (task % 48) * 64;
      float* s = (float*)smem;
      float* red = s + 17 * 1024;
      for (int i = tid; i < 17 * 1024; i += 512) {
        const int r = i >> 10, k = i & 1023;
        const float v = (r < 16) ? P.c[r * 1024 + k] : P.c_ctx[k];
        s[i] = silu_f(v);
      }
      __syncthreads();
      const int nl = tid & 63, ks = tid >> 6;
      float acc[17];
#pragma unroll
      for (int r = 0; r < 17; ++r) acc[r] = 0.f;
      const float* wp = P.w_mod + ((size_t)layer * 1024 + ks * 128) * 3072 + n0 + nl;
      for (int k = 0; k < 128; ++k) {
        const float wv = wp[(size_t)k * 3072];
#pragma unroll
        for (int r = 0; r < 17; ++r) acc[r] += s[r * 1024 + ks * 128 + k] * wv;
      }
#pragma unroll
      for (int r = 0; r < 17; ++r) red[(ks * 17 + r) * 64 + nl] = acc[r];
      __syncthreads();
      for (int o = tid; o < 17 * 64; o += 512) {
        const int r = o >> 6, n = o & 63;
        float v = P.b_mod[layer * 3072 + n0 + n];
#pragma unroll
        for (int k2 = 0; k2 < 8; ++k2) v += red[(k2 * 17 + r) * 64 + n];
        mods[(layer * 17 + r) * 3072 + n0 + n] = v;
      }
      __syncthreads();
    } else {
      const int base = ((task - 192) * 512 + tid) * 8;
#pragma unroll 1
      for (int e = 0; e < 8; ++e) {
        const int ent = base + e;
        const int t = ent >> 5, a = (ent >> 4) & 1, f = ent & 15;
        const float pos = (float)(a ? (t & 63) : (t >> 6));
        const float inv = powf(10000.f, -(float)f / 16.f);
        float sn, cs;
        sincosf(pos * inv, &sn, &cs);
        rope[ent] = make_float2(cs, sn);
      }
    }
  }
}

DI void cvt_tile(const float* __restrict__ src, int ldn, h16* __restrict__ dst, int ldk, int k0, int n0, float* t) {
  const int tid = otid();
  {
    const int r = tid >> 4, c4 = tid & 15;
#pragma unroll
    for (int i = 0; i < 2; ++i) {
      const int k = r + 32 * i;
      const float4 v = *(const float4*)(src + (size_t)(k0 + k) * ldn + n0 + c4 * 4);
      t[k * 65 + c4 * 4 + 0] = v.x; t[k * 65 + c4 * 4 + 1] = v.y; t[k * 65 + c4 * 4 + 2] = v.z; t[k * 65 + c4 * 4 + 3] = v.w;
    }
  }
  __syncthreads();
  {
    const int n = tid >> 3, kc = tid & 7;
    half8 o;
#pragma unroll
    for (int j = 0; j < 8; ++j) o[j] = (h16)t[(kc * 8 + j) * 65 + n];
    *(half8*)(dst + (size_t)(n0 + n) * ldk + k0 + kc * 8) = o;
  }
  __syncthreads();
}

DI void cvt_layer_weights(const Params& P, int layer, int t0, int step, char* smem) {
  h16* winT = (h16*)(P.ws + wbase(layer));
  h16* wbrT = (h16*)(P.ws + wbase(layer) + OFF_WBRT);
  h16* woutT = (h16*)(P.ws + wbase(layer) + OFF_WOUTT);
  for (int t = t0; t < 2112 + 384 + 256; t += step) {
    if (t < 2112) {
      cvt_tile(P.w_in + (size_t)layer * D * IN_COLS, IN_COLS, winT, LDH, (t & 15) * 64, (t >> 4) * 64, (float*)smem);
    } else if (t < 2112 + 384) {
      const int u = t - 2112, br = u >> 7, v = u & 127;
      cvt_tile(P.w_branch + ((size_t)layer * 3 + br) * WB * D, D, wbrT + (size_t)br * D * LDY, LDY, (v & 7) * 64, (v >> 3) * 64, (float*)smem);
    } else {
      const int u = t - 2112 - 384;
      cvt_tile(P.w_out + (size_t)layer * D * D, D, woutT, LDH, (u & 15) * 64, (u >> 4) * 64, (float*)smem);
    }
  }
}

DI void phase_norm(const Params& P, int layer, char* smem) {
  const int tid = otid(), w = tid >> 6, lane = tid & 63;
  if (layer == 0) cvt_layer_weights(P, 0, blockIdx.x, gridDim.x, smem);
  const int gw = blockIdx.x * 8 + w, nw = gridDim.x * 8;
  const float* mods = (const float*)(P.ws + WS_MODS) + (size_t)layer * 17 * 3072;
  const float* ng = P.norm_g + layer * D;
  h16* hb = (h16*)(P.ws + WS_H16);
  for (int row = gw; row < T_ALL; row += nw) {
    const float* src;
    int b;
    if (row < T_LAT) { src = (layer == 0 ? P.x : P.out) + (size_t)row * D; b = row >> 11; }
    else { const int rc = row - T_LAT; src = (layer == 0 ? P.ctx : (const float*)(P.ws + WS_CTXW)) + (size_t)rc * D; b = 16; }
    const float* md = mods + b * 3072;
    float4 xv[4];
    float ss = 0.f;
#pragma unroll
    for (int j = 0; j < 4; ++j) {
      xv[j] = *(const float4*)(src + j * 256 + lane * 4);
      ss += xv[j].x * xv[j].x + xv[j].y * xv[j].y + xv[j].z * xv[j].z + xv[j].w * xv[j].w;
    }
#pragma unroll
    for (int m = 32; m >= 1; m >>= 1) ss += __shfl_xor(ss, m);
    const float rstd = rsqrtf(ss * (1.f / 1024.f) + 1e-6f);
#pragma unroll
    for (int j = 0; j < 4; ++j) {
      const int k = j * 256 + lane * 4;
      const float4 g = *(const float4*)(ng + k);
      const float4 sh = *(const float4*)(md + k);
      const float4 sc = *(const float4*)(md + 1024 + k);
      *(half4*)(hb + (size_t)row * LDH + k) = cvt4(xv[j].x * rstd * g.x * (1.f + sc.x) + sh.x, xv[j].y * rstd * g.y * (1.f + sc.y) + sh.y,
                                                  xv[j].z * rstd * g.z * (1.f + sc.z) + sh.z, xv[j].w * rstd * g.w * (1.f + sc.w) + sh.w);
    }
  }
  float* h2 = (float*)(P.ws + WS_H2);
  const float* w1 = P.fw1 + layer * 33 * 64;
  const float* w2 = P.fw2 + layer * 64 * 64;
  const float f0 = P.ffreq[layer * 128 + lane], f1 = P.ffreq[layer * 128 + 64 + lane];
  const float b1 = P.fb1[layer * 64 + lane], b2 = P.fb2[layer * 64 + lane];
  for (int p = gw; p < SEQ + CTXL; p += nw) {
    const int L = p >= SEQ ? CTXL : SEQ, tau = p >= SEQ ? p - SEQ : p;
    const float tt = (float)tau / (float)(L - 1);
    const float wv = (6.283185307179586f / (float)L) * (float)tau;
    float feat = 0.f;
    if (lane == 0) feat = tt;
    else if (lane <= 16) feat = cosf(wv * (1e-4f + (float)(lane - 1) * ((15.f - 1e-4f) / 15.f)));
    else if (lane <= 32) feat = sinf(wv * (1e-4f + (float)(lane - 17) * ((15.f - 1e-4f) / 15.f)));
    float a1 = b1;
    for (int e = 0; e < 33; ++e) a1 += __shfl(feat, e) * w1[e * 64 + lane];
    const float h1 = sinf(f0 * a1);
    float a2 = b2;
    for (int k = 0; k < 64; ++k) a2 += __shfl(h1, k) * w2[k * 64 + lane];
    h2[(size_t)p * 64 + lane] = sinf(f1 * a2);
  }
}

DI void filt2_task(const Params& P, int layer, int set, int o, int cg16, char* smem) {
  const int tid = otid();
  const int L = set ? CTXL : SEQ, KLEN = set ? KLEN_C : KLEN_L, OFF = set ? KOFF_C : KOFF_L;
  h16* krb = (h16*)(P.ws + (set ? WS_KRC : WS_KRL));
  const float* h2 = (const float*)(P.ws + WS_H2) + (set ? (size_t)SEQ * 64 : 0);
  float* invS = (float*)(P.ws + WS_INVS);
  const int c0 = cg16 * 16;
  float* w3s = (float*)smem;
  float* part = w3s + 2048;
  for (int i = tid; i < 2048; i += 512) {
    const int k = i >> 5, d = (i >> 4) & 1, cc = i & 15;
    w3s[i] = P.fw3[((size_t)layer * 64 + k) * 2048 + (o * 2 + d) * 512 + c0 + cc];
  }
  __syncthreads();
  const int cc = tid & 15, sl = tid >> 4, c = c0 + cc;
  const float b30 = P.fb3[layer * 2048 + (o * 2 + 0) * 512 + c], b31 = P.fb3[layer * 2048 + (o * 2 + 1) * 512 + c];
  const float MIN_DECAY = -3.0701134573253940f, MAX_DECAY = -15.350567286626974f;
  const float delta = fabsf(MIN_DECAY + (float)c * ((MAX_DECAY - MIN_DECAY) / 511.f));
  h16* kr = krb + (size_t)(o * 512 + c) * KLEN;
  const int nper = L >> 5;
  float sum = 0.f;
  for (int tau = sl * nper; tau < (sl + 1) * nper; ++tau) {
    const float4* hr = (const float4*)(h2 + (size_t)tau * 64);
    float v0 = b30, v1 = b31;
#pragma unroll
    for (int kc = 0; kc < 16; ++kc) {
      const float4 hv = hr[kc];
      v0 += hv.x * w3s[(kc * 4 + 0) * 32 + cc] + hv.y * w3s[(kc * 4 + 1) * 32 + cc] + hv.z * w3s[(kc * 4 + 2) * 32 + cc] + hv.w * w3s[(kc * 4 + 3) * 32 + cc];
      v1 += hv.x * w3s[(kc * 4 + 0) * 32 + 16 + cc] + hv.y * w3s[(kc * 4 + 1) * 32 + 16 + cc] + hv.z * w3s[(kc * 4 + 2) * 32 + 16 + cc] + hv.w * w3s[(kc * 4 + 3) * 32 + 16 + cc];
    }
    const float tt = (float)tau / (float)(L - 1);
    const float dec = expf(-tt * delta);
    v0 *= dec; v1 *= dec;
    kr[OFF - tau] = (h16)v0;
    sum += fabsf(v0);
    if (tau >= 1) { kr[OFF + tau] = (h16)v1; sum += fabsf(v1); }
  }
  for (int z = sl; z < 257; z += 32) {
    const int idx = z < 65 ? z : (OFF + L + (z - 65));
    kr[idx] = (h16)0.f;
  }
  part[sl * 16 + cc] = sum;
  __syncthreads();
  if (tid < 16) {
    float tot = 0.f;
    for (int s2 = 0; s2 < 32; ++s2) tot += part[s2 * 16 + tid];
    invS[(set * 2 + o) * 512 + c0 + tid] = 1.f / tot;
  }
  __syncthreads();
}

struct SchedH {
  XcdSched xs;
  DI bool next(int i, Unit2& u) const { const int it = xs.item(i); if (it < 0) return false; u.pm = (it & 31) >> 2; u.pn = (it >> 5) * 4 + (it & 3); return true; }
};
struct EpiH {
  h16* hT;
  DI void operator()(const f32x4 (&acc)[2][2][4][2], const Unit2& u, int wr_, int wc_, int fr_, int fq_) const {
    const int tid2 = otid(), wid2 = tid2 >> 6, wr = wid2 >> 2, wc = wid2 & 3, fr = tid2 & 15, fq = (tid2 >> 4) & 3;
    const bool gate = u.pm >= 6;
    const int tok0 = u.pn * 256;
    const bool isctx = tok0 >= T_LAT;
#pragma unroll
    for (int ai = 0; ai < 2; ++ai)
#pragma unroll
      for (int m = 0; m < 4; ++m) {
        const int col = u.pm * 256 + ai * 128 + wr * 64 + m * 16 + fr;
#pragma unroll
        for (int bj = 0; bj < 2; ++bj)
#pragma unroll
          for (int n = 0; n < 2; ++n) {
            const int grow = tok0 + bj * 128 + wc * 32 + n * 16 + 4 * fq;
            float v0 = acc[ai][bj][m][n][0], v1 = acc[ai][bj][m][n][1], v2 = acc[ai][bj][m][n][2], v3 = acc[ai][bj][m][n][3];
            if (gate) { v0 = silu_f(v0); v1 = silu_f(v1); v2 = silu_f(v2); v3 = silu_f(v3); }
            h16* dst;
            if (!isctx) { const int b = grow >> 11, tt = grow & 2047; dst = hT + ((size_t)(b * 2048 + col) * SEQ + tt); }
            else { const int rc = grow - T_LAT, b = rc >> 8, tt = rc & 255; dst = hT + HTC_OFF + ((size_t)(b * 2048 + col) * CTXL + tt); }
            *(half4*)dst = cvt4(v0, v1, v2, v3);
          }
      }
  }
};
DI void phase_gemm_h(const Params& P, int layer, char* smem) {
  const bool last = layer == DEPTH - 1;
  const int n_mt = last ? 128 : 144;
  {
    const int nfilt = last ? 64 : 128;
    const int G = gridDim.x, first = G - (G >> 1);
    for (int item = (int)blockIdx.x - first; item >= 0 && item < nfilt; item += (G >> 1)) {
      const int id = nfilt - 1 - item;
      filt2_task(P, layer, id >> 6, (id & 63) >> 5, id & 31, smem);
    }
  }
  SchedH S; S.xs.init(n_mt * 8);
  EpiH E; E.hT = (h16*)(P.ws + WS_R1);
  gemm256_stream<false>(smem, (const h16*)(P.ws + wbase(layer)) + (size_t)H_OFF * LDH, LDH, (const h16*)(P.ws + WS_H16), LDH, D, S, E);
}

DI void phase_shortconv(const Params& P, int layer, char* smem) {
  const bool last = layer == DEPTH - 1;
  const int tid = otid(), lane = tid & 63, w = tid >> 6;
  const int gw = blockIdx.x * 8 + w, nw = gridDim.x * 8;
  h16* hT = (h16*)(P.ws + WS_R1);
  const float* cw = P.conv_h + (size_t)layer * 3 * 1536;
  const int nrows_l = NBATCH * 1536;
  const int nrows = last ? nrows_l : 2 * nrows_l;
  for (int r = gw; r < nrows; r += nw) {
    if (r < nrows_l) {
      const int b = r / 1536, col = r % 1536;
      const float w0 = cw[col], w1 = cw[1536 + col], w2 = cw[3072 + col];
      h16* p = hT + (size_t)(b * 2048 + col) * SEQ;
      half8 v[4];
#pragma unroll
      for (int j = 0; j < 4; ++j) v[j] = *(const half8*)(p + j * 512 + lane * 8);
      float prev[4], next[4];
#pragma unroll
      for (int j = 0; j < 4; ++j) {
        const float lastv = (float)v[j][7], firstv = (float)v[j][0];
        float pu = __shfl_up(lastv, 1);
        float nd = __shfl_down(firstv, 1);
        prev[j] = pu; next[j] = nd;
      }
#pragma unroll
      for (int j = 0; j < 4; ++j) {
        const float l63 = (j > 0) ? __shfl((float)v[j > 0 ? j - 1 : 0][7], 63) : 0.f;
        const float f0 = (j < 3) ? __shfl((float)v[j < 3 ? j + 1 : 3][0], 0) : 0.f;
        if (lane == 0) prev[j] = l63;
        if (lane == 63) next[j] = f0;
      }
#pragma unroll
      for (int j = 0; j < 4; ++j) {
        half8 o;
#pragma unroll
        for (int e = 0; e < 8; ++e) {
          const float a = e == 0 ? prev[j] : (float)v[j][e > 0 ? e - 1 : 0];
          const float cc = (float)v[j][e];
          const float d = e == 7 ? next[j] : (float)v[j][e < 7 ? e + 1 : 7];
          o[e] = (h16)(w0 * a + w1 * cc + w2 * d);
        }
        *(half8*)(p + j * 512 + lane * 8) = o;
      }
    } else {
      const int r2 = r - nrows_l;
      const int b = r2 / 1536, col = r2 % 1536;
      const float w0 = cw[col], w1 = cw[1536 + col], w2 = cw[3072 + col];
      h16* p = hT + HTC_OFF + (size_t)(b * 2048 + col) * CTXL;
      const half4 v = *(const half4*)(p + lane * 4);
      float prev = __shfl_up((float)v[3], 1), next = __shfl_down((float)v[0], 1);
      if (lane == 0) prev = 0.f;
      if (lane == 63) next = 0.f;
      half4 o;
      o[0] = (h16)(w0 * prev + w1 * (float)v[0] + w2 * (float)v[1]);
      o[1] = (h16)(w0 * (float)v[0] + w1 * (float)v[1] + w2 * (float)v[2]);
      o[2] = (h16)(w0 * (float)v[1] + w1 * (float)v[2] + w2 * (float)v[3]);
      o[3] = (h16)(w0 * (float)v[2] + w1 * (float)v[3] + w2 * next);
      *(half4*)(p + lane * 4) = o;
    }
  }
}

template <int MODE>
DI void toeplitz_task(const Params& P, int layer, int set, int cg, int chunk, char* smem) {
  const int tid = otid(), w = tid >> 6, lane = tid & 63;
  const int L = set ? CTXL : SEQ, KLEN = set ? KLEN_C : KLEN_L, OFF = set ? KOFF_C : KOFF_L;
  const h16* krg = (const h16*)(P.ws + (set ? WS_KRC : WS_KRL)) + (size_t)(MODE * 512 + cg * 8) * KLEN;
  h16* krs = (h16*)smem;
  char* stg = smem + 8 * KLEN_L * 2;
  for (int i = tid; i < KLEN; i += 512) *(half8*)(krs + i * 8) = *(const half8*)(krg + i * 8);
  __syncthreads();
  const int c = cg * 8 + w;
  const int bb = lane & 15, kg = lane >> 4;
  const h16* hT = (const h16*)(P.ws + WS_R1) + (set ? HTC_OFF : 0);
  h16* z1T = (h16*)(P.ws + WS_R2) + (set ? Z1C_OFF : 0);
  const h16* Urow = (MODE == 0) ? hT + (size_t)(bb * 2048 + c) * L : z1T + (size_t)(bb * 512 + c) * L;
  const float invs = ((const float*)(P.ws + WS_INVS))[(set * 2 + MODE) * 512 + c];
  const float bias = P.hbias[(layer * 2 + MODE) * 512 + c];
  const int nsteps = (L >> 5) + 1;
  constexpr int GS = 5;
  const int ngroups = (nsteps + GS - 1) / GS;
  const int npass = set ? 1 : 2;
  const h16* krw = krs + w * KLEN;
  for (int pass = 0; pass < npass; ++pass) {
    const int tb = chunk * 512 + pass * 256;
    f32x4 acc[2][8];
#pragma unroll
    for (int ta = 0; ta < 2; ++ta)
#pragma unroll
      for (int r = 0; r < 8; ++r) acc[ta][r] = f32x4{0.f, 0.f, 0.f, 0.f};
    u32x4 cur[2 * GS], nxt[2 * GS];
    auto load_group = [&](int g, u32x4 (&dst)[2 * GS]) {
#pragma unroll
      for (int q = 0; q < GS; ++q) {
        const int s = -32 + (g * GS + q) * 32 + 8 * kg;
        const int s2 = s + 8;
        const int sc = min(max(s, 0), L - 8), sc2 = min(max(s2, 0), L - 8);
        dst[2 * q] = *(const u32x4*)(Urow + sc);
        dst[2 * q + 1] = *(const u32x4*)(Urow + sc2);
      }
    };
    load_group(0, cur);
    const int abase = OFF - tb - 8 * ((lane & 15) - kg);
    half8 afn0 = *(const half8*)(krw + abase - 32), afn1 = *(const half8*)(krw + abase - 32 - 128);
    for (int g = 0; g < ngroups; ++g) {
      load_group(g + 1 < ngroups ? g + 1 : g, nxt);
      __builtin_amdgcn_sched_barrier(0);
#pragma unroll
      for (int q = 0; q < GS; ++q) {
        const int s0 = -32 + (g * GS + q) * 32;
        const half8 af0 = afn0, af1 = afn1;
        afn0 = *(const half8*)(krw + abase + s0 + 32);
        afn1 = *(const half8*)(krw + abase + s0 + 32 - 128);
        unsigned d[8];
        {
          const int sw0 = s0 + 8 * kg, sw1 = sw0 + 8;
          const bool va = (sw0 >= 0) && (sw0 < L), vb = (sw1 >= 0) && (sw1 < L);
#pragma unroll
          for (int e = 0; e < 4; ++e) { d[e] = va ? cur[2 * q][e] : 0u; d[4 + e] = vb ? cur[2 * q + 1][e] : 0u; }
        }
#pragma unroll
        for (int r = 0; r < 8; ++r) {
          u32x4 bw;
#pragma unroll
          for (int e = 0; e < 4; ++e)
            bw[e] = (r & 1) ? __builtin_amdgcn_alignbit(d[(r >> 1) + e + 1 > 7 ? 7 : (r >> 1) + e + 1], d[(r >> 1) + e], 16) : d[(r >> 1) + e];
          const half8 bfr = __builtin_bit_cast(half8, bw);
          acc[0][r] = __builtin_amdgcn_mfma_f32_16x16x32_f16(af0, bfr, acc[0][r], 0, 0, 0);
          acc[1][r] = __builtin_amdgcn_mfma_f32_16x16x32_f16(af1, bfr, acc[1][r], 0, 0, 0);
        }
      }
#pragma unroll
      for (int e = 0; e < 2 * GS; ++e) cur[e] = nxt[e];
    }
#pragma unroll
    for (int ta = 0; ta < 2; ++ta) {
      const int t0 = tb + 128 * ta + 32 * kg;
#pragma unroll
      for (int v = 0; v < 4; ++v) {
        const int t = t0 + 8 * v;
        if (MODE == 0) {
          const half8 x1 = *(const half8*)(hT + (size_t)(bb * 2048 + 512 + c) * L + t);
          const half8 uu = *(const half8*)(Urow + t);
          half8 o;
#pragma unroll
          for (int r = 0; r < 8; ++r) o[r] = (h16)((float)x1[r] * (acc[ta][r][v] * invs + (float)uu[r] * bias));
          *(half8*)(z1T + (size_t)(bb * 512 + c) * L + t) = o;
        } else {
          const half8 x2 = *(const half8*)(hT + (size_t)(bb * 2048 + 1024 + c) * L + t);
          const half8 gt = *(const half8*)(hT + (size_t)(bb * 2048 + 1536 + c) * L + t);
          const half8 uu = *(const half8*)(Urow + t);
#pragma unroll
          for (int r = 0; r < 8; ++r) {
            const float y = (float)x2[r] * (acc[ta][r][v] * invs + (float)uu[r] * bias) * (float)gt[r];
            const int tl = t - tb + r;
            *(h16*)(stg + ((tl * 16 + bb) * 8 + w) * 2) = (h16)y;
          }
        }
      }
    }
    if (MODE == 1) {
      __syncthreads();
      h16* yb = (h16*)(P.ws + WS_YB);
#pragma unroll
      for (int i = 0; i < 8; ++i) {
        const int item = tid + 512 * i;
        const int b = item >> 8, tl = item & 255;
        const size_t tok = set ? (size_t)T_LAT + b * CTXL + tb + tl : (size_t)b * SEQ + tb + tl;
        *(half8*)(yb + tok * LDY + cg * 8) = *(const half8*)(stg + (tl * 16 + b) * 16);
      }
      __syncthreads();
    }
  }
  __syncthreads();
}

template <int MODE>
DI void phase_toeplitz(const Params& P, int layer, char* smem) {
  const bool last = layer == DEPTH - 1;
  const int total = last ? 256 : 320;
  for (int item = blockIdx.x; item < total; item += gridDim.x) {
    if (item < 256) toeplitz_task<MODE>(P, layer, 0, item >> 2, item & 3, smem);
    else toeplitz_task<MODE>(P, layer, 1, item - 256, 0, smem);
  }
}

struct SchedAQ {
  XcdSched xs; bool last;
  DI bool next(int i, Unit2& u) const {
    const int it = xs.item(i); if (it < 0) return false;
    int mt, nt;
    if (last && it >= 128 * 13) { mt = 128 + (it - 128 * 13); nt = 10; }
    else { const int g = it / 52, rem = it % 52; nt = rem >> 2; mt = g * 4 + (rem & 3); }
    u.pm = mt; u.pn = nt < 8 ? nt : nt + 8;
    return true;
  }
};
struct EpiAQ {
  h16 *pa, *qb, *kb, *vT, *zs;
  const float *qg, *kg;
  const float2* rope;
  DI void norm_rope(f32x4 (&x)[2][2], const float* gvec, bool do_rope, int t, int fq) const {
    float ss = 0.f;
#pragma unroll
    for (int bj = 0; bj < 2; ++bj)
#pragma unroll
      for (int n = 0; n < 2; ++n)
#pragma unroll
        for (int v = 0; v < 4; ++v) ss += x[bj][n][v] * x[bj][n][v];
    ss += __shfl_xor(ss, 16);
    ss += __shfl_xor(ss, 32);
    const float rstd = rsqrtf(ss * (1.f / 64.f) + 1e-6f);
#pragma unroll
    for (int bj = 0; bj < 2; ++bj)
#pragma unroll
      for (int n = 0; n < 2; ++n) {
        const float4 g = *(const float4*)(gvec + bj * 32 + n * 16 + 4 * fq);
        x[bj][n][0] *= rstd * g.x; x[bj][n][1] *= rstd * g.y; x[bj][n][2] *= rstd * g.z; x[bj][n][3] *= rstd * g.w;
      }
    if (do_rope) {
#pragma unroll
      for (int bj = 0; bj < 2; ++bj) {
        const float4* rp = (const float4*)(rope + ((size_t)t * 2 + bj) * 16 + 4 * fq);
        const float4 ca = rp[0], cb = rp[1];
        const float cs[4] = {ca.x, ca.z, cb.x, cb.z}, sn[4] = {ca.y, ca.w, cb.y, cb.w};
#pragma unroll
        for (int v = 0; v < 4; ++v) {
          const float x1 = x[bj][0][v], x2 = x[bj][1][v];
          x[bj][0][v] = x1 * cs[v] - x2 * sn[v];
          x[bj][1][v] = x2 * cs[v] + x1 * sn[v];
        }
      }
    }
  }
  DI void operator()(const f32x4 (&acc)[2][2][4][2], const Unit2& u, int wr_, int wc_, int fr_, int fq_) const {
    const int tid2 = otid(), wid2 = tid2 >> 6, wr = wid2 >> 2, wc = wid2 & 3, fr = tid2 & 15, fq = (tid2 >> 4) & 3;
    const int row0 = u.pm * 256;
    const bool isctx = row0 >= T_LAT;
    const int pn = u.pn;
#pragma unroll
    for (int ai = 0; ai < 2; ++ai)
#pragma unroll
      for (int m = 0; m < 4; ++m) {
        const int row = row0 + ai * 128 + wr * 64 + m * 16 + fr;
        int b, t;
        if (!isctx) { b = row >> 11; t = row & 2047; } else { b = (row - T_LAT) >> 8; t = (row - T_LAT) & 255; }
        f32x4 x[2][2];
#pragma unroll
        for (int bj = 0; bj < 2; ++bj)
#pragma unroll
          for (int n = 0; n < 2; ++n) x[bj][n] = acc[ai][bj][m][n];
        if (pn < 8) {
#pragma unroll
          for (int bj = 0; bj < 2; ++bj)
#pragma unroll
            for (int n = 0; n < 2; ++n) {
              f32x4 v = x[bj][n];
              if (pn >= 6) { v[0] = silu_f(v[0]); v[1] = silu_f(v[1]); v[2] = silu_f(v[2]); v[3] = silu_f(v[3]); }
              *(half4*)(pa + (size_t)row * 2048 + pn * 256 + wc * 64 + bj * 32 + n * 16 + 4 * fq) = cvt4(v[0], v[1], v[2], v[3]);
            }
        } else if (pn < 18) {
          const int head = (pn - 16) * 4 + wc;
          norm_rope(x, qg, !isctx, t, fq);
#pragma unroll
          for (int bj = 0; bj < 2; ++bj)
#pragma unroll
            for (int n = 0; n < 2; ++n)
              *(half4*)(qb + (size_t)row * 512 + head * 64 + bj * 32 + n * 16 + 4 * fq) = cvt4(x[bj][n][0], x[bj][n][1], x[bj][n][2], x[bj][n][3]);
        } else if (pn == 18) {
          const int key = isctx ? t : CTXL + t;
          if (wc < 2) {
            norm_rope(x, kg, !isctx, t, fq);
#pragma unroll
            for (int bj = 0; bj < 2; ++bj)
#pragma unroll
              for (int n = 0; n < 2; ++n)
                *(half4*)(kb + ((size_t)(b * 2 + wc) * SKV + key) * 64 + bj * 32 + n * 16 + 4 * fq) = cvt4(x[bj][n][0], x[bj][n][1], x[bj][n][2], x[bj][n][3]);
          } else {
#pragma unroll
            for (int bj = 0; bj < 2; ++bj)
#pragma unroll
              for (int n = 0; n < 2; ++n)
#pragma unroll
                for (int v = 0; v < 4; ++v) vT[((size_t)(b * 2 + (wc - 2)) * 64 + bj * 32 + n * 16 + 4 * fq + v) * SKV + key] = (h16)x[bj][n][v];
          }
        } else {
#pragma unroll
          for (int bj = 0; bj < 2; ++bj)
#pragma unroll
            for (int n = 0; n < 2; ++n)
              *(half4*)(zs + (size_t)row * 512 + (pn - 19) * 256 + wc * 64 + bj * 32 + n * 16 + 4 * fq) =
                  cvt4(silu_f(x[bj][n][0]), silu_f(x[bj][n][1]), silu_f(x[bj][n][2]), silu_f(x[bj][n][3]));
        }
      }
  }
};
DI void phase_gemm_aq(const Params& P, int layer, char* smem) {
  const bool last = layer == DEPTH - 1;
  SchedAQ S; S.last = last; S.xs.init(128 * 13 + (last ? 16 : 16 * 13));
  EpiAQ E;
  E.pa = (h16*)(P.ws + WS_R1); E.qb = (h16*)(P.ws + WS_Q); E.kb = (h16*)(P.ws + WS_K); E.vT = (h16*)(P.ws + WS_VT); E.zs = (h16*)(P.ws + WS_ZS);
  E.qg = P.qg + layer * 64; E.kg = P.kg + layer * 64; E.rope = (const float2*)(P.ws + WS_ROPE);
  if (!last) {
    const int G = gridDim.x;
    if ((G & 7) == 0) {
      const int nxb = G >> 3, per = (128 * 13 + 16 * 13 + 7) >> 3, nlong = per - (per / nxb) * nxb;
      const int j = blockIdx.x >> 3, xcd = blockIdx.x & 7;
      if (j >= nlong) cvt_layer_weights(P, layer + 1, (j - nlong) * 8 + xcd, (nxb - nlong) * 8, smem);
    } else cvt_layer_weights(P, layer + 1, blockIdx.x, G, smem);
  }
  gemm256_stream<true>(smem, (const h16*)(P.ws + WS_H16), LDH, (const h16*)(P.ws + wbase(layer)), LDH, D, S, E);
}

DI void attn_task(const Params& P, int set, int b, int kvh, int qt, char* smem) {
  const int tid = otid(), w = tid >> 6, lane = tid & 63, r32 = lane & 31, hh = lane >> 5;
  const int head = kvh * 4 + (w & 3), qsub = w >> 2;
  const int nkeys = set ? CTXL : SKV;
  const size_t row0 = (set ? (size_t)T_LAT + b * CTXL : (size_t)b * SEQ) + qt * 128 + qsub * 64 + r32;
  const h16* qb = (const h16*)(P.ws + WS_Q);
  h16* yc = (h16*)(P.ws + WS_YC);
  const h16* zs = (const h16*)(P.ws + WS_ZS);
  const h16* kg = (const h16*)(P.ws + WS_K) + (size_t)(b * 2 + kvh) * SKV * 64;
  const h16* vg = (const h16*)(P.ws + WS_VT) + (size_t)(b * 2 + kvh) * 64 * SKV;
  half8 qf[2][4];
#pragma unroll
  for (int qi = 0; qi < 2; ++qi)
#pragma unroll
    for (int ds = 0; ds < 4; ++ds) qf[qi][ds] = *(const half8*)(qb + (row0 + 32 * qi) * 512 + head * 64 + 16 * ds + 8 * hh);
  const int srow = tid >> 3, sch = tid & 7, ssw = (srow >> 1) & 7;
  const int k_wr = srow * 128 + ((sch ^ ssw) * 16);
  const int u = sch >> 1, od = sch & 1;
  const int v_wr0 = 8192 + srow * 128 + (((2 * u) ^ ssw) * 16) + 8 * od;
  const int v_wr1 = 8192 + srow * 128 + (((2 * u + 1) ^ ssw) * 16) + 8 * od;
  const int sw = (r32 >> 1) & 7;
  const int ntile = nkeys >> 6;
  half8 kreg = *(const half8*)(kg + (size_t)srow * 64 + sch * 8);
  half8 vreg = *(const half8*)(vg + (size_t)srow * SKV + sch * 8);
  {
    char* s = smem;
    *(half8*)(s + k_wr) = kreg;
    half4 lo, hi;
    lo[0] = vreg[0]; lo[1] = vreg[1]; lo[2] = vreg[2]; lo[3] = vreg[3];
    hi[0] = vreg[4]; hi[1] = vreg[5]; hi[2] = vreg[6]; hi[3] = vreg[7];
    *(half4*)(s + v_wr0) = lo;
    *(half4*)(s + v_wr1) = hi;
  }
  __syncthreads();
  f32x16 o[2][2];
#pragma unroll
  for (int qi = 0; qi < 2; ++qi)
#pragma unroll
    for (int v = 0; v < 16; ++v) { o[qi][0][v] = 0.f; o[qi][1][v] = 0.f; }
  float m_run[2] = {-1e30f, -1e30f}, l_run[2] = {0.f, 0.f};
  const float cscale = 0.125f * 1.4426950408889634f;
  asm volatile("" : "+v"(qf[0][0]), "+v"(qf[0][1]), "+v"(qf[0][2]), "+v"(qf[0][3]), "+v"(qf[1][0]), "+v"(qf[1][1]), "+v"(qf[1][2]), "+v"(qf[1][3]));
#pragma unroll 1
  for (int kt = 0; kt < ntile; ++kt) {
    if (kt + 1 < ntile) {
      kreg = *(const half8*)(kg + (size_t)((kt + 1) * 64 + srow) * 64 + sch * 8);
      vreg = *(const half8*)(vg + (size_t)srow * SKV + (kt + 1) * 64 + sch * 8);
    }
    const char* s = smem + (kt & 1) * 16384;
    f32x16 sc[2][2];
#pragma unroll
    for (int qi = 0; qi < 2; ++qi)
#pragma unroll
      for (int v = 0; v < 16; ++v) { sc[qi][0][v] = 0.f; sc[qi][1][v] = 0.f; }
#pragma unroll
    for (int ds = 0; ds < 4; ++ds) {
      const int co = ((2 * ds + hh) ^ sw) * 16;
      const half8 k0 = *(const half8*)(s + r32 * 128 + co);
      const half8 k1 = *(const half8*)(s + (32 + r32) * 128 + co);
#pragma unroll
      for (int qi = 0; qi < 2; ++qi) {
        sc[qi][0] = __builtin_amdgcn_mfma_f32_32x32x16_f16(k0, qf[qi][ds], sc[qi][0], 0, 0, 0);
        sc[qi][1] = __builtin_amdgcn_mfma_f32_32x32x16_f16(k1, qf[qi][ds], sc[qi][1], 0, 0, 0);
      }
    }
#pragma unroll
    for (int qi = 0; qi < 2; ++qi) {
      float mx = sc[qi][0][0];
#pragma unroll
      for (int v = 0; v < 16; ++v) { mx = fmaxf(mx, sc[qi][0][v]); mx = fmaxf(mx, sc[qi][1][v]); }
      mx = fmaxf(mx, __shfl_xor(mx, 32));
      const float m_new = fmaxf(m_run[qi], mx * cscale);
      const float alpha = __builtin_amdgcn_exp2f(m_run[qi] - m_new);
      m_run[qi] = m_new;
      float ps = 0.f;
#pragma unroll
      for (int v = 0; v < 16; ++v) {
        sc[qi][0][v] = __builtin_amdgcn_exp2f(sc[qi][0][v] * cscale - m_new); ps += sc[qi][0][v];
        sc[qi][1][v] = __builtin_amdgcn_exp2f(sc[qi][1][v] * cscale - m_new); ps += sc[qi][1][v];
      }
      l_run[qi] = l_run[qi] * alpha + ps;
#pragma unroll
      for (int v = 0; v < 16; ++v) { o[qi][0][v] *= alpha; o[qi][1][v] *= alpha; }
    }
#pragma unroll
    for (int uu = 0; uu < 4; ++uu) {
      const int co = ((2 * uu + hh) ^ sw) * 16;
      const half8 v0 = *(const half8*)(s + 8192 + r32 * 128 + co);
      const half8 v1 = *(const half8*)(s + 8192 + (32 + r32) * 128 + co);
#pragma unroll
      for (int qi = 0; qi < 2; ++qi) {
        half8 pf;
#pragma unroll
        for (int j = 0; j < 8; ++j) pf[j] = (h16)((uu < 2) ? sc[qi][0][8 * (uu & 1) + j] : sc[qi][1][8 * (uu & 1) + j]);
        o[qi][0] = __builtin_amdgcn_mfma_f32_32x32x16_f16(v0, pf, o[qi][0], 0, 0, 0);
        o[qi][1] = __builtin_amdgcn_mfma_f32_32x32x16_f16(v1, pf, o[qi][1], 0, 0, 0);
      }
    }
    if (kt + 1 < ntile) {
      char* s2 = smem + ((kt + 1) & 1) * 16384;
      *(half8*)(s2 + k_wr) = kreg;
      half4 lo, hi;
      lo[0] = vreg[0]; lo[1] = vreg[1]; lo[2] = vreg[2]; lo[3] = vreg[3];
      hi[0] = vreg[4]; hi[1] = vreg[5]; hi[2] = vreg[6]; hi[3] = vreg[7];
      *(half4*)(s2 + v_wr0) = lo;
      *(half4*)(s2 + v_wr1) = hi;
    }
    __syncthreads();
  }
#pragma unroll
  for (int qi = 0; qi < 2; ++qi) {
    const float ltot = l_run[qi] + __shfl_xor(l_run[qi], 32);
    const float inv = 1.f / ltot;
    const size_t row = row0 + 32 * qi;
#pragma unroll
    for (int db = 0; db < 2; ++db)
#pragma unroll
      for (int g = 0; g < 4; ++g) {
        const size_t off = row * 512 + head * 64 + db * 32 + 8 * g + 4 * hh;
        const half4 z = *(const half4*)(zs + off);
        const f32x16& oo = o[qi][db];
        *(half4*)(yc + row * LDY + head * 64 + db * 32 + 8 * g + 4 * hh) = cvt4(oo[4 * g] * inv * (float)z[0], oo[4 * g + 1] * inv * (float)z[1], oo[4 * g + 2] * inv * (float)z[2], oo[4 * g + 3] * inv * (float)z[3]);
      }
  }
}

DI void phase_attn(const Params& P, int layer, char* smem) {
  const bool last = layer == DEPTH - 1;
  const int n_lat = NBATCH * 2 * 16;
  const int total = n_lat + (last ? 0 : NBATCH * 2 * 2);
  for (int item = blockIdx.x; item < total; item += gridDim.x) {
    if (item < n_lat) attn_task(P, 0, item >> 5, (item >> 4) & 1, item & 15, smem);
    else { const int u = item - n_lat; attn_task(P, 1, u >> 2, (u >> 1) & 1, u & 1, smem); }
  }
  const int tid = otid(), lane = tid & 63, w = tid >> 6;
  const int gw = blockIdx.x * 8 + w, nw = gridDim.x * 8;
  const h16* pa = (const h16*)(P.ws + WS_R1);
  h16* ya = (h16*)(P.ws + WS_R2);
  const int nitems = (last ? T_LAT : T_ALL) / 8;
  const float* cw = P.conv_a + (size_t)layer * 3 * 512 + lane * 8;
  float w0[8], w1[8], w2[8];
#pragma unroll
  for (int e = 0; e < 8; ++e) { w0[e] = cw[e]; w1[e] = cw[512 + e]; w2[e] = cw[1024 + e]; }
  for (int it = gw; it < nitems; it += nw) {
    const int tk0 = it * 8;
    int t0, L;
    if (tk0 < T_LAT) { t0 = tk0 & 2047; L = SEQ; } else { t0 = (tk0 - T_LAT) & 255; L = CTXL; }
    float up[8], uc[8], un[8];
    auto load_u = [&](int dt, float (&dst)[8]) {
      const int t = t0 + dt;
      if (t < 0 || t >= L) {
#pragma unroll
        for (int e = 0; e < 8; ++e) dst[e] = 0.f;
      } else {
        const h16* rp = pa + (size_t)(tk0 + dt) * 2048 + lane * 8;
        const half8 xa = *(const half8*)rp, ca = *(const half8*)(rp + 1024);
#pragma unroll
        for (int e = 0; e < 8; ++e) dst[e] = (float)xa[e] * (float)ca[e];
      }
    };
    load_u(-1, up);
    load_u(0, uc);
#pragma unroll 1
    for (int dt = 0; dt < 8; ++dt) {
      load_u(dt + 1, un);
      const h16* rp = pa + (size_t)(tk0 + dt) * 2048 + lane * 8;
      const half8 ba = *(const half8*)(rp + 512), za = *(const half8*)(rp + 1536);
      half8 o;
#pragma unroll
      for (int e = 0; e < 8; ++e) o[e] = (h16)((float)ba[e] * (w0[e] * up[e] + w1[e] * uc[e] + w2[e] * un[e]) * (float)za[e]);
      *(half8*)(ya + (size_t)(tk0 + dt) * LDY + lane * 8) = o;
#pragma unroll
      for (int e = 0; e < 8; ++e) { up[e] = uc[e]; uc[e] = un[e]; }
    }
  }
}

template <int MB>
DI void merge_tile(const Params& P, int layer, size_t row0, int nt, char* smem) {
  const h16* hb = (const h16*)(P.ws + WS_H16);
  const h16* winT = (const h16*)(P.ws + wbase(layer));
  const h16* wbrT = (const h16*)(P.ws + wbase(layer) + OFF_WBRT);
  h16* mg = (h16*)(P.ws + WS_R1);
  f32x16 macc[MB][2];
  zero_acc<MB>(macc);
#pragma unroll 1
  for (int n = 0; n < 3; ++n) {
    const h16* yn = (const h16*)(P.ws + (n == 0 ? WS_R2 : (n == 1 ? WS_YB : WS_YC)));
    f32x16 pa2[MB][2];
    half8 gpk[MB][2][2];
    zero_acc<MB>(pa2);
    gemm_kloop<MB, true>(pa2, hb + row0 * LDH, LDH, winT + (size_t)(G_OFF + n * 1024 + nt * 256) * LDH, LDH, D, smem);
#pragma unroll
    for (int mb = 0; mb < MB; ++mb)
#pragma unroll
      for (int nb = 0; nb < 2; ++nb)
#pragma unroll
        for (int v = 0; v < 16; ++v) gpk[mb][nb][v >> 3][v & 7] = (h16)sigmoid_f(pa2[mb][nb][v]);
    zero_acc<MB>(pa2);
    gemm_kloop<MB, true>(pa2, yn + row0 * LDY, LDY, wbrT + (size_t)(n * 1024 + nt * 256) * LDY, LDY, WB, smem);
#pragma unroll
    for (int mb = 0; mb < MB; ++mb)
#pragma unroll
      for (int nb = 0; nb < 2; ++nb)
#pragma unroll
        for (int v = 0; v < 16; ++v) macc[mb][nb][v] += (float)gpk[mb][nb][v >> 3][v & 7] * pa2[mb][nb][v];
  }
  const int tid = otid(), lane = tid & 63, w = tid >> 6, wr = w >> 2, wc = w & 3, r32 = lane & 31, hh = lane >> 5;
#pragma unroll
  for (int mb = 0; mb < MB; ++mb) {
    const size_t row = row0 + wr * 32 * MB + mb * 32 + r32;
#pragma unroll
    for (int nb = 0; nb < 2; ++nb)
#pragma unroll
      for (int g = 0; g < 4; ++g)
        *(half4*)(mg + row * LDH + nt * 256 + wc * 64 + nb * 32 + 8 * g + 4 * hh) =
            cvt4(macc[mb][nb][4 * g], macc[mb][nb][4 * g + 1], macc[mb][nb][4 * g + 2], macc[mb][nb][4 * g + 3]);
  }
}
DI void split_rounds(int total, int& nfull, int& nhalf) {
  const int G = gridDim.x;
  nfull = (total / G) * G;
  const int rem = total - nfull;
  if (rem > 0 && 2 * rem <= G) nhalf = 2 * rem; else { nfull = total; nhalf = 0; }
}
DI void phase_merge(const Params& P, int layer, char* smem) {
  const bool last = layer == DEPTH - 1;
  const int total = (last ? T_LAT : T_ALL) / 128 * 4;
  int nfull, nhalf;
  split_rounds(total, nfull, nhalf);
  for_items_xcd(nfull, [&](int item) {
    const int mt = (item >> 5) * 8 + (item & 7), nt = (item & 31) >> 3;
    merge_tile<2>(P, layer, (size_t)mt * 128, nt, smem);
  });
  for_items_xcd(nhalf, [&](int h) {
    const int item = nfull + (h >> 1);
    const int mt = (item >> 5) * 8 + (item & 7), nt = (item & 31) >> 3;
    merge_tile<1>(P, layer, (size_t)mt * 128 + (h & 1) * 64, nt, smem);
  });
}

template <int MB>
DI void out_tile(const Params& P, int layer, int row0, int nt, char* smem) {
  const h16* mg = (const h16*)(P.ws + WS_R1);
  const h16* woutT = (const h16*)(P.ws + wbase(layer) + OFF_WOUTT);
  const float* mods = (const float*)(P.ws + WS_MODS) + (size_t)layer * 17 * 3072;
  float* ctxw = (float*)(P.ws + WS_CTXW);
  f32x16 acc[MB][2];
  zero_acc<MB>(acc);
  gemm_kloop<MB, true>(acc, mg + (size_t)row0 * LDH, LDH, woutT + (size_t)(nt * 256) * LDH, LDH, D, smem);
  const int tid = otid(), lane = tid & 63, w = tid >> 6, wr = w >> 2, wc = w & 3, r32 = lane & 31, hh = lane >> 5;
#pragma unroll
  for (int mb = 0; mb < MB; ++mb) {
    const int row = row0 + wr * 32 * MB + mb * 32 + r32;
    const float* src; float* dst; int b;
    if (row < T_LAT) { b = row >> 11; src = (layer == 0 ? P.x : P.out) + (size_t)row * D; dst = P.out + (size_t)row * D; }
    else { const int rc = row - T_LAT; b = 16; src = (layer == 0 ? P.ctx : ctxw) + (size_t)rc * D; dst = ctxw + (size_t)rc * D; }
    const float* gt = mods + b * 3072 + 2048;
#pragma unroll
    for (int nb = 0; nb < 2; ++nb)
#pragma unroll
      for (int g = 0; g < 4; ++g) {
        const int col = nt * 256 + wc * 64 + nb * 32 + 8 * g + 4 * hh;
        const float4 xo = *(const float4*)(src + col);
        const float4 gv = *(const float4*)(gt + col);
        float4 r;
        r.x = xo.x + gv.x * acc[mb][nb][4 * g]; r.y = xo.y + gv.y * acc[mb][nb][4 * g + 1];
        r.z = xo.z + gv.z * acc[mb][nb][4 * g + 2]; r.w = xo.w + gv.w * acc[mb][nb][4 * g + 3];
        *(float4*)(dst + col) = r;
      }
  }
}
DI void phase_out(const Params& P, int layer, char* smem) {
  const bool last = layer == DEPTH - 1;
  const int total = (last ? T_LAT : T_ALL) / 128 * 4;
  int nfull, nhalf;
  split_rounds(total, nfull, nhalf);
  for_items_xcd(nfull, [&](int item) {
    const int mt = (item >> 5) * 8 + (item & 7), nt = (item & 31) >> 3;
    out_tile<2>(P, layer, mt * 128, nt, smem);
  });
  for_items_xcd(nhalf, [&](int h) {
    const int item = nfull + (h >> 1);
    const int mt = (item >> 5) * 8 + (item & 7), nt = (item & 31) >> 3;
    out_tile<1>(P, layer, mt * 128 + (h & 1) * 64, nt, smem);
  });
}

#define XB_TMO      128
#define XB_XCNT(j)  (256  + 64 * (j))
#define XB_XSUB(j)  (1280 + 64 * (j))
#define XB_XGEN(j)  (2304 + 64 * (j))
#define XB_TOP      3328
#define XB_TOPGEN   3392
#define XCD_BAR_WORDS 3456
#define XB_SPIN_CAP (1u << 20)
#define LAS __attribute__((address_space(3)))
DI unsigned xb_ld(unsigned* p) { return __hip_atomic_load(p, __ATOMIC_RELAXED, __HIP_MEMORY_SCOPE_AGENT); }
DI unsigned xb_add(unsigned* p, unsigned v) { return __hip_atomic_fetch_add(p, v, __ATOMIC_RELAXED, __HIP_MEMORY_SCOPE_AGENT); }
DI unsigned xb_xcc_id() { return (unsigned)__builtin_amdgcn_s_getreg((3 << 11) | 20) & 0xFu; }
#define XB_SPIN(cond, bar) do { unsigned _sp = 0; while (cond) { __builtin_amdgcn_s_sleep(1); \
    if ((++_sp & 255u) == 0u) { if (xb_ld(&(bar)[XB_TMO])) break; if (_sp > XB_SPIN_CAP) { atomicAdd(&(bar)[XB_TMO], 1u); break; } } } } while (0)
struct XcdBarrier { unsigned* bar; unsigned x; volatile LAS unsigned* st; };
DI XcdBarrier xcd_barrier_post(unsigned* bar, volatile LAS unsigned* st) {
  XcdBarrier b; b.bar = bar; b.x = xb_xcc_id(); b.st = st;
  if (threadIdx.x == 0) (void)xb_add(&bar[XB_XCNT(b.x)], 1u);
  return b;
}
DI void xcd_barrier_complete(unsigned* bar, unsigned x, unsigned& nloc, unsigned& nx) {
  const unsigned G = gridDim.x;
  unsigned sum, cnt, mine, sp = 0u;
  for (;;) {
    sum = 0u; cnt = 0u; mine = 0u;
#pragma unroll
    for (unsigned j = 0; j < 16; ++j) { const unsigned c = xb_ld(&bar[XB_XCNT(j)]); sum += c; cnt += (c > 0u) ? 1u : 0u; mine = (j == x) ? c : mine; }
    if (sum == G) break;
    __builtin_amdgcn_s_sleep(1);
    if ((++sp & 255u) == 0u) { if (xb_ld(&bar[XB_TMO])) break; if (sp > XB_SPIN_CAP) { atomicAdd(&bar[XB_TMO], 1u); break; } }
  }
  nloc = mine > 0u ? mine : 1u; nx = cnt > 0u ? cnt : 1u;
}
DI void xcd_barrier(const XcdBarrier& b) {
  asm volatile("s_waitcnt vmcnt(0)" ::: "memory");
  __syncthreads();
  if (threadIdx.x == 0) {
    unsigned* bar = b.bar;
    asm volatile("" : "+s"(bar));
    __builtin_amdgcn_s_waitcnt(0);
    unsigned nloc = b.st[0], nx = b.st[1];
    if (nloc == 0u) { xcd_barrier_complete(bar, b.x, nloc, nx); b.st[0] = nloc; b.st[1] = nx; }
    const unsigned old = xb_add(&bar[XB_XSUB(b.x)], 1u);
    const unsigned gen = old / nloc;
    if (old + 1u == (gen + 1u) * nloc) {
      __builtin_amdgcn_fence(__ATOMIC_RELEASE, "agent");
      asm volatile("s_waitcnt vmcnt(0)" ::: "memory");
      const unsigned og = xb_add(&bar[XB_TOP], 1u);
      const unsigned tg = og / nx;
      if (og + 1u == (tg + 1u) * nx) xb_add(&bar[XB_TOPGEN], 1u);
      else XB_SPIN(xb_ld(&bar[XB_TOPGEN]) == tg, bar);
      __builtin_amdgcn_fence(__ATOMIC_ACQUIRE, "agent");
      xb_add(&bar[XB_XGEN(b.x)], 1u);
      asm volatile("s_waitcnt vmcnt(0)" ::: "memory");
    } else {
      XB_SPIN(xb_ld(&bar[XB_XGEN(b.x)]) == gen, bar);
      __builtin_amdgcn_fence(__ATOMIC_ACQUIRE, "agent");
      asm volatile("s_waitcnt vmcnt(0)" ::: "memory");
    }
  }
  __syncthreads();
}

__global__ void __launch_bounds__(512) mega_kernel(Params P) {
  extern __shared__ __attribute__((aligned(16))) char smem[];
  volatile LAS unsigned* xst = (volatile LAS unsigned*)(smem + LDS_BYTES);
  if (threadIdx.x == 0) { xst[0] = 0u; xst[1] = 0u; }
  __syncthreads();
  const XcdBarrier xb = xcd_barrier_post((unsigned*)(P.ws + WS_BAR), xst);
  for (int ph = P.ph_lo; ph < P.ph_hi; ++ph) {
    if (ph == 0) phase_prep(P, smem);
    else {
      const int layer = (ph - 1) / NPH_LAYER, k = (ph - 1) % NPH_LAYER;
#ifndef PROBE_REP
#define PROBE_REP -1
#endif
      const int nrep = (k == PROBE_REP) ? 2 : 1;
      for (int rep = 0; rep < nrep; ++rep) {
      switch (k) {
        case 0: { int lo = layer; asm volatile("" : "+s"(lo)); phase_norm(P, lo, smem); } break;
        case 1: { int lo = layer; asm volatile("" : "+s"(lo)); phase_gemm_h(P, lo, smem); } break;
        case 2: { int lo = layer; asm volatile("" : "+s"(lo)); phase_shortconv(P, lo, smem); } break;
        case 3: { int lo = layer; asm volatile("" : "+s"(lo)); phase_toeplitz<0>(P, lo, smem); } break;
        case 4: { int lo = layer; asm volatile("" : "+s"(lo)); phase_toeplitz<1>(P, lo, smem); } break;
        case 5: { int lo = layer; asm volatile("" : "+s"(lo)); phase_gemm_aq(P, lo, smem); } break;
        case 6: { int lo = layer; asm volatile("" : "+s"(lo)); phase_attn(P, lo, smem); } break;
        case 7: { int lo = layer; asm volatile("" : "+s"(lo)); phase_merge(P, lo, smem); } break;
        default: { int lo = layer; asm volatile("" : "+s"(lo)); phase_out(P, lo, smem); } break;
      }
      if (rep + 1 < nrep) cg::this_grid().sync();
      }
    }
    if (ph + 1 < P.ph_hi) {
      if (ph == P.ph_lo) cg::this_grid().sync();
      else xcd_barrier(xb);
    }
  }
}

extern "C" void kernel_launch(void* const* d_in, const int* in_sizes, int n_in, void* d_out, int out_size, void* d_ws, size_t ws_size,
                              hipStream_t stream) {
  static int grid = 0;
  if (grid == 0) {
    int dev = 0, cus = 0, per_cu = 0;
    hipGetDevice(&dev);
    hipDeviceGetAttribute(&cus, hipDeviceAttributeMultiprocessorCount, dev);
    if (hipFuncSetAttribute((const void*)mega_kernel, hipFuncAttributeMaxDynamicSharedMemorySize, LDS_BYTES + 16) != hipSuccess) {
      fprintf(stderr, "hipFuncSetAttribute failed\n");
      grid = -1;
      return;
    }
    hipOccupancyMaxActiveBlocksPerMultiprocessor(&per_cu, (const void*)mega_kernel, 512, LDS_BYTES + 16);
    if (per_cu < 1) per_cu = 1;
    grid = cus * per_cu;
    if (ws_size < WS_END || n_in != 22) { fprintf(stderr, "workspace too small: %zu < %zu\n", ws_size, (size_t)WS_END); grid = -1; }
  }
  if (grid < 0) return;
  Params p{};
  const float** f = (const float**)&p;
  for (int i = 0; i < 22; ++i) f[i] = (const float*)d_in[i];
  p.out = (float*)d_out;
  p.ws = (char*)d_ws;
#if PER_PHASE_LAUNCH
  for (int ph = 0; ph < NPHASES; ++ph) {
    p.ph_lo = ph; p.ph_hi = ph + 1;
    hipLaunchKernelGGL(mega_kernel, dim3(grid), dim3(512), LDS_BYTES + 16, stream, p);
  }
#else
  p.ph_lo = 0; p.ph_hi = NPHASES;
  if (hipMemsetAsync((char*)d_ws + WS_BAR, 0, XCD_BAR_WORDS * 4, stream) != hipSuccess) { fprintf(stderr, "memset of barrier word failed\n"); return; }
  void* args[] = {&p};
  hipError_t e = hipLaunchCooperativeKernel((const void*)mega_kernel, dim3(grid), dim3(512), args, LDS_BYTES + 16, stream);
  if (e != hipSuccess) fprintf(stderr, "cooperative launch failed: %s (grid %d)\n", hipGetErrorString(e), grid);
#endif
}
```

```cpp
#include <hip/hip_runtime.h>
#include <hip/hip_cooperative_groups.h>
#include <cstdio>
namespace cg = cooperative_groups;

#ifndef PER_PHASE_LAUNCH
#define PER_PHASE_LAUNCH 0
#endif

typedef _Float16 h16;
typedef _Float16 half8 __attribute__((ext_vector_type(8)));
typedef _Float16 half4 __attribute__((ext_vector_type(4)));
typedef float f32x16 __attribute__((ext_vector_type(16)));
typedef float f32x4 __attribute__((ext_vector_type(4)));
typedef unsigned u32x4 __attribute__((ext_vector_type(4)));
#define DI __device__ __forceinline__

constexpr int D = 1024, NBATCH = 16, SEQ = 2048, CTXL = 256, DEPTH = 4, WB = 512;
constexpr int T_LAT = NBATCH * SEQ, T_CTX = NBATCH * CTXL, T_ALL = T_LAT + T_CTX;
constexpr int IN_COLS = 8448, H_OFF = 2048, C_OFF = 4096, K_OFF = 4608, Z_OFF = 4864, G_OFF = 5376;
constexpr int SKV = CTXL + SEQ;
constexpr int KLEN_L = 2 * SEQ + 256, KOFF_L = SEQ + 64;
constexpr int KLEN_C = 2 * CTXL + 256, KOFF_C = CTXL + 64;
constexpr int LDH = 1088, LDY = 576;
constexpr int NPH_LAYER = 9;
constexpr int NPHASES = 1 + DEPTH * NPH_LAYER;
constexpr int LDS_BYTES = 3 * 49152;

constexpr size_t al(size_t x) { return (x + 255) & ~size_t(255); }
constexpr size_t WS_CTXW = 0;
constexpr size_t WS_MODS = WS_CTXW + al((size_t)T_CTX * D * 4);
constexpr size_t WS_ROPE = WS_MODS + al((size_t)DEPTH * 17 * 3072 * 4);
constexpr size_t WS_WINT = WS_ROPE + al((size_t)SEQ * 32 * 8);
constexpr size_t WS_WBRT = WS_WINT + al((size_t)IN_COLS * LDH * 2);
constexpr size_t WS_WOUTT = WS_WBRT + al((size_t)3 * D * LDY * 2);
constexpr size_t WS_H2 = WS_WOUTT + al((size_t)D * LDH * 2);
constexpr size_t WS_KRL = WS_H2 + al((size_t)(SEQ + CTXL) * 64 * 4);
constexpr size_t WS_KRC = WS_KRL + al((size_t)2 * WB * KLEN_L * 2);
constexpr size_t WS_INVS = WS_KRC + al((size_t)2 * WB * KLEN_C * 2);
constexpr size_t WS_H16 = WS_INVS + al((size_t)2 * 2 * WB * 4);
constexpr size_t WS_R1 = WS_H16 + al((size_t)T_ALL * LDH * 2);
constexpr size_t WS_R2 = WS_R1 + al((size_t)T_ALL * 2048 * 2);
constexpr size_t WS_YB = WS_R2 + al((size_t)T_ALL * LDY * 2);
constexpr size_t WS_Q = WS_YB + al((size_t)T_ALL * LDY * 2);
constexpr size_t WS_K = WS_Q + al((size_t)T_ALL * WB * 2);
constexpr size_t WS_VT = WS_K + al((size_t)NBATCH * 2 * SKV * 64 * 2);
constexpr size_t WS_ZS = WS_VT + al((size_t)NBATCH * 2 * SKV * 64 * 2);
constexpr size_t WS_YC = WS_ZS + al((size_t)T_ALL * WB * 2);
constexpr size_t WS_BAR = WS_YC + al((size_t)T_ALL * LDY * 2);
constexpr size_t WS_W1 = WS_BAR + 16384;
constexpr size_t WS_END = WS_W1 + (WS_H2 - WS_WINT);
constexpr size_t OFF_WBRT = WS_WBRT - WS_WINT, OFF_WOUTT = WS_WOUTT - WS_WINT;
constexpr size_t HTC_OFF = (size_t)NBATCH * 2048 * SEQ;
constexpr size_t Z1C_OFF = (size_t)NBATCH * WB * SEQ;

struct Params {
  const float *x, *c, *ctx, *c_ctx, *norm_g, *w_mod, *b_mod, *w_in, *conv_a, *conv_h, *fw1, *fb1, *fw2, *fb2, *fw3, *fb3,
      *ffreq, *hbias, *qg, *kg, *w_branch, *w_out;
  float* out;
  char* ws;
  int ph_lo, ph_hi;
};

DI size_t wbase(int layer) { return (layer & 1) ? WS_W1 : WS_WINT; }
DI float silu_f(float x) { return x / (1.f + __expf(-x)); }
DI float sigmoid_f(float x) { return 1.f / (1.f + __expf(-x)); }
DI half4 cvt4(float a, float b, float c, float d) { half4 r; r[0] = (h16)a; r[1] = (h16)b; r[2] = (h16)c; r[3] = (h16)d; return r; }
DI void wait_vm0() { asm volatile("s_waitcnt vmcnt(0)" ::: "memory"); }
DI int otid() { int t = threadIdx.x; asm volatile("" : "+v"(t)); return t; }

template <int MB, bool SWAP>
DI void gemm_kloop(f32x16 (&acc)[MB][2], const h16* __restrict__ A, int lda, const h16* __restrict__ B, int ldb, int K, char* lds) {
  constexpr int A_BYTES = 64 * MB * 128, B_BYTES = 256 * 128, STAGE = A_BYTES + B_BYTES;
  static_assert(3 * STAGE <= LDS_BYTES, "ring does not fit");
  const int tid = otid(), w = tid >> 6, lane = tid & 63;
  const int wr = w >> 2, wc = w & 3;
  const int lrow = w * 8 + (lane >> 3), pch = lane & 7;
  const int gch = pch ^ ((lrow >> 1) & 7);
  const unsigned voa = (unsigned)(lrow * lda + gch * 8) * 2u, vob = (unsigned)(lrow * ldb + gch * 8) * 2u;
  const int lofs = lrow * 128 + pch * 16;
  const int r32 = lane & 31, hh = lane >> 5, sw = (r32 >> 1) & 7;
  const int a_rd = (wr * 32 * MB + r32) * 128;
  const int b_rd = A_BYTES + (wc * 64 + r32) * 128;
  const int nk = K >> 6;
  constexpr int NP = MB + 4;
  auto piece = [&](int p, int kt, int buf) {
    char* s = lds + buf * STAGE;
    if (p < MB) __builtin_amdgcn_global_load_lds((const unsigned*)((const char*)(A + (size_t)p * 64 * lda + kt * 64) + voa), (unsigned*)(s + p * 8192 + lofs), 16, 0, 0);
    else __builtin_amdgcn_global_load_lds((const unsigned*)((const char*)(B + (size_t)(p - MB) * 64 * ldb + kt * 64) + vob), (unsigned*)(s + A_BYTES + (p - MB) * 8192 + lofs), 16, 0, 0);
  };
  wait_vm0();
#pragma unroll
  for (int p = 0; p < NP; ++p) piece(p, 0, 0);
#pragma unroll
  for (int p = 0; p < NP; ++p) piece(p, 1, 1);
  int cur = 0;
  for (int kt = 0; kt < nk; ++kt) {
    if (kt + 1 < nk) { if (MB == 2) asm volatile("s_waitcnt vmcnt(6)" ::: "memory"); else asm volatile("s_waitcnt vmcnt(5)" ::: "memory"); }
    else wait_vm0();
    __syncthreads();
    const char* s = lds + cur * STAGE;
    const int nbuf = cur == 0 ? 2 : cur - 1;
    const bool more = kt + 2 < nk;
    half8 af[2][MB], bf[2][2];
#pragma unroll
    for (int mb = 0; mb < MB; ++mb) af[0][mb] = *(const half8*)(s + a_rd + mb * 4096 + (((0 + hh) ^ sw) * 16));
#pragma unroll
    for (int nb = 0; nb < 2; ++nb) bf[0][nb] = *(const half8*)(s + b_rd + nb * 4096 + (((0 + hh) ^ sw) * 16));
#pragma unroll
    for (int ks = 0; ks < 4; ++ks) {
      if (ks < 3) {
#pragma unroll
        for (int mb = 0; mb < MB; ++mb) af[(ks + 1) & 1][mb] = *(const half8*)(s + a_rd + mb * 4096 + (((2 * (ks + 1) + hh) ^ sw) * 16));
#pragma unroll
        for (int nb = 0; nb < 2; ++nb) bf[(ks + 1) & 1][nb] = *(const half8*)(s + b_rd + nb * 4096 + (((2 * (ks + 1) + hh) ^ sw) * 16));
      }
      if (more) {
        if (2 * ks < NP) piece(2 * ks, kt + 2, nbuf);
        if (2 * ks + 1 < NP) piece(2 * ks + 1, kt + 2, nbuf);
      }
      __builtin_amdgcn_sched_barrier(0);
      __builtin_amdgcn_s_setprio(1);
#pragma unroll
      for (int mb = 0; mb < MB; ++mb)
#pragma unroll
        for (int nb = 0; nb < 2; ++nb)
          acc[mb][nb] = SWAP ? __builtin_amdgcn_mfma_f32_32x32x16_f16(bf[ks & 1][nb], af[ks & 1][mb], acc[mb][nb], 0, 0, 0)
                             : __builtin_amdgcn_mfma_f32_32x32x16_f16(af[ks & 1][mb], bf[ks & 1][nb], acc[mb][nb], 0, 0, 0);
      __builtin_amdgcn_s_setprio(0);
      __builtin_amdgcn_sched_barrier(0);
    }
    cur = cur == 2 ? 0 : cur + 1;
  }
  __syncthreads();
}

DI int lds_byte16(int r, int c) { const int st = (r >> 4) * 2 + (c >> 5), rr = r & 15, cc = c & 31, ob = rr * 64 + cc * 2; return st * 1024 + (ob ^ (((ob >> 9) & 1) << 5)); }
DI void stage_rc16(int b, int& R, int& C) { const int st = b / 1024, sb = b % 1024, swz = sb ^ (((sb >> 9) & 1) << 5); R = (st >> 1) * 16 + swz / 64; C = (st & 1) * 32 + (swz % 64) / 2; }
struct Unit2 { int pm, pn; };
template <bool HEADPERM, class Sched, class Epi>
DI void gemm256_stream(char* lds, const h16* __restrict__ Ab, int lda, const h16* __restrict__ Bb, int ldb, int K, const Sched& S, const Epi& E) {
  constexpr int HTB = 128 * 64 * 2;
  const int tid = otid(), wid = __builtin_amdgcn_readfirstlane(tid >> 6), lane = tid & 63, wr = wid >> 2, wc = wid & 3, fr = lane & 15, fq = lane >> 4;
  const int nt = K / 64;
  unsigned voffA[2], voffB0[2], voffB1[2];
#pragma unroll
  for (int i = 0; i < 2; ++i) {
    int R, C;
    stage_rc16(tid * 16 + i * 8192, R, C);
    voffA[i] = (unsigned)(R * lda + C) * 2u;
    if (HEADPERM) {
      const int rb = (R >> 5) * 64 + (R & 31);
      voffB0[i] = (unsigned)(rb * ldb + C) * 2u;
      voffB1[i] = (unsigned)((rb + 32) * ldb + C) * 2u;
    } else {
      voffB0[i] = (unsigned)(R * ldb + C) * 2u;
      voffB1[i] = (unsigned)((R + 128) * ldb + C) * 2u;
    }
  }
  const size_t kstep = 128;
  const size_t hstepA = (size_t)128 * lda * 2;
  const size_t tstepA = 2 * hstepA, tstepB = (size_t)256 * ldb * 2;
  const unsigned ldsw = (unsigned)wid * 1024u;
  const int aoff = lds_byte16(wr * 64 + fr, fq * 8), boff = lds_byte16(wc * 32 + fr, fq * 8);
#define G8_SA(b, h) (((b) * 2 + (h)) * HTB)
#define G8_SB(b, h) ((4 + (b) * 2 + (h)) * HTB)
#define G8_STAGE(bufoff, gbase, voff) do { _Pragma("unroll") for (int _i = 0; _i < 2; ++_i) \
    __builtin_amdgcn_global_load_lds((const unsigned*)((const char*)(gbase) + (voff)[_i]), (unsigned*)(lds + (bufoff) + ldsw + _i * 8192 + lane * 16), 16, 0, 0); } while (0)
#define G8_LDA(dst, b, h) do { _Pragma("unroll") for (int m = 0; m < 4; ++m) _Pragma("unroll") for (int k = 0; k < 2; ++k) dst[m][k] = *(const half8*)(lds + G8_SA(b, h) + aoff + m * 2048 + k * 1024); } while (0)
#define G8_LDB(dst, b, h) do { _Pragma("unroll") for (int n = 0; n < 2; ++n) _Pragma("unroll") for (int k = 0; k < 2; ++k) dst[n][k] = *(const half8*)(lds + G8_SB(b, h) + boff + n * 2048 + k * 1024); } while (0)
#define G8_MMA(ai, bj, At, Bt) do { __builtin_amdgcn_s_setprio(1); _Pragma("unroll") for (int m = 0; m < 4; ++m) _Pragma("unroll") for (int n = 0; n < 2; ++n) _Pragma("unroll") for (int k = 0; k < 2; ++k) \
    acc[ai][bj][m][n] = __builtin_amdgcn_mfma_f32_16x16x32_f16(Bt[n][k], At[m][k], acc[ai][bj][m][n], 0, 0, 0); __builtin_amdgcn_s_setprio(0); } while (0)
#define G8_WAIT_V(n) asm volatile("s_waitcnt vmcnt(" #n ")" ::: "memory")
#define G8_WAIT_L(n) asm volatile("s_waitcnt lgkmcnt(" #n ")" ::: "memory")
#define G8_BAR __builtin_amdgcn_s_barrier()
#define G8_SCHED __builtin_amdgcn_sched_barrier(0)
  Unit2 cur, nxt;
  int ui = 0;
  if (!S.next(0, cur)) return;
  f32x4 acc[2][2][4][2];
#pragma unroll
  for (int a = 0; a < 2; ++a)
#pragma unroll
    for (int b = 0; b < 2; ++b)
#pragma unroll
      for (int m = 0; m < 4; ++m)
#pragma unroll
        for (int n = 0; n < 2; ++n) acc[a][b][m][n] = f32x4{0.f, 0.f, 0.f, 0.f};
  half8 At[4][2], B0[2][2], B1[2][2];
  const char* cA = (const char*)Ab + (size_t)cur.pm * tstepA;
  const char* cB = (const char*)Bb + (size_t)cur.pn * tstepB;
  G8_STAGE(G8_SB(0, 0), cB, voffB0); G8_STAGE(G8_SA(0, 0), cA, voffA); G8_STAGE(G8_SB(0, 1), cB, voffB1); G8_STAGE(G8_SA(0, 1), cA + hstepA, voffA);
  if (wr == 1) G8_BAR;
  G8_WAIT_V(4); G8_BAR;
  G8_STAGE(G8_SB(1, 0), cB + kstep, voffB0); G8_STAGE(G8_SA(1, 0), cA + kstep, voffA); G8_STAGE(G8_SB(1, 1), cB + kstep, voffB1);
  G8_WAIT_V(6); G8_BAR;
  for (;;) {
    const bool has_next = S.next(ui + 1, nxt);
    const char* nA = has_next ? (const char*)Ab + (size_t)nxt.pm * tstepA : cA;
    const char* nB = has_next ? (const char*)Bb + (size_t)nxt.pn * tstepB : cB;
    for (int t = 0; t < nt; t += 2) {
      const bool lastk = (t == nt - 2);
      const char* a1 = cA + (size_t)(t + 1) * kstep;
      const char* a2 = lastk ? nA : cA + (size_t)(t + 2) * kstep;
      const char* b2 = lastk ? nB : cB + (size_t)(t + 2) * kstep;
      const char* a3 = a2 + kstep;
      const char* b3 = b2 + kstep;
      G8_LDB(B0, 0, 0); G8_SCHED; G8_LDA(At, 0, 0); G8_STAGE(G8_SA(1, 1), a1 + hstepA, voffA);
      G8_WAIT_L(8); G8_BAR; G8_WAIT_L(0); G8_MMA(0, 0, At, B0); G8_BAR; G8_SCHED;
      G8_LDB(B1, 0, 1); G8_STAGE(G8_SB(0, 0), b2, voffB0);
      G8_BAR; G8_WAIT_L(0); G8_MMA(0, 1, At, B1); G8_BAR;
      G8_LDA(At, 0, 1); G8_STAGE(G8_SA(0, 0), a2, voffA);
      G8_BAR; G8_WAIT_L(0); G8_MMA(1, 0, At, B0); G8_BAR; G8_SCHED;
      G8_STAGE(G8_SB(0, 1), b2, voffB1);
      G8_WAIT_V(6); G8_BAR; G8_MMA(1, 1, At, B1); G8_BAR;
      G8_LDB(B0, 1, 0); G8_SCHED; G8_LDA(At, 1, 0); G8_STAGE(G8_SA(0, 1), a2 + hstepA, voffA);
      G8_WAIT_L(8); G8_BAR; G8_WAIT_L(0); G8_MMA(0, 0, At, B0); G8_BAR; G8_SCHED;
      G8_LDB(B1, 1, 1); G8_STAGE(G8_SB(1, 0), b3, voffB0);
      G8_BAR; G8_WAIT_L(0); G8_MMA(0, 1, At, B1); G8_BAR;
      G8_LDA(At, 1, 1); G8_STAGE(G8_SA(1, 0), a3, voffA);
      G8_BAR; G8_WAIT_L(0); G8_MMA(1, 0, At, B0); G8_BAR; G8_SCHED;
      G8_STAGE(G8_SB(1, 1), b3, voffB1);
      G8_WAIT_V(6); G8_BAR; G8_MMA(1, 1, At, B1); G8_BAR;
    }
    E(acc, cur, wr, wc, fr, fq);
    if (!has_next) break;
#pragma unroll
    for (int a = 0; a < 2; ++a)
#pragma unroll
      for (int b = 0; b < 2; ++b)
#pragma unroll
        for (int m = 0; m < 4; ++m)
#pragma unroll
          for (int n = 0; n < 2; ++n) acc[a][b][m][n] = f32x4{0.f, 0.f, 0.f, 0.f};
    cur = nxt; cA = nA; cB = nB; ++ui;
  }
  G8_WAIT_V(0);
  if (wr == 0) G8_BAR;
  G8_BAR;
#undef G8_SA
#undef G8_SB
#undef G8_STAGE
#undef G8_LDA
#undef G8_LDB
#undef G8_MMA
#undef G8_WAIT_V
#undef G8_WAIT_L
#undef G8_BAR
#undef G8_SCHED
}
struct XcdSched {
  int total, per, nxb, xcd, j;
  DI void init(int total_) { total = total_; const int G = gridDim.x; if (G & 7) { per = total; nxb = G; xcd = 0; j = blockIdx.x; } else { per = (total + 7) >> 3; nxb = G >> 3; xcd = blockIdx.x & 7; j = blockIdx.x >> 3; } }
  DI int item(int i) const { const int li = j + i * nxb; if (li >= per) return -1; const int lin = xcd * per + li; return lin < total ? lin : -1; }
};

template <class F>
DI void for_items_xcd(int total, F f) {
  const int G = gridDim.x;
  if (G & 7) { for (int it = blockIdx.x; it < total; it += G) f(it); return; }
  const int nxb = G >> 3, xcd = blockIdx.x & 7, j = blockIdx.x >> 3, per = (total + 7) >> 3;
  for (int i = j; i < per; i += nxb) { const int lin = xcd * per + i; if (lin < total) f(lin); }
}

template <int MB>
DI void zero_acc(f32x16 (&acc)[MB][2]) {
#pragma unroll
  for (int mb = 0; mb < MB; ++mb)
#pragma unroll
    for (int nb = 0; nb < 2; ++nb)
#pragma unroll
      for (int v = 0; v < 16; ++v) acc[mb][nb][v] = 0.f;
}

DI void phase_prep(const Params& P, char* smem) {
  const int tid = otid();
  float* mods = (float*)(P.ws + WS_MODS);
  float2* rope = (float2*)(P.ws + WS_ROPE);
  for (int task = blockIdx.x; task < 208; task += gridDim.x) {
    if (task < 192) {
      const int layer = task / 48, n0 = (task % 48) * 64;
      float* s = (float*)smem;
      float* red = s + 17 * 1024;
      for (int i = tid; i < 17 * 1024; i += 512) {
        const int r = i >> 10, k = i & 1023;
        const float v = (r < 16) ? P.c[r * 1024 + k] : P.c_ctx[k];
        s[i] = silu_f(v);
      }
      __syncthreads();
      const int nl = tid & 63, ks = tid >> 6;
      float acc[17];
#pragma unroll
      for (int r = 0; r < 17; ++r) acc[r] = 0.f;
      const float* wp = P.w_mod + ((size_t)layer * 1024 + ks * 128) * 3072 + n0 + nl;
      for (int k = 0; k < 128; ++k) {
        const float wv = wp[(size_t)k * 3072];
#pragma unroll
        for (int r = 0; r < 17; ++r) acc[r] += s[r * 1024 + ks * 128 + k] * wv;
      }
#pragma unroll
      for (int r = 0; r < 17; ++r) red[(ks * 17 + r) * 64 + nl] = acc[r];
      __syncthreads();
      for (int o = tid; o < 17 * 64; o += 512) {
        const int r = o >> 6, n = o & 63;
        float v = P.b_mod[layer * 3072 + n0 + n];
#pragma unroll
        for (int k2 = 0; k2 < 8; ++k2) v += red[(k2 * 17 + r) * 64 + n];
        mods[(layer * 17 + r) * 3072 + n0 + n] = v;
      }
      __syncthreads();
    } else {
      const int base = ((task - 192) * 512 + tid) * 8;
#pragma unroll 1
      for (int e = 0; e < 8; ++e) {
        const int ent = base + e;
        const int t = ent >> 5, a = (ent >> 4) & 1, f = ent & 15;
        const float pos = (float)(a ? (t & 63) : (t >> 6));
        const float inv = powf(10000.f, -(float)f / 16.f);
        float sn, cs;
        sincosf(pos * inv, &sn, &cs);
        rope[ent] = make_float2(cs, sn);
      }
    }
  }
}

DI void cvt_tile(const float* __restrict__ src, int ldn, h16* __restrict__ dst, int ldk, int k0, int n0, float* t) {
  const int tid = otid();
  {
    const int r = tid >> 4, c4 = tid & 15;
#pragma unroll
    for (int i = 0; i < 2; ++i) {
      const int k = r + 32 * i;
      const float4 v = *(const float4*)(src + (size_t)(k0 + k) * ldn + n0 + c4 * 4);
      t[k * 65 + c4 * 4 + 0] = v.x; t[k * 65 + c4 * 4 + 1] = v.y; t[k * 65 + c4 * 4 + 2] = v.z; t[k * 65 + c4 * 4 + 3] = v.w;
    }
  }
  __syncthreads();
  {
    const int n = tid >> 3, kc = tid & 7;
    half8 o;
#pragma unroll
    for (int j = 0; j < 8; ++j) o[j] = (h16)t[(kc * 8 + j) * 65 + n];
    *(half8*)(dst + (size_t)(n0 + n) * ldk + k0 + kc * 8) = o;
  }
  __syncthreads();
}

DI void cvt_layer_weights(const Params& P, int layer, int t0, int step, char* smem) {
  h16* winT = (h16*)(P.ws + wbase(layer));
  h16* wbrT = (h16*)(P.ws + wbase(layer) + OFF_WBRT);
  h16* woutT = (h16*)(P.ws + wbase(layer) + OFF_WOUTT);
  for (int t = t0; t < 2112 + 384 + 256; t += step) {
    if (t < 2112) {
      cvt_tile(P.w_in + (size_t)layer * D * IN_COLS, IN_COLS, winT, LDH, (t & 15) * 64, (t >> 4) * 64, (float*)smem);
    } else if (t < 2112 + 384) {
      const int u = t - 2112, br = u >> 7, v = u & 127;
      cvt_tile(P.w_branch + ((size_t)layer * 3 + br) * WB * D, D, wbrT + (size_t)br * D * LDY, LDY, (v & 7) * 64, (v >> 3) * 64, (float*)smem);
    } else {
      const int u = t - 2112 - 384;
      cvt_tile(P.w_out + (size_t)layer * D * D, D, woutT, LDH, (u & 15) * 64, (u >> 4) * 64, (float*)smem);
    }
  }
}

DI void phase_norm(const Params& P, int layer, char* smem) {
  const int tid = otid(), w = tid >> 6, lane = tid & 63;
  if (layer == 0) cvt_layer_weights(P, 0, blockIdx.x, gridDim.x, smem);
  const int gw = blockIdx.x * 8 + w, nw = gridDim.x * 8;
  const float* mods = (const float*)(P.ws + WS_MODS) + (size_t)layer * 17 * 3072;
  const float* ng = P.norm_g + layer * D;
  h16* hb = (h16*)(P.ws + WS_H16);
  for (int row = gw; row < T_ALL; row += nw) {
    const float* src;
    int b;
    if (row < T_LAT) { src = (layer == 0 ? P.x : P.out) + (size_t)row * D; b = row >> 11; }
    else { const int rc = row - T_LAT; src = (layer == 0 ? P.ctx : (const float*)(P.ws + WS_CTXW)) + (size_t)rc * D; b = 16; }
    const float* md = mods + b * 3072;
    float4 xv[4];
    float ss = 0.f;
#pragma unroll
    for (int j = 0; j < 4; ++j) {
      xv[j] = *(const float4*)(src + j * 256 + lane * 4);
      ss += xv[j].x * xv[j].x + xv[j].y * xv[j].y + xv[j].z * xv[j].z + xv[j].w * xv[j].w;
    }
#pragma unroll
    for (int m = 32; m >= 1; m >>= 1) ss += __shfl_xor(ss, m);
    const float rstd = rsqrtf(ss * (1.f / 1024.f) + 1e-6f);
#pragma unroll
    for (int j = 0; j < 4; ++j) {
      const int k = j * 256 + lane * 4;
      const float4 g = *(const float4*)(ng + k);
      const float4 sh = *(const float4*)(md + k);
      const float4 sc = *(const float4*)(md + 1024 + k);
      *(half4*)(hb + (size_t)row * LDH + k) = cvt4(xv[j].x * rstd * g.x * (1.f + sc.x) + sh.x, xv[j].y * rstd * g.y * (1.f + sc.y) + sh.y,
                                                  xv[j].z * rstd * g.z * (1.f + sc.z) + sh.z, xv[j].w * rstd * g.w * (1.f + sc.w) + sh.w);
    }
  }
  float* h2 = (float*)(P.ws + WS_H2);
  const float* w1 = P.fw1 + layer * 33 * 64;
  const float* w2 = P.fw2 + layer * 64 * 64;
  const float f0 = P.ffreq[layer * 128 + lane], f1 = P.ffreq[layer * 128 + 64 + lane];
  const float b1 = P.fb1[layer * 64 + lane], b2 = P.fb2[layer * 64 + lane];
  for (int p = gw; p < SEQ + CTXL; p += nw) {
    const int L = p >= SEQ ? CTXL : SEQ, tau = p >= SEQ ? p - SEQ : p;
    const float tt = (float)tau / (float)(L - 1);
    const float wv = (6.283185307179586f / (float)L) * (float)tau;
    float feat = 0.f;
    if (lane == 0) feat = tt;
    else if (lane <= 16) feat = cosf(wv * (1e-4f + (float)(lane - 1) * ((15.f - 1e-4f) / 15.f)));
    else if (lane <= 32) feat = sinf(wv * (1e-4f + (float)(lane - 17) * ((15.f - 1e-4f) / 15.f)));
    float a1 = b1;
    for (int e = 0; e < 33; ++e) a1 += __shfl(feat, e) * w1[e * 64 + lane];
    const float h1 = sinf(f0 * a1);
    float a2 = b2;
    for (int k = 0; k < 64; ++k) a2 += __shfl(h1, k) * w2[k * 64 + lane];
    h2[(size_t)p * 64 + lane] = sinf(f1 * a2);
  }
}

DI void filt2_task(const Params& P, int layer, int set, int o, int cg16, char* smem) {
  const int tid = otid();
  const int L = set ? CTXL : SEQ, KLEN = set ? KLEN_C : KLEN_L, OFF = set ? KOFF_C : KOFF_L;
  h16* krb = (h16*)(P.ws + (set ? WS_KRC : WS_KRL));
  const float* h2 = (const float*)(P.ws + WS_H2) + (set ? (size_t)SEQ * 64 : 0);
  float* invS = (float*)(P.ws + WS_INVS);
  const int c0 = cg16 * 16;
  float* w3s = (float*)smem;
  float* part = w3s + 2048;
  for (int i = tid; i < 2048; i += 512) {
    const int k = i >> 5, d = (i >> 4) & 1, cc = i & 15;
    w3s[i] = P.fw3[((size_t)layer * 64 + k) * 2048 + (o * 2 + d) * 512 + c0 + cc];
  }
  __syncthreads();
  const int cc = tid & 15, sl = tid >> 4, c = c0 + cc;
  const float b30 = P.fb3[layer * 2048 + (o * 2 + 0) * 512 + c], b31 = P.fb3[layer * 2048 + (o * 2 + 1) * 512 + c];
  const float MIN_DECAY = -3.0701134573253940f, MAX_DECAY = -15.350567286626974f;
  const float delta = fabsf(MIN_DECAY + (float)c * ((MAX_DECAY - MIN_DECAY) / 511.f));
  h16* kr = krb + (size_t)(o * 512 + c) * KLEN;
  const int nper = L >> 5;
  float sum = 0.f;
  for (int tau = sl * nper; tau < (sl + 1) * nper; ++tau) {
    const float4* hr = (const float4*)(h2 + (size_t)tau * 64);
    float v0 = b30, v1 = b31;
#pragma unroll
    for (int kc = 0; kc < 16; ++kc) {
      const float4 hv = hr[kc];
      v0 += hv.x * w3s[(kc * 4 + 0) * 32 + cc] + hv.y * w3s[(kc * 4 + 1) * 32 + cc] + hv.z * w3s[(kc * 4 + 2) * 32 + cc] + hv.w * w3s[(kc * 4 + 3) * 32 + cc];
      v1 += hv.x * w3s[(kc * 4 + 0) * 32 + 16 + cc] + hv.y * w3s[(kc * 4 + 1) * 32 + 16 + cc] + hv.z * w3s[(kc * 4 + 2) * 32 + 16 + cc] + hv.w * w3s[(kc * 4 + 3) * 32 + 16 + cc];
    }
    const float tt = (float)tau / (float)(L - 1);
    const float dec = expf(-tt * delta);
    v0 *= dec; v1 *= dec;
    kr[OFF - tau] = (h16)v0;
    sum += fabsf(v0);
    if (tau >= 1) { kr[OFF + tau] = (h16)v1; sum += fabsf(v1); }
  }
  for (int z = sl; z < 257; z += 32) {
    const int idx = z < 65 ? z : (OFF + L + (z - 65));
    kr[idx] = (h16)0.f;
  }
  part[sl * 16 + cc] = sum;
  __syncthreads();
  if (tid < 16) {
    float tot = 0.f;
    for (int s2 = 0; s2 < 32; ++s2) tot += part[s2 * 16 + tid];
    invS[(set * 2 + o) * 512 + c0 + tid] = 1.f / tot;
  }
  __syncthreads();
}

struct SchedH {
  XcdSched xs;
  DI bool next(int i, Unit2& u) const { const int it = xs.item(i); if (it < 0) return false; u.pm = (it & 31) >> 2; u.pn = (it >> 5) * 4 + (it & 3); return true; }
};
struct EpiH {
  h16* hT;
  DI void operator()(const f32x4 (&acc)[2][2][4][2], const Unit2& u, int wr_, int wc_, int fr_, int fq_) const {
    const int tid2 = otid(), wid2 = tid2 >> 6, wr = wid2 >> 2, wc = wid2 & 3, fr = tid2 & 15, fq = (tid2 >> 4) & 3;
    const bool gate = u.pm >= 6;
    const int tok0 = u.pn * 256;
    const bool isctx = tok0 >= T_LAT;
#pragma unroll
    for (int ai = 0; ai < 2; ++ai)
#pragma unroll
      for (int m = 0; m < 4; ++m) {
        const int col = u.pm * 256 + ai * 128 + wr * 64 + m * 16 + fr;
#pragma unroll
        for (int bj = 0; bj < 2; ++bj)
#pragma unroll
          for (int n = 0; n < 2; ++n) {
            const int grow = tok0 + bj * 128 + wc * 32 + n * 16 + 4 * fq;
            float v0 = acc[ai][bj][m][n][0], v1 = acc[ai][bj][m][n][1], v2 = acc[ai][bj][m][n][2], v3 = acc[ai][bj][m][n][3];
            if (gate) { v0 = silu_f(v0); v1 = silu_f(v1); v2 = silu_f(v2); v3 = silu_f(v3); }
            h16* dst;
            if (!isctx) { const int b = grow >> 11, tt = grow & 2047; dst = hT + ((size_t)(b * 2048 + col) * SEQ + tt); }
            else { const int rc = grow - T_LAT, b = rc >> 8, tt = rc & 255; dst = hT + HTC_OFF + ((size_t)(b * 2048 + col) * CTXL + tt); }
            *(half4*)dst = cvt4(v0, v1, v2, v3);
          }
      }
  }
};
DI void phase_gemm_h(const Params& P, int layer, char* smem) {
  const bool last = layer == DEPTH - 1;
  const int n_mt = last ? 128 : 144;
  {
    const int nfilt = last ? 64 : 128;
    const int G = gridDim.x, first = G - (G >> 1);
    for (int item = (int)blockIdx.x - first; item >= 0 && item < nfilt; item += (G >> 1)) {
      const int id = nfilt - 1 - item;
      filt2_task(P, layer, id >> 6, (id & 63) >> 5, id & 31, smem);
    }
  }
  SchedH S; S.xs.init(n_mt * 8);
  EpiH E; E.hT = (h16*)(P.ws + WS_R1);
  gemm256_stream<false>(smem, (const h16*)(P.ws + wbase(layer)) + (size_t)H_OFF * LDH, LDH, (const h16*)(P.ws + WS_H16), LDH, D, S, E);
}

DI void phase_shortconv(const Params& P, int layer, char* smem) {
  const bool last = layer == DEPTH - 1;
  const int tid = otid(), lane = tid & 63, w = tid >> 6;
  const int gw = blockIdx.x * 8 + w, nw = gridDim.x * 8;
  h16* hT = (h16*)(P.ws + WS_R1);
  const float* cw = P.conv_h + (size_t)layer * 3 * 1536;
  const int nrows_l = NBATCH * 1536;
  const int nrows = last ? nrows_l : 2 * nrows_l;
  for (int r = gw; r < nrows; r += nw) {
    if (r < nrows_l) {
      const int b = r / 1536, col = r % 1536;
      const float w0 = cw[col], w1 = cw[1536 + col], w2 = cw[3072 + col];
      h16* p = hT + (size_t)(b * 2048 + col) * SEQ;
      half8 v[4];
#pragma unroll
      for (int j = 0; j < 4; ++j) v[j] = *(const half8*)(p + j * 512 + lane * 8);
      float prev[4], next[4];
#pragma unroll
      for (int j = 0; j < 4; ++j) {
        const float lastv = (float)v[j][7], firstv = (float)v[j][0];
        float pu = __shfl_up(lastv, 1);
        float nd = __shfl_down(firstv, 1);
        prev[j] = pu; next[j] = nd;
      }
#pragma unroll
      for (int j = 0; j < 4; ++j) {
        const float l63 = (j > 0) ? __shfl((float)v[j > 0 ? j - 1 : 0][7], 63) : 0.f;
        const float f0 = (j < 3) ? __shfl((float)v[j < 3 ? j + 1 : 3][0], 0) : 0.f;
        if (lane == 0) prev[j] = l63;
        if (lane == 63) next[j] = f0;
      }
#pragma unroll
      for (int j = 0; j < 4; ++j) {
        half8 o;
#pragma unroll
        for (int e = 0; e < 8; ++e) {
          const float a = e == 0 ? prev[j] : (float)v[j][e > 0 ? e - 1 : 0];
          const float cc = (float)v[j][e];
          const float d = e == 7 ? next[j] : (float)v[j][e < 7 ? e + 1 : 7];
          o[e] = (h16)(w0 * a + w1 * cc + w2 * d);
        }
        *(half8*)(p + j * 512 + lane * 8) = o;
      }
    } else {
      const int r2 = r - nrows_l;
      const int b = r2 / 1536, col = r2 % 1536;
      const float w0 = cw[col], w1 = cw[1536 + col], w2 = cw[3072 + col];
      h16* p = hT + HTC_OFF + (size_t)(b * 2048 + col) * CTXL;
      const half4 v = *(const half4*)(p + lane * 4);
      float prev = __shfl_up((float)v[3], 1), next = __shfl_down((float)v[0], 1);
      if (lane == 0) prev = 0.f;
      if (lane == 63) next = 0.f;
      half4 o;
      o[0] = (h16)(w0 * prev + w1 * (float)v[0] + w2 * (float)v[1]);
      o[1] = (h16)(w0 * (float)v[0] + w1 * (float)v[1] + w2 * (float)v[2]);
      o[2] = (h16)(w0 * (float)v[1] + w1 * (float)v[2] + w2 * (float)v[3]);
      o[3] = (h16)(w0 * (float)v[2] + w1 * (float)v[3] + w2 * next);
      *(half4*)(p + lane * 4) = o;
    }
  }
}

template <int MODE, int TB>
DI void toeplitz_task(const Params& P, int layer, int set, int cg, int chunk, char* smem) {
  const int tid = otid(), w = tid >> 6, lane = tid & 63;
  const int L = set ? CTXL : SEQ, KLEN = set ? KLEN_C : KLEN_L, OFF = set ? KOFF_C : KOFF_L;
  const h16* krg = (const h16*)(P.ws + (set ? WS_KRC : WS_KRL)) + (size_t)(MODE * 512 + cg * 8) * KLEN;
  h16* krs = (h16*)smem;
  char* stg = smem + 8 * KLEN_L * 2;
  for (int i = tid; i < KLEN; i += 512) *(half8*)(krs + i * 8) = *(const half8*)(krg + i * 8);
  __syncthreads();
  const int c = cg * 8 + w;
  const int bb = lane & 15, kg = lane >> 4;
  const h16* hT = (const h16*)(P.ws + WS_R1) + (set ? HTC_OFF : 0);
  h16* z1T = (h16*)(P.ws + WS_R2) + (set ? Z1C_OFF : 0);
  const h16* Urow = (MODE == 0) ? hT + (size_t)(bb * 2048 + c) * L : z1T + (size_t)(bb * 512 + c) * L;
  const float invs = ((const float*)(P.ws + WS_INVS))[(set * 2 + MODE) * 512 + c];
  const float bias = P.hbias[(layer * 2 + MODE) * 512 + c];
  const int nsteps = (L >> 5) + 1;
  constexpr int GS = TB == 4 ? 2 : 5;
  const int ngroups = (nsteps + GS - 1) / GS;
  const int npass = (TB == 4 || set) ? 1 : 2;
  const h16* krw = krs + w * KLEN;
  for (int pass = 0; pass < npass; ++pass) {
    const int tb = chunk * 512 + pass * 256;
    f32x4 acc[TB][8];
#pragma unroll
    for (int ta = 0; ta < TB; ++ta)
#pragma unroll
      for (int r = 0; r < 8; ++r) acc[ta][r] = f32x4{0.f, 0.f, 0.f, 0.f};
    u32x4 cur[2 * GS], nxt[2 * GS];
    auto load_group = [&](int g, u32x4 (&dst)[2 * GS]) {
#pragma unroll
      for (int q = 0; q < GS; ++q) {
        const int s = -32 + (g * GS + q) * 32 + 8 * kg;
        const int s2 = s + 8;
        const int sc = min(max(s, 0), L - 8), sc2 = min(max(s2, 0), L - 8);
        dst[2 * q] = *(const u32x4*)(Urow + sc);
        dst[2 * q + 1] = *(const u32x4*)(Urow + sc2);
      }
    };
    load_group(0, cur);
    const int abase = OFF - tb - 8 * ((lane & 15) - kg);
    half8 afn[TB];
#pragma unroll
    for (int ta = 0; ta < TB; ++ta) afn[ta] = *(const half8*)(krw + abase - 32 - 128 * ta);
    for (int g = 0; g < ngroups; ++g) {
      load_group(g + 1 < ngroups ? g + 1 : g, nxt);
      __builtin_amdgcn_sched_barrier(0);
#pragma unroll
      for (int q = 0; q < GS; ++q) {
        const int s0 = -32 + (g * GS + q) * 32;
        half8 af[TB];
#pragma unroll
        for (int ta = 0; ta < TB; ++ta) { af[ta] = afn[ta]; afn[ta] = *(const half8*)(krw + abase + s0 + 32 - 128 * ta); }
        unsigned d[8];
        {
          const int sw0 = s0 + 8 * kg, sw1 = sw0 + 8;
          const bool va = (sw0 >= 0) && (sw0 < L), vb = (sw1 >= 0) && (sw1 < L);
#pragma unroll
          for (int e = 0; e < 4; ++e) { d[e] = va ? cur[2 * q][e] : 0u; d[4 + e] = vb ? cur[2 * q + 1][e] : 0u; }
        }
#pragma unroll
        for (int r = 0; r < 8; ++r) {
          u32x4 bw;
#pragma unroll
          for (int e = 0; e < 4; ++e)
            bw[e] = (r & 1) ? __builtin_amdgcn_alignbit(d[(r >> 1) + e + 1 > 7 ? 7 : (r >> 1) + e + 1], d[(r >> 1) + e], 16) : d[(r >> 1) + e];
          const half8 bfr = __builtin_bit_cast(half8, bw);
#pragma unroll
          for (int ta = 0; ta < TB; ++ta) acc[ta][r] = __builtin_amdgcn_mfma_f32_16x16x32_f16(af[ta], bfr, acc[ta][r], 0, 0, 0);
        }
      }
#pragma unroll
      for (int e = 0; e < 2 * GS; ++e) cur[e] = nxt[e];
    }
#pragma unroll
    for (int hf = 0; hf < TB / 2; ++hf) {
    const int tbh = tb + 256 * hf;
#pragma unroll
    for (int ta = 2 * hf; ta < 2 * hf + 2; ++ta) {
      const int t0 = tb + 128 * ta + 32 * kg;
#pragma unroll
      for (int v = 0; v < 4; ++v) {
        const int t = t0 + 8 * v;
        if (MODE == 0) {
          const half8 x1 = *(const half8*)(hT + (size_t)(bb * 2048 + 512 + c) * L + t);
          const half8 uu = *(const half8*)(Urow + t);
          half8 o;
#pragma unroll
          for (int r = 0; r < 8; ++r) o[r] = (h16)((float)x1[r] * (acc[ta][r][v] * invs + (float)uu[r] * bias));
          *(half8*)(z1T + (size_t)(bb * 512 + c) * L + t) = o;
        } else {
          const half8 x2 = *(const half8*)(hT + (size_t)(bb * 2048 + 1024 + c) * L + t);
          const half8 gt = *(const half8*)(hT + (size_t)(bb * 2048 + 1536 + c) * L + t);
          const half8 uu = *(const half8*)(Urow + t);
#pragma unroll
          for (int r = 0; r < 8; ++r) {
            const float y = (float)x2[r] * (acc[ta][r][v] * invs + (float)uu[r] * bias) * (float)gt[r];
            const int tl = t - tbh + r;
            *(h16*)(stg + ((tl * 16 + bb) * 8 + w) * 2) = (h16)y;
          }
        }
      }
    }
    if (MODE == 1) {
      __syncthreads();
      h16* yb = (h16*)(P.ws + WS_YB);
#pragma unroll
      for (int i = 0; i < 8; ++i) {
        const int item = tid + 512 * i;
        const int b = item >> 8, tl = item & 255;
        const size_t tok = set ? (size_t)T_LAT + b * CTXL + tbh + tl : (size_t)b * SEQ + tbh + tl;
        *(half8*)(yb + tok * LDY + cg * 8) = *(const half8*)(stg + (tl * 16 + b) * 16);
      }
      __syncthreads();
    }
    }
  }
  __syncthreads();
}

template <int MODE>
DI void phase_toeplitz(const Params& P, int layer, char* smem) {
  const bool last = layer == DEPTH - 1;
  const int total = last ? 256 : 320;
  for (int item = blockIdx.x; item < total; item += gridDim.x) {
    if (item < 256) toeplitz_task<MODE, 4>(P, layer, 0, item >> 2, item & 3, smem);
    else toeplitz_task<MODE, 2>(P, layer, 1, item - 256, 0, smem);
  }
}

struct SchedAQ {
  XcdSched xs; bool last;
  DI bool next(int i, Unit2& u) const {
    const int it = xs.item(i); if (it < 0) return false;
    int mt, nt;
    if (last && it >= 128 * 13) { mt = 128 + (it - 128 * 13); nt = 10; }
    else { const int g = it / 52, rem = it % 52; nt = rem >> 2; mt = g * 4 + (rem & 3); }
    u.pm = mt; u.pn = nt < 8 ? nt : nt + 8;
    return true;
  }
};
struct EpiAQ {
  h16 *pa, *qb, *kb, *vT, *zs;
  const float *qg, *kg;
  const float2* rope;
  DI void norm_rope(f32x4 (&x)[2][2], const float* gvec, bool do_rope, int t, int fq) const {
    float ss = 0.f;
#pragma unroll
    for (int bj = 0; bj < 2; ++bj)
#pragma unroll
      for (int n = 0; n < 2; ++n)
#pragma unroll
        for (int v = 0; v < 4; ++v) ss += x[bj][n][v] * x[bj][n][v];
    ss += __shfl_xor(ss, 16);
    ss += __shfl_xor(ss, 32);
    const float rstd = rsqrtf(ss * (1.f / 64.f) + 1e-6f);
#pragma unroll
    for (int bj = 0; bj < 2; ++bj)
#pragma unroll
      for (int n = 0; n < 2; ++n) {
        const float4 g = *(const float4*)(gvec + bj * 32 + n * 16 + 4 * fq);
        x[bj][n][0] *= rstd * g.x; x[bj][n][1] *= rstd * g.y; x[bj][n][2] *= rstd * g.z; x[bj][n][3] *= rstd * g.w;
      }
    if (do_rope) {
#pragma unroll
      for (int bj = 0; bj < 2; ++bj) {
        const float4* rp = (const float4*)(rope + ((size_t)t * 2 + bj) * 16 + 4 * fq);
        const float4 ca = rp[0], cb = rp[1];
        const float cs[4] = {ca.x, ca.z, cb.x, cb.z}, sn[4] = {ca.y, ca.w, cb.y, cb.w};
#pragma unroll
        for (int v = 0; v < 4; ++v) {
          const float x1 = x[bj][0][v], x2 = x[bj][1][v];
          x[bj][0][v] = x1 * cs[v] - x2 * sn[v];
          x[bj][1][v] = x2 * cs[v] + x1 * sn[v];
        }
      }
    }
  }
  DI void operator()(const f32x4 (&acc)[2][2][4][2], const Unit2& u, int wr_, int wc_, int fr_, int fq_) const {
    const int tid2 = otid(), wid2 = tid2 >> 6, wr = wid2 >> 2, wc = wid2 & 3, fr = tid2 & 15, fq = (tid2 >> 4) & 3;
    const int row0 = u.pm * 256;
    const bool isctx = row0 >= T_LAT;
    const int pn = u.pn;
#pragma unroll
    for (int ai = 0; ai < 2; ++ai)
#pragma unroll
      for (int m = 0; m < 4; ++m) {
        const int row = row0 + ai * 128 + wr * 64 + m * 16 + fr;
        int b, t;
        if (!isctx) { b = row >> 11; t = row & 2047; } else { b = (row - T_LAT) >> 8; t = (row - T_LAT) & 255; }
        f32x4 x[2][2];
#pragma unroll
        for (int bj = 0; bj < 2; ++bj)
#pragma unroll
          for (int n = 0; n < 2; ++n) x[bj][n] = acc[ai][bj][m][n];
        if (pn < 8) {
#pragma unroll
          for (int bj = 0; bj < 2; ++bj)
#pragma unroll
            for (int n = 0; n < 2; ++n) {
              f32x4 v = x[bj][n];
              if (pn >= 6) { v[0] = silu_f(v[0]); v[1] = silu_f(v[1]); v[2] = silu_f(v[2]); v[3] = silu_f(v[3]); }
              *(half4*)(pa + (size_t)row * 2048 + pn * 256 + wc * 64 + bj * 32 + n * 16 + 4 * fq) = cvt4(v[0], v[1], v[2], v[3]);
            }
        } else if (pn < 18) {
          const int head = (pn - 16) * 4 + wc;
          norm_rope(x, qg, !isctx, t, fq);
#pragma unroll
          for (int bj = 0; bj < 2; ++bj)
#pragma unroll
            for (int n = 0; n < 2; ++n)
              *(half4*)(qb + (size_t)row * 512 + head * 64 + bj * 32 + n * 16 + 4 * fq) = cvt4(x[bj][n][0], x[bj][n][1], x[bj][n][2], x[bj][n][3]);
        } else if (pn == 18) {
          const int key = isctx ? t : CTXL + t;
          if (wc < 2) {
            norm_rope(x, kg, !isctx, t, fq);
#pragma unroll
            for (int bj = 0; bj < 2; ++bj)
#pragma unroll
              for (int n = 0; n < 2; ++n)
                *(half4*)(kb + ((size_t)(b * 2 + wc) * SKV + key) * 64 + bj * 32 + n * 16 + 4 * fq) = cvt4(x[bj][n][0], x[bj][n][1], x[bj][n][2], x[bj][n][3]);
          } else {
#pragma unroll
            for (int bj = 0; bj < 2; ++bj)
#pragma unroll
              for (int n = 0; n < 2; ++n)
#pragma unroll
                for (int v = 0; v < 4; ++v) vT[((size_t)(b * 2 + (wc - 2)) * 64 + bj * 32 + n * 16 + 4 * fq + v) * SKV + key] = (h16)x[bj][n][v];
          }
        } else {
#pragma unroll
          for (int bj = 0; bj < 2; ++bj)
#pragma unroll
            for (int n = 0; n < 2; ++n)
              *(half4*)(zs + (size_t)row * 512 + (pn - 19) * 256 + wc * 64 + bj * 32 + n * 16 + 4 * fq) =
                  cvt4(silu_f(x[bj][n][0]), silu_f(x[bj][n][1]), silu_f(x[bj][n][2]), silu_f(x[bj][n][3]));
        }
      }
  }
};
DI void phase_gemm_aq(const Params& P, int layer, char* smem) {
  const bool last = layer == DEPTH - 1;
  SchedAQ S; S.last = last; S.xs.init(128 * 13 + (last ? 16 : 16 * 13));
  EpiAQ E;
  E.pa = (h16*)(P.ws + WS_R1); E.qb = (h16*)(P.ws + WS_Q); E.kb = (h16*)(P.ws + WS_K); E.vT = (h16*)(P.ws + WS_VT); E.zs = (h16*)(P.ws + WS_ZS);
  E.qg = P.qg + layer * 64; E.kg = P.kg + layer * 64; E.rope = (const float2*)(P.ws + WS_ROPE);
  if (!last) {
    const int G = gridDim.x;
    if ((G & 7) == 0) {
      const int nxb = G >> 3, per = (128 * 13 + 16 * 13 + 7) >> 3, nlong = per - (per / nxb) * nxb;
      const int j = blockIdx.x >> 3, xcd = blockIdx.x & 7;
      if (j >= nlong) cvt_layer_weights(P, layer + 1, (j - nlong) * 8 + xcd, (nxb - nlong) * 8, smem);
    } else cvt_layer_weights(P, layer + 1, blockIdx.x, G, smem);
  }
  gemm256_stream<true>(smem, (const h16*)(P.ws + WS_H16), LDH, (const h16*)(P.ws + wbase(layer)), LDH, D, S, E);
}

DI void attn_task(const Params& P, int set, int b, int kvh, int qt, char* smem) {
  const int tid = otid(), w = tid >> 6, lane = tid & 63, r32 = lane & 31, hh = lane >> 5;
  const int head = kvh * 4 + (w & 3), qsub = w >> 2;
  const int nkeys = set ? CTXL : SKV;
  const size_t row0 = (set ? (size_t)T_LAT + b * CTXL : (size_t)b * SEQ) + qt * 128 + qsub * 64 + r32;
  const h16* qb = (const h16*)(P.ws + WS_Q);
  h16* yc = (h16*)(P.ws + WS_YC);
  const h16* zs = (const h16*)(P.ws + WS_ZS);
  const h16* kg = (const h16*)(P.ws + WS_K) + (size_t)(b * 2 + kvh) * SKV * 64;
  const h16* vg = (const h16*)(P.ws + WS_VT) + (size_t)(b * 2 + kvh) * 64 * SKV;
  half8 qf[2][4];
#pragma unroll
  for (int qi = 0; qi < 2; ++qi)
#pragma unroll
    for (int ds = 0; ds < 4; ++ds) qf[qi][ds] = *(const half8*)(qb + (row0 + 32 * qi) * 512 + head * 64 + 16 * ds + 8 * hh);
  const int srow = tid >> 3, sch = tid & 7, ssw = (srow >> 1) & 7;
  const int k_wr = srow * 128 + ((sch ^ ssw) * 16);
  const int u = sch >> 1, od = sch & 1;
  const int v_wr0 = 8192 + srow * 128 + (((2 * u) ^ ssw) * 16) + 8 * od;
  const int v_wr1 = 8192 + srow * 128 + (((2 * u + 1) ^ ssw) * 16) + 8 * od;
  const int sw = (r32 >> 1) & 7;
  const int ntile = nkeys >> 6;
  half8 kreg = *(const half8*)(kg + (size_t)srow * 64 + sch * 8);
  half8 vreg = *(const half8*)(vg + (size_t)srow * SKV + sch * 8);
  {
    char* s = smem;
    *(half8*)(s + k_wr) = kreg;
    half4 lo, hi;
    lo[0] = vreg[0]; lo[1] = vreg[1]; lo[2] = vreg[2]; lo[3] = vreg[3];
    hi[0] = vreg[4]; hi[1] = vreg[5]; hi[2] = vreg[6]; hi[3] = vreg[7];
    *(half4*)(s + v_wr0) = lo;
    *(half4*)(s + v_wr1) = hi;
  }
  __syncthreads();
  f32x16 o[2][2];
#pragma unroll
  for (int qi = 0; qi < 2; ++qi)
#pragma unroll
    for (int v = 0; v < 16; ++v) { o[qi][0][v] = 0.f; o[qi][1][v] = 0.f; }
  float m_run[2] = {-1e30f, -1e30f}, l_run[2] = {0.f, 0.f};
  const float cscale = 0.125f * 1.4426950408889634f;
  asm volatile("" : "+v"(qf[0][0]), "+v"(qf[0][1]), "+v"(qf[0][2]), "+v"(qf[0][3]), "+v"(qf[1][0]), "+v"(qf[1][1]), "+v"(qf[1][2]), "+v"(qf[1][3]));
#pragma unroll 1
  for (int kt = 0; kt < ntile; ++kt) {
    if (kt + 1 < ntile) {
      kreg = *(const half8*)(kg + (size_t)((kt + 1) * 64 + srow) * 64 + sch * 8);
      vreg = *(const half8*)(vg + (size_t)srow * SKV + (kt + 1) * 64 + sch * 8);
    }
    const char* s = smem + (kt & 1) * 16384;
    f32x16 sc[2][2];
#pragma unroll
    for (int qi = 0; qi < 2; ++qi)
#pragma unroll
      for (int v = 0; v < 16; ++v) { sc[qi][0][v] = 0.f; sc[qi][1][v] = 0.f; }
#pragma unroll
    for (int ds = 0; ds < 4; ++ds) {
      const int co = ((2 * ds + hh) ^ sw) * 16;
      const half8 k0 = *(const half8*)(s + r32 * 128 + co);
      const half8 k1 = *(const half8*)(s + (32 + r32) * 128 + co);
#pragma unroll
      for (int qi = 0; qi < 2; ++qi) {
        sc[qi][0] = __builtin_amdgcn_mfma_f32_32x32x16_f16(k0, qf[qi][ds], sc[qi][0], 0, 0, 0);
        sc[qi][1] = __builtin_amdgcn_mfma_f32_32x32x16_f16(k1, qf[qi][ds], sc[qi][1], 0, 0, 0);
      }
    }
#pragma unroll
    for (int qi = 0; qi < 2; ++qi) {
      float mx = sc[qi][0][0];
#pragma unroll
      for (int v = 0; v < 16; ++v) { mx = fmaxf(mx, sc[qi][0][v]); mx = fmaxf(mx, sc[qi][1][v]); }
      mx = fmaxf(mx, __shfl_xor(mx, 32));
      const float m_new = fmaxf(m_run[qi], mx * cscale);
      const float alpha = __builtin_amdgcn_exp2f(m_run[qi] - m_new);
      m_run[qi] = m_new;
      float ps = 0.f;
#pragma unroll
      for (int v = 0; v < 16; ++v) {
        sc[qi][0][v] = __builtin_amdgcn_exp2f(sc[qi][0][v] * cscale - m_new); ps += sc[qi][0][v];
        sc[qi][1][v] = __builtin_amdgcn_exp2f(sc[qi][1][v] * cscale - m_new); ps += sc[qi][1][v];
      }
      l_run[qi] = l_run[qi] * alpha + ps;
#pragma unroll
      for (int v = 0; v < 16; ++v) { o[qi][0][v] *= alpha; o[qi][1][v] *= alpha; }
    }
#pragma unroll
    for (int uu = 0; uu < 4; ++uu) {
      const int co = ((2 * uu + hh) ^ sw) * 16;
      const half8 v0 = *(const half8*)(s + 8192 + r32 * 128 + co);
      const half8 v1 = *(const half8*)(s + 8192 + (32 + r32) * 128 + co);
#pragma unroll
      for (int qi = 0; qi < 2; ++qi) {
        half8 pf;
#pragma unroll
        for (int j = 0; j < 8; ++j) pf[j] = (h16)((uu < 2) ? sc[qi][0][8 * (uu & 1) + j] : sc[qi][1][8 * (uu & 1) + j]);
        o[qi][0] = __builtin_amdgcn_mfma_f32_32x32x16_f16(v0, pf, o[qi][0], 0, 0, 0);
        o[qi][1] = __builtin_amdgcn_mfma_f32_32x32x16_f16(v1, pf, o[qi][1], 0, 0, 0);
      }
    }
    if (kt + 1 < ntile) {
      char* s2 = smem + ((kt + 1) & 1) * 16384;
      *(half8*)(s2 + k_wr) = kreg;
      half4 lo, hi;
      lo[0] = vreg[0]; lo[1] = vreg[1]; lo[2] = vreg[2]; lo[3] = vreg[3];
      hi[0] = vreg[4]; hi[1] = vreg[5]; hi[2] = vreg[6]; hi[3] = vreg[7];
      *(half4*)(s2 + v_wr0) = lo;
      *(half4*)(s2 + v_wr1) = hi;
    }
    __syncthreads();
  }
#pragma unroll
  for (int qi = 0; qi < 2; ++qi) {
    const float ltot = l_run[qi] + __shfl_xor(l_run[qi], 32);
    const float inv = 1.f / ltot;
    const size_t row = row0 + 32 * qi;
#pragma unroll
    for (int db = 0; db < 2; ++db)
#pragma unroll
      for (int g = 0; g < 4; ++g) {
        const size_t off = row * 512 + head * 64 + db * 32 + 8 * g + 4 * hh;
        const half4 z = *(const half4*)(zs + off);
        const f32x16& oo = o[qi][db];
        *(half4*)(yc + row * LDY + head * 64 + db * 32 + 8 * g + 4 * hh) = cvt4(oo[4 * g] * inv * (float)z[0], oo[4 * g + 1] * inv * (float)z[1], oo[4 * g + 2] * inv * (float)z[2], oo[4 * g + 3] * inv * (float)z[3]);
      }
  }
}

DI void phase_attn(const Params& P, int layer, char* smem) {
  const bool last = layer == DEPTH - 1;
  const int n_lat = NBATCH * 2 * 16;
  const int total = n_lat + (last ? 0 : NBATCH * 2 * 2);
  for (int item = blockIdx.x; item < total; item += gridDim.x) {
    if (item < n_lat) attn_task(P, 0, item >> 5, (item >> 4) & 1, item & 15, smem);
    else { const int u = item - n_lat; attn_task(P, 1, u >> 2, (u >> 1) & 1, u & 1, smem); }
  }
  const int tid = otid(), lane = tid & 63, w = tid >> 6;
  const int gw = blockIdx.x * 8 + w, nw = gridDim.x * 8;
  const h16* pa = (const h16*)(P.ws + WS_R1);
  h16* ya = (h16*)(P.ws + WS_R2);
  const int nitems = (last ? T_LAT : T_ALL) / 8;
  const float* cw = P.conv_a + (size_t)layer * 3 * 512 + lane * 8;
  float w0[8], w1[8], w2[8];
#pragma unroll
  for (int e = 0; e < 8; ++e) { w0[e] = cw[e]; w1[e] = cw[512 + e]; w2[e] = cw[1024 + e]; }
  for (int it = gw; it < nitems; it += nw) {
    const int tk0 = it * 8;
    int t0, L;
    if (tk0 < T_LAT) { t0 = tk0 & 2047; L = SEQ; } else { t0 = (tk0 - T_LAT) & 255; L = CTXL; }
    float up[8], uc[8], un[8];
    auto load_u = [&](int dt, float (&dst)[8]) {
      const int t = t0 + dt;
      if (t < 0 || t >= L) {
#pragma unroll
        for (int e = 0; e < 8; ++e) dst[e] = 0.f;
      } else {
        const h16* rp = pa + (size_t)(tk0 + dt) * 2048 + lane * 8;
        const half8 xa = *(const half8*)rp, ca = *(const half8*)(rp + 1024);
#pragma unroll
        for (int e = 0; e < 8; ++e) dst[e] = (float)xa[e] * (float)ca[e];
      }
    };
    load_u(-1, up);
    load_u(0, uc);
#pragma unroll 1
    for (int dt = 0; dt < 8; ++dt) {
      load_u(dt + 1, un);
      const h16* rp = pa + (size_t)(tk0 + dt) * 2048 + lane * 8;
      const half8 ba = *(const half8*)(rp + 512), za = *(const half8*)(rp + 1536);
      half8 o;
#pragma unroll
      for (int e = 0; e < 8; ++e) o[e] = (h16)((float)ba[e] * (w0[e] * up[e] + w1[e] * uc[e] + w2[e] * un[e]) * (float)za[e]);
      *(half8*)(ya + (size_t)(tk0 + dt) * LDY + lane * 8) = o;
#pragma unroll
      for (int e = 0; e < 8; ++e) { up[e] = uc[e]; uc[e] = un[e]; }
    }
  }
}

template <int MB>
DI void merge_tile(const Params& P, int layer, size_t row0, int nt, char* smem) {
  const h16* hb = (const h16*)(P.ws + WS_H16);
  const h16* winT = (const h16*)(P.ws + wbase(layer));
  const h16* wbrT = (const h16*)(P.ws + wbase(layer) + OFF_WBRT);
  h16* mg = (h16*)(P.ws + WS_R1);
  f32x16 macc[MB][2];
  zero_acc<MB>(macc);
#pragma unroll 1
  for (int n = 0; n < 3; ++n) {
    const h16* yn = (const h16*)(P.ws + (n == 0 ? WS_R2 : (n == 1 ? WS_YB : WS_YC)));
    f32x16 pa2[MB][2];
    half8 gpk[MB][2][2];
    zero_acc<MB>(pa2);
    gemm_kloop<MB, true>(pa2, hb + row0 * LDH, LDH, winT + (size_t)(G_OFF + n * 1024 + nt * 256) * LDH, LDH, D, smem);
#pragma unroll
    for (int mb = 0; mb < MB; ++mb)
#pragma unroll
      for (int nb = 0; nb < 2; ++nb)
#pragma unroll
        for (int v = 0; v < 16; ++v) gpk[mb][nb][v >> 3][v & 7] = (h16)sigmoid_f(pa2[mb][nb][v]);
    zero_acc<MB>(pa2);
    gemm_kloop<MB, true>(pa2, yn + row0 * LDY, LDY, wbrT + (size_t)(n * 1024 + nt * 256) * LDY, LDY, WB, smem);
#pragma unroll
    for (int mb = 0; mb < MB; ++mb)
#pragma unroll
      for (int nb = 0; nb < 2; ++nb)
#pragma unroll
        for (int v = 0; v < 16; ++v) macc[mb][nb][v] += (float)gpk[mb][nb][v >> 3][v & 7] * pa2[mb][nb][v];
  }
  const int tid = otid(), lane = tid & 63, w = tid >> 6, wr = w >> 2, wc = w & 3, r32 = lane & 31, hh = lane >> 5;
#pragma unroll
  for (int mb = 0; mb < MB; ++mb) {
    const size_t row = row0 + wr * 32 * MB + mb * 32 + r32;
#pragma unroll
    for (int nb = 0; nb < 2; ++nb)
#pragma unroll
      for (int g = 0; g < 4; ++g)
        *(half4*)(mg + row * LDH + nt * 256 + wc * 64 + nb * 32 + 8 * g + 4 * hh) =
            cvt4(macc[mb][nb][4 * g], macc[mb][nb][4 * g + 1], macc[mb][nb][4 * g + 2], macc[mb][nb][4 * g + 3]);
  }
}
DI void split_rounds(int total, int& nfull, int& nhalf) {
  const int G = gridDim.x;
  nfull = (total / G) * G;
  const int rem = total - nfull;
  if (rem > 0 && 2 * rem <= G) nhalf = 2 * rem; else { nfull = total; nhalf = 0; }
}
DI void phase_merge(const Params& P, int layer, char* smem) {
  const bool last = layer == DEPTH - 1;
  const int total = (last ? T_LAT : T_ALL) / 128 * 4;
  int nfull, nhalf;
  split_rounds(total, nfull, nhalf);
  for_items_xcd(nfull, [&](int item) {
    const int mt = (item >> 5) * 8 + (item & 7), nt = (item & 31) >> 3;
    merge_tile<2>(P, layer, (size_t)mt * 128, nt, smem);
  });
  for_items_xcd(nhalf, [&](int h) {
    const int item = nfull + (h >> 1);
    const int mt = (item >> 5) * 8 + (item & 7), nt = (item & 31) >> 3;
    merge_tile<1>(P, layer, (size_t)mt * 128 + (h & 1) * 64, nt, smem);
  });
}

template <int MB>
DI void out_tile(const Params& P, int layer, int row0, int nt, char* smem) {
  const h16* mg = (const h16*)(P.ws + WS_R1);
  const h16* woutT = (const h16*)(P.ws + wbase(layer) + OFF_WOUTT);
  const float* mods = (const float*)(P.ws + WS_MODS) + (size_t)layer * 17 * 3072;
  float* ctxw = (float*)(P.ws + WS_CTXW);
  f32x16 acc[MB][2];
  zero_acc<MB>(acc);
  gemm_kloop<MB, true>(acc, mg + (size_t)row0 * LDH, LDH, woutT + (size_t)(nt * 256) * LDH, LDH, D, smem);
  const int tid = otid(), lane = tid & 63, w = tid >> 6, wr = w >> 2, wc = w & 3, r32 = lane & 31, hh = lane >> 5;
#pragma unroll
  for (int mb = 0; mb < MB; ++mb) {
    const int row = row0 + wr * 32 * MB + mb * 32 + r32;
    const float* src; float* dst; int b;
    if (row < T_LAT) { b = row >> 11; src = (layer == 0 ? P.x : P.out) + (size_t)row * D; dst = P.out + (size_t)row * D; }
    else { const int rc = row - T_LAT; b = 16; src = (layer == 0 ? P.ctx : ctxw) + (size_t)rc * D; dst = ctxw + (size_t)rc * D; }
    const float* gt = mods + b * 3072 + 2048;
#pragma unroll
    for (int nb = 0; nb < 2; ++nb)
#pragma unroll
      for (int g = 0; g < 4; ++g) {
        const int col = nt * 256 + wc * 64 + nb * 32 + 8 * g + 4 * hh;
        const float4 xo = *(const float4*)(src + col);
        const float4 gv = *(const float4*)(gt + col);
        float4 r;
        r.x = xo.x + gv.x * acc[mb][nb][4 * g]; r.y = xo.y + gv.y * acc[mb][nb][4 * g + 1];
        r.z = xo.z + gv.z * acc[mb][nb][4 * g + 2]; r.w = xo.w + gv.w * acc[mb][nb][4 * g + 3];
        *(float4*)(dst + col) = r;
      }
  }
}
DI void phase_out(const Params& P, int layer, char* smem) {
  const bool last = layer == DEPTH - 1;
  const int total = (last ? T_LAT : T_ALL) / 128 * 4;
  int nfull, nhalf;
  split_rounds(total, nfull, nhalf);
  for_items_xcd(nfull, [&](int item) {
    const int mt = (item >> 5) * 8 + (item & 7), nt = (item & 31) >> 3;
    out_tile<2>(P, layer, mt * 128, nt, smem);
  });
  for_items_xcd(nhalf, [&](int h) {
    const int item = nfull + (h >> 1);
    const int mt = (item >> 5) * 8 + (item & 7), nt = (item & 31) >> 3;
    out_tile<1>(P, layer, mt * 128 + (h & 1) * 64, nt, smem);
  });
}

#define XB_TMO      128
#define XB_XCNT(j)  (256  + 64 * (j))
#define XB_XSUB(j)  (1280 + 64 * (j))
#define XB_XGEN(j)  (2304 + 64 * (j))
#define XB_TOP      3328
#define XB_TOPGEN   3392
#define XCD_BAR_WORDS 3456
#define XB_SPIN_CAP (1u << 20)
#define LAS __attribute__((address_space(3)))
DI unsigned xb_ld(unsigned* p) { return __hip_atomic_load(p, __ATOMIC_RELAXED, __HIP_MEMORY_SCOPE_AGENT); }
DI unsigned xb_add(unsigned* p, unsigned v) { return __hip_atomic_fetch_add(p, v, __ATOMIC_RELAXED, __HIP_MEMORY_SCOPE_AGENT); }
DI unsigned xb_xcc_id() { return (unsigned)__builtin_amdgcn_s_getreg((3 << 11) | 20) & 0xFu; }
#define XB_SPIN(cond, bar) do { unsigned _sp = 0; while (cond) { __builtin_amdgcn_s_sleep(1); \
    if ((++_sp & 255u) == 0u) { if (xb_ld(&(bar)[XB_TMO])) break; if (_sp > XB_SPIN_CAP) { atomicAdd(&(bar)[XB_TMO], 1u); break; } } } } while (0)
struct XcdBarrier { unsigned* bar; unsigned x; volatile LAS unsigned* st; };
DI XcdBarrier xcd_barrier_post(unsigned* bar, volatile LAS unsigned* st) {
  XcdBarrier b; b.bar = bar; b.x = xb_xcc_id(); b.st = st;
  if (threadIdx.x == 0) (void)xb_add(&bar[XB_XCNT(b.x)], 1u);
  return b;
}
DI void xcd_barrier_complete(unsigned* bar, unsigned x, unsigned& nloc, unsigned& nx) {
  const unsigned G = gridDim.x;
  unsigned sum, cnt, mine, sp = 0u;
  for (;;) {
    sum = 0u; cnt = 0u; mine = 0u;
#pragma unroll
    for (unsigned j = 0; j < 16; ++j) { const unsigned c = xb_ld(&bar[XB_XCNT(j)]); sum += c; cnt += (c > 0u) ? 1u : 0u; mine = (j == x) ? c : mine; }
    if (sum == G) break;
    __builtin_amdgcn_s_sleep(1);
    if ((++sp & 255u) == 0u) { if (xb_ld(&bar[XB_TMO])) break; if (sp > XB_SPIN_CAP) { atomicAdd(&bar[XB_TMO], 1u); break; } }
  }
  nloc = mine > 0u ? mine : 1u; nx = cnt > 0u ? cnt : 1u;
}
DI void xcd_barrier(const XcdBarrier& b) {
  asm volatile("s_waitcnt vmcnt(0)" ::: "memory");
  __syncthreads();
  if (threadIdx.x == 0) {
    unsigned* bar = b.bar;
    asm volatile("" : "+s"(bar));
    __builtin_amdgcn_s_waitcnt(0);
    unsigned nloc = b.st[0], nx = b.st[1];
    if (nloc == 0u) { xcd_barrier_complete(bar, b.x, nloc, nx); b.st[0] = nloc; b.st[1] = nx; }
    const unsigned old = xb_add(&bar[XB_XSUB(b.x)], 1u);
    const unsigned gen = old / nloc;
    if (old + 1u == (gen + 1u) * nloc) {
      __builtin_amdgcn_fence(__ATOMIC_RELEASE, "agent");
      asm volatile("s_waitcnt vmcnt(0)" ::: "memory");
      const unsigned og = xb_add(&bar[XB_TOP], 1u);
      const unsigned tg = og / nx;
      if (og + 1u == (tg + 1u) * nx) xb_add(&bar[XB_TOPGEN], 1u);
      else XB_SPIN(xb_ld(&bar[XB_TOPGEN]) == tg, bar);
      __builtin_amdgcn_fence(__ATOMIC_ACQUIRE, "agent");
      xb_add(&bar[XB_XGEN(b.x)], 1u);
      asm volatile("s_waitcnt vmcnt(0)" ::: "memory");
    } else {
      XB_SPIN(xb_ld(&bar[XB_XGEN(b.x)]) == gen, bar);
      __builtin_amdgcn_fence(__ATOMIC_ACQUIRE, "agent");
      asm volatile("s_waitcnt vmcnt(0)" ::: "memory");
    }
  }
  __syncthreads();
}

__global__ void __launch_bounds__(512) mega_kernel(Params P) {
  extern __shared__ __attribute__((aligned(16))) char smem[];
  volatile LAS unsigned* xst = (volatile LAS unsigned*)(smem + LDS_BYTES);
  if (threadIdx.x == 0) { xst[0] = 0u; xst[1] = 0u; }
  __syncthreads();
  const XcdBarrier xb = xcd_barrier_post((unsigned*)(P.ws + WS_BAR), xst);
  for (int ph = P.ph_lo; ph < P.ph_hi; ++ph) {
    if (ph == 0) phase_prep(P, smem);
    else {
      const int layer = (ph - 1) / NPH_LAYER, k = (ph - 1) % NPH_LAYER;
#ifndef PROBE_REP
#define PROBE_REP -1
#endif
      const int nrep = (k == PROBE_REP) ? 2 : 1;
      for (int rep = 0; rep < nrep; ++rep) {
      switch (k) {
        case 0: { int lo = layer; asm volatile("" : "+s"(lo)); phase_norm(P, lo, smem); } break;
        case 1: { int lo = layer; asm volatile("" : "+s"(lo)); phase_gemm_h(P, lo, smem); } break;
        case 2: { int lo = layer; asm volatile("" : "+s"(lo)); phase_shortconv(P, lo, smem); } break;
        case 3: { int lo = layer; asm volatile("" : "+s"(lo)); phase_toeplitz<0>(P, lo, smem); } break;
        case 4: { int lo = layer; asm volatile("" : "+s"(lo)); phase_toeplitz<1>(P, lo, smem); } break;
        case 5: { int lo = layer; asm volatile("" : "+s"(lo)); phase_gemm_aq(P, lo, smem); } break;
        case 6: { int lo = layer; asm volatile("" : "+s"(lo)); phase_attn(P, lo, smem); } break;
        case 7: { int lo = layer; asm volatile("" : "+s"(lo)); phase_merge(P, lo, smem); } break;
        default: { int lo = layer; asm volatile("" : "+s"(lo)); phase_out(P, lo, smem); } break;
      }
      if (rep + 1 < nrep) cg::this_grid().sync();
      }
    }
    if (ph + 1 < P.ph_hi) {
      if (ph == P.ph_lo) cg::this_grid().sync();
      else xcd_barrier(xb);
    }
  }
}

extern "C" void kernel_launch(void* const* d_in, const int* in_sizes, int n_in, void* d_out, int out_size, void* d_ws, size_t ws_size,
                              hipStream_t stream) {
  static int grid = 0;
  if (grid == 0) {
    int dev = 0, cus = 0, per_cu = 0;
    hipGetDevice(&dev);
    hipDeviceGetAttribute(&cus, hipDeviceAttributeMultiprocessorCount, dev);
    if (hipFuncSetAttribute((const void*)mega_kernel, hipFuncAttributeMaxDynamicSharedMemorySize, LDS_BYTES + 16) != hipSuccess) {
      fprintf(stderr, "hipFuncSetAttribute failed\n");
      grid = -1;
      return;
    }
    hipOccupancyMaxActiveBlocksPerMultiprocessor(&per_cu, (const void*)mega_kernel, 512, LDS_BYTES + 16);
    if (per_cu < 1) per_cu = 1;
    grid = cus * per_cu;
    if (ws_size < WS_END || n_in != 22) { fprintf(stderr, "workspace too small: %zu < %zu\n", ws_size, (size_t)WS_END); grid = -1; }
  }
  if (grid < 0) return;
  Params p{};
  const float** f = (const float**)&p;
  for (int i = 0; i < 22; ++i) f[i] = (const float*)d_in[i];
  p.out = (float*)d_out;
  p.ws = (char*)d_ws;
#if PER_PHASE_LAUNCH
  for (int ph = 0; ph < NPHASES; ++ph) {
    p.ph_lo = ph; p.ph_hi = ph + 1;
    hipLaunchKernelGGL(mega_kernel, dim3(grid), dim3(512), LDS_BYTES + 16, stream, p);
  }
#else
  p.ph_lo = 0; p.ph_hi = NPHASES;
  if (hipMemsetAsync((char*)d_ws + WS_BAR, 0, XCD_BAR_WORDS * 4, stream) != hipSuccess) { fprintf(stderr, "memset of barrier word failed\n"); return; }
  void* args[] = {&p};
  hipError_t e = hipLaunchCooperativeKernel((const void*)mega_kernel, dim3(grid), dim3(512), args, LDS_BYTES + 16, stream);
  if (e != hipSuccess) fprintf(stderr, "cooperative launch failed: %s (grid %d)\n", hipGetErrorString(e), grid);
#endif
}
```

```cpp
#include <hip/hip_runtime.h>
#include <hip/hip_cooperative_groups.h>
#include <cstdio>
namespace cg = cooperative_groups;

#ifndef PER_PHASE_LAUNCH
#define PER_PHASE_LAUNCH 0
#endif

typedef _Float16 h16;
typedef _Float16 half8 __attribute__((ext_vector_type(8)));
typedef _Float16 half4 __attribute__((ext_vector_type(4)));
typedef float f32x16 __attribute__((ext_vector_type(16)));
typedef float f32x4 __attribute__((ext_vector_type(4)));
typedef unsigned u32x4 __attribute__((ext_vector_type(4)));
#define DI __device__ __forceinline__

constexpr int D = 1024, NBATCH = 16, SEQ = 2048, CTXL = 256, DEPTH = 4, WB = 512;
constexpr int T_LAT = NBATCH * SEQ, T_CTX = NBATCH * CTXL, T_ALL = T_LAT + T_CTX;
constexpr int IN_COLS = 8448, H_OFF = 2048, C_OFF = 4096, K_OFF = 4608, Z_OFF = 4864, G_OFF = 5376;
constexpr int SKV = CTXL + SEQ;
constexpr int KLEN_L = 2 * SEQ + 256, KOFF_L = SEQ + 64;
constexpr int KLEN_C = 2 * CTXL + 256, KOFF_C = CTXL + 64;
constexpr int LDH = 1088, LDY = 576;
constexpr int NPH_LAYER = 9;
constexpr int NPHASES = 1 + DEPTH * NPH_LAYER;
constexpr int LDS_BYTES = 3 * 49152;

constexpr size_t al(size_t x) { return (x + 255) & ~size_t(255); }
constexpr size_t WS_CTXW = 0;
constexpr size_t WS_MODS = WS_CTXW + al((size_t)T_CTX * D * 4);
constexpr size_t WS_ROPE = WS_MODS + al((size_t)DEPTH * 17 * 3072 * 4);
constexpr size_t WS_WINT = WS_ROPE + al((size_t)SEQ * 32 * 8);
constexpr size_t WS_WBRT = WS_WINT + al((size_t)IN_COLS * LDH * 2);
constexpr size_t WS_WOUTT = WS_WBRT + al((size_t)3 * D * LDY * 2);
constexpr size_t WS_H2 = WS_WOUTT + al((size_t)D * LDH * 2);
constexpr size_t WS_KRL = WS_H2 + al((size_t)(SEQ + CTXL) * 64 * 4);
constexpr size_t WS_KRC = WS_KRL + al((size_t)2 * WB * KLEN_L * 2);
constexpr size_t WS_INVS = WS_KRC + al((size_t)2 * WB * KLEN_C * 2);
constexpr size_t WS_H16 = WS_INVS + al((size_t)2 * 2 * WB * 4);
constexpr size_t WS_R1 = WS_H16 + al((size_t)T_ALL * LDH * 2);
constexpr size_t WS_R2 = WS_R1 + al((size_t)T_ALL * 2048 * 2);
constexpr size_t WS_YB = WS_R2 + al((size_t)T_ALL * LDY * 2);
constexpr size_t WS_Q = WS_YB + al((size_t)T_ALL * LDY * 2);
constexpr size_t WS_K = WS_Q + al((size_t)T_ALL * WB * 2);
constexpr size_t WS_VT = WS_K + al((size_t)NBATCH * 2 * SKV * 64 * 2);
constexpr size_t WS_ZS = WS_VT + al((size_t)NBATCH * 2 * SKV * 64 * 2);
constexpr size_t WS_YC = WS_ZS + al((size_t)T_ALL * WB * 2);
constexpr size_t WS_BAR = WS_YC + al((size_t)T_ALL * LDY * 2);
constexpr size_t WS_W1 = WS_BAR + 16384;
constexpr size_t WS_END = WS_W1 + (WS_H2 - WS_WINT);
constexpr size_t OFF_WBRT = WS_WBRT - WS_WINT, OFF_WOUTT = WS_WOUTT - WS_WINT;
constexpr size_t HTC_OFF = (size_t)NBATCH * 2048 * SEQ;
constexpr size_t Z1C_OFF = (size_t)NBATCH * WB * SEQ;

struct Params {
  const float *x, *c, *ctx, *c_ctx, *norm_g, *w_mod, *b_mod, *w_in, *conv_a, *conv_h, *fw1, *fb1, *fw2, *fb2, *fw3, *fb3,
      *ffreq, *hbias, *qg, *kg, *w_branch, *w_out;
  float* out;
  char* ws;
  int ph_lo, ph_hi;
};

DI size_t wbase(int layer) { return (layer & 1) ? WS_W1 : WS_WINT; }
DI float silu_f(float x) { return x / (1.f + __expf(-x)); }
DI float sigmoid_f(float x) { return 1.f / (1.f + __expf(-x)); }
DI half4 cvt4(float a, float b, float c, float d) { half4 r; r[0] = (h16)a; r[1] = (h16)b; r[2] = (h16)c; r[3] = (h16)d; return r; }
DI void wait_vm0() { asm volatile("s_waitcnt vmcnt(0)" ::: "memory"); }
DI int otid() { int t = threadIdx.x; asm volatile("" : "+v"(t)); return t; }

template <int MB, bool SWAP>
DI void gemm_kloop(f32x16 (&acc)[MB][2], const h16* __restrict__ A, int lda, const h16* __restrict__ B, int ldb, int K, char* lds) {
  constexpr int A_BYTES = 64 * MB * 128, B_BYTES = 256 * 128, STAGE = A_BYTES + B_BYTES;
  static_assert(3 * STAGE <= LDS_BYTES, "ring does not fit");
  const int tid = otid(), w = tid >> 6, lane = tid & 63;
  const int wr = w >> 2, wc = w & 3;
  const int lrow = w * 8 + (lane >> 3), pch = lane & 7;
  const int gch = pch ^ ((lrow >> 1) & 7);
  const unsigned voa = (unsigned)(lrow * lda + gch * 8) * 2u, vob = (unsigned)(lrow * ldb + gch * 8) * 2u;
  const int lofs = lrow * 128 + pch * 16;
  const int r32 = lane & 31, hh = lane >> 5, sw = (r32 >> 1) & 7;
  const int a_rd = (wr * 32 * MB + r32) * 128;
  const int b_rd = A_BYTES + (wc * 64 + r32) * 128;
  const int nk = K >> 6;
  constexpr int NP = MB + 4;
  auto piece = [&](int p, int kt, int buf) {
    char* s = lds + buf * STAGE;
    if (p < MB) __builtin_amdgcn_global_load_lds((const unsigned*)((const char*)(A + (size_t)p * 64 * lda + kt * 64) + voa), (unsigned*)(s + p * 8192 + lofs), 16, 0, 0);
    else __builtin_amdgcn_global_load_lds((const unsigned*)((const char*)(B + (size_t)(p - MB) * 64 * ldb + kt * 64) + vob), (unsigned*)(s + A_BYTES + (p - MB) * 8192 + lofs), 16, 0, 0);
  };
  wait_vm0();
#pragma unroll
  for (int p = 0; p < NP; ++p) piece(p, 0, 0);
#pragma unroll
  for (int p = 0; p < NP; ++p) piece(p, 1, 1);
  int cur = 0;
  for (int kt = 0; kt < nk; ++kt) {
    if (kt + 1 < nk) { if (MB == 2) asm volatile("s_waitcnt vmcnt(6)" ::: "memory"); else asm volatile("s_waitcnt vmcnt(5)" ::: "memory"); }
    else wait_vm0();
    __syncthreads();
    const char* s = lds + cur * STAGE;
    const int nbuf = cur == 0 ? 2 : cur - 1;
    const bool more = kt + 2 < nk;
    half8 af[2][MB], bf[2][2];
#pragma unroll
    for (int mb = 0; mb < MB; ++mb) af[0][mb] = *(const half8*)(s + a_rd + mb * 4096 + (((0 + hh) ^ sw) * 16));
#pragma unroll
    for (int nb = 0; nb < 2; ++nb) bf[0][nb] = *(const half8*)(s + b_rd + nb * 4096 + (((0 + hh) ^ sw) * 16));
#pragma unroll
    for (int ks = 0; ks < 4; ++ks) {
      if (ks < 3) {
#pragma unroll
        for (int mb = 0; mb < MB; ++mb) af[(ks + 1) & 1][mb] = *(const half8*)(s + a_rd + mb * 4096 + (((2 * (ks + 1) + hh) ^ sw) * 16));
#pragma unroll
        for (int nb = 0; nb < 2; ++nb) bf[(ks + 1) & 1][nb] = *(const half8*)(s + b_rd + nb * 4096 + (((2 * (ks + 1) + hh) ^ sw) * 16));
      }
      if (more) {
        if (2 * ks < NP) piece(2 * ks, kt + 2, nbuf);
        if (2 * ks + 1 < NP) piece(2 * ks + 1, kt + 2, nbuf);
      }
      __builtin_amdgcn_sched_barrier(0);
      __builtin_amdgcn_s_setprio(1);
#pragma unroll
      for (int mb = 0; mb < MB; ++mb)
#pragma unroll
        for (int nb = 0; nb < 2; ++nb)
          acc[mb][nb] = SWAP ? __builtin_amdgcn_mfma_f32_32x32x16_f16(bf[ks & 1][nb], af[ks & 1][mb], acc[mb][nb], 0, 0, 0)
                             : __builtin_amdgcn_mfma_f32_32x32x16_f16(af[ks & 1][mb], bf[ks & 1][nb], acc[mb][nb], 0, 0, 0);
      __builtin_amdgcn_s_setprio(0);
      __builtin_amdgcn_sched_barrier(0);
    }
    cur = cur == 2 ? 0 : cur + 1;
  }
  __syncthreads();
}

DI int lds_byte16(int r, int c) { const int st = (r >> 4) * 2 + (c >> 5), rr = r & 15, cc = c & 31, ob = rr * 64 + cc * 2; return st * 1024 + (ob ^ (((ob >> 9) & 1) << 5)); }
DI void stage_rc16(int b, int& R, int& C) { const int st = b / 1024, sb = b % 1024, swz = sb ^ (((sb >> 9) & 1) << 5); R = (st >> 1) * 16 + swz / 64; C = (st & 1) * 32 + (swz % 64) / 2; }
struct Unit2 { int pm, pn; };
template <bool HEADPERM, class Sched, class Epi>
DI void gemm256_stream(char* lds, const h16* __restrict__ Ab, int lda, const h16* __restrict__ Bb, int ldb, int K, const Sched& S, const Epi& E) {
  constexpr int HTB = 128 * 64 * 2;
  const int tid = otid(), wid = __builtin_amdgcn_readfirstlane(tid >> 6), lane = tid & 63, wr = wid >> 2, wc = wid & 3, fr = lane & 15, fq = lane >> 4;
  const int nt = K / 64;
  unsigned voffA[2], voffB0[2], voffB1[2];
#pragma unroll
  for (int i = 0; i < 2; ++i) {
    int R, C;
    stage_rc16(tid * 16 + i * 8192, R, C);
    voffA[i] = (unsigned)(R * lda + C) * 2u;
    if (HEADPERM) {
      const int rb = (R >> 5) * 64 + (R & 31);
      voffB0[i] = (unsigned)(rb * ldb + C) * 2u;
      voffB1[i] = (unsigned)((rb + 32) * ldb + C) * 2u;
    } else {
      voffB0[i] = (unsigned)(R * ldb + C) * 2u;
      voffB1[i] = (unsigned)((R + 128) * ldb + C) * 2u;
    }
  }
  const size_t kstep = 128;
  const size_t hstepA = (size_t)128 * lda * 2;
  const size_t tstepA = 2 * hstepA, tstepB = (size_t)256 * ldb * 2;
  const unsigned ldsw = (unsigned)wid * 1024u;
  const int aoff = lds_byte16(wr * 64 + fr, fq * 8), boff = lds_byte16(wc * 32 + fr, fq * 8);
#define G8_SA(b, h) (((b) * 2 + (h)) * HTB)
#define G8_SB(b, h) ((4 + (b) * 2 + (h)) * HTB)
#define G8_STAGE(bufoff, gbase, voff) do { _Pragma("unroll") for (int _i = 0; _i < 2; ++_i) \
    __builtin_amdgcn_global_load_lds((const unsigned*)((const char*)(gbase) + (voff)[_i]), (unsigned*)(lds + (bufoff) + ldsw + _i * 8192 + lane * 16), 16, 0, 0); } while (0)
#define G8_LDA(dst, b, h) do { _Pragma("unroll") for (int m = 0; m < 4; ++m) _Pragma("unroll") for (int k = 0; k < 2; ++k) dst[m][k] = *(const half8*)(lds + G8_SA(b, h) + aoff + m * 2048 + k * 1024); } while (0)
#define G8_LDB(dst, b, h) do { _Pragma("unroll") for (int n = 0; n < 2; ++n) _Pragma("unroll") for (int k = 0; k < 2; ++k) dst[n][k] = *(const half8*)(lds + G8_SB(b, h) + boff + n * 2048 + k * 1024); } while (0)
#define G8_MMA(ai, bj, At, Bt) do { __builtin_amdgcn_s_setprio(1); _Pragma("unroll") for (int m = 0; m < 4; ++m) _Pragma("unroll") for (int n = 0; n < 2; ++n) _Pragma("unroll") for (int k = 0; k < 2; ++k) \
    acc[ai][bj][m][n] = __builtin_amdgcn_mfma_f32_16x16x32_f16(Bt[n][k], At[m][k], acc[ai][bj][m][n], 0, 0, 0); __builtin_amdgcn_s_setprio(0); } while (0)
#define G8_WAIT_V(n) asm volatile("s_waitcnt vmcnt(" #n ")" ::: "memory")
#define G8_WAIT_L(n) asm volatile("s_waitcnt lgkmcnt(" #n ")" ::: "memory")
#define G8_BAR __builtin_amdgcn_s_barrier()
#define G8_SCHED __builtin_amdgcn_sched_barrier(0)
  Unit2 cur, nxt;
  int ui = 0;
  if (!S.next(0, cur)) return;
  f32x4 acc[2][2][4][2];
#pragma unroll
  for (int a = 0; a < 2; ++a)
#pragma unroll
    for (int b = 0; b < 2; ++b)
#pragma unroll
      for (int m = 0; m < 4; ++m)
#pragma unroll
        for (int n = 0; n < 2; ++n) acc[a][b][m][n] = f32x4{0.f, 0.f, 0.f, 0.f};
  half8 At[4][2], B0[2][2], B1[2][2];
  const char* cA = (const char*)Ab + (size_t)cur.pm * tstepA;
  const char* cB = (const char*)Bb + (size_t)cur.pn * tstepB;
  G8_STAGE(G8_SB(0, 0), cB, voffB0); G8_STAGE(G8_SA(0, 0), cA, voffA); G8_STAGE(G8_SB(0, 1), cB, voffB1); G8_STAGE(G8_SA(0, 1), cA + hstepA, voffA);
  if (wr == 1) G8_BAR;
  G8_WAIT_V(4); G8_BAR;
  G8_STAGE(G8_SB(1, 0), cB + kstep, voffB0); G8_STAGE(G8_SA(1, 0), cA + kstep, voffA); G8_STAGE(G8_SB(1, 1), cB + kstep, voffB1);
  G8_WAIT_V(6); G8_BAR;
  for (;;) {
    const bool has_next = S.next(ui + 1, nxt);
    const char* nA = has_next ? (const char*)Ab + (size_t)nxt.pm * tstepA : cA;
    const char* nB = has_next ? (const char*)Bb + (size_t)nxt.pn * tstepB : cB;
    for (int t = 0; t < nt; t += 2) {
      const bool lastk = (t == nt - 2);
      const char* a1 = cA + (size_t)(t + 1) * kstep;
      const char* a2 = lastk ? nA : cA + (size_t)(t + 2) * kstep;
      const char* b2 = lastk ? nB : cB + (size_t)(t + 2) * kstep;
      const char* a3 = a2 + kstep;
      const char* b3 = b2 + kstep;
      G8_LDB(B0, 0, 0); G8_SCHED; G8_LDA(At, 0, 0); G8_STAGE(G8_SA(1, 1), a1 + hstepA, voffA);
      G8_WAIT_L(8); G8_BAR; G8_WAIT_L(0); G8_MMA(0, 0, At, B0); G8_BAR; G8_SCHED;
      G8_LDB(B1, 0, 1); G8_STAGE(G8_SB(0, 0), b2, voffB0);
      G8_BAR; G8_WAIT_L(0); G8_MMA(0, 1, At, B1); G8_BAR;
      G8_LDA(At, 0, 1); G8_STAGE(G8_SA(0, 0), a2, voffA);
      G8_BAR; G8_WAIT_L(0); G8_MMA(1, 0, At, B0); G8_BAR; G8_SCHED;
      G8_STAGE(G8_SB(0, 1), b2, voffB1);
      G8_WAIT_V(6); G8_BAR; G8_MMA(1, 1, At, B1); G8_BAR;
      G8_LDB(B0, 1, 0); G8_SCHED; G8_LDA(At, 1, 0); G8_STAGE(G8_SA(0, 1), a2 + hstepA, voffA);
      G8_WAIT_L(8); G8_BAR; G8_WAIT_L(0); G8_MMA(0, 0, At, B0); G8_BAR; G8_SCHED;
      G8_LDB(B1, 1, 1); G8_STAGE(G8_SB(1, 0), b3, voffB0);
      G8_BAR; G8_WAIT_L(0); G8_MMA(0, 1, At, B1); G8_BAR;
      G8_LDA(At, 1, 1); G8_STAGE(G8_SA(1, 0), a3, voffA);
      G8_BAR; G8_WAIT_L(0); G8_MMA(1, 0, At, B0); G8_BAR; G8_SCHED;
      G8_STAGE(G8_SB(1, 1), b3, voffB1);
      G8_WAIT_V(6); G8_BAR; G8_MMA(1, 1, At, B1); G8_BAR;
    }
    E(acc, cur, wr, wc, fr, fq);
    if (!has_next) break;
#pragma unroll
    for (int a = 0; a < 2; ++a)
#pragma unroll
      for (int b = 0; b < 2; ++b)
#pragma unroll
        for (int m = 0; m < 4; ++m)
#pragma unroll
          for (int n = 0; n < 2; ++n) acc[a][b][m][n] = f32x4{0.f, 0.f, 0.f, 0.f};
    cur = nxt; cA = nA; cB = nB; ++ui;
  }
  G8_WAIT_V(0);
  if (wr == 0) G8_BAR;
  G8_BAR;
#undef G8_SA
#undef G8_SB
#undef G8_STAGE
#undef G8_LDA
#undef G8_LDB
#undef G8_MMA
#undef G8_WAIT_V
#undef G8_WAIT_L
#undef G8_BAR
#undef G8_SCHED
}
struct XcdSched {
  int total, per, nxb, xcd, j;
  DI void init(int total_) { total = total_; const int G = gridDim.x; if (G & 7) { per = total; nxb = G; xcd = 0; j = blockIdx.x; } else { per = (total + 7) >> 3; nxb = G >> 3; xcd = blockIdx.x & 7; j = blockIdx.x >> 3; } }
  DI int item(int i) const { const int li = j + i * nxb; if (li >= per) return -1; const int lin = xcd * per + li; return lin < total ? lin : -1; }
};

template <class F>
DI void for_items_xcd(int total, F f) {
  const int G = gridDim.x;
  if (G & 7) { for (int it = blockIdx.x; it < total; it += G) f(it); return; }
  const int nxb = G >> 3, xcd = blockIdx.x & 7, j = blockIdx.x >> 3, per = (total + 7) >> 3;
  for (int i = j; i < per; i += nxb) { const int lin = xcd * per + i; if (lin < total) f(lin); }
}

template <int MB>
DI void zero_acc(f32x16 (&acc)[MB][2]) {
#pragma unroll
  for (int mb = 0; mb < MB; ++mb)
#pragma unroll
    for (int nb = 0; nb < 2; ++nb)
#pragma unroll
      for (int v = 0; v < 16; ++v) acc[mb][nb][v] = 0.f;
}

DI void phase_prep(const Params& P, char* smem) {
  const int tid = otid();
  float* mods = (float*)(P.ws + WS_MODS);
  float2* rope = (float2*)(P.ws + WS_ROPE);
  for (int task = blockIdx.x; task < 208; task += gridDim.x) {
    if (task < 192) {
      const int layer = task / 48, n0 = (task % 48) * 64;
      float* s = (float*)smem;
      float* red = s + 17 * 1024;
      for (int i = tid; i < 17 * 1024; i += 512) {
        const int r = i >> 10, k = i & 1023;
        const float v = (r < 16) ? P.c[r * 1024 + k] : P.c_ctx[k];
        s[i] = silu_f(v);
      }
      __syncthreads();
      const int nl = tid & 63, ks = tid >> 6;
      float acc[17];
#pragma unroll
      for (int r = 0; r < 17; ++r) acc[r] = 0.f;
      const float* wp = P.w_mod + ((size_t)layer * 1024 + ks * 128) * 3072 + n0 + nl;
      for (int k = 0; k < 128; ++k) {
        const float wv = wp[(size_t)k * 3072];
#pragma unroll
        for (int r = 0; r < 17; ++r) acc[r] += s[r * 1024 + ks * 128 + k] * wv;
      }
#pragma unroll
      for (int r = 0; r < 17; ++r) red[(ks * 17 + r) * 64 + nl] = acc[r];
      __syncthreads();
      for (int o = tid; o < 17 * 64; o += 512) {
        const int r = o >> 6, n = o & 63;
        float v = P.b_mod[layer * 3072 + n0 + n];
#pragma unroll
        for (int k2 = 0; k2 < 8; ++k2) v += red[(k2 * 17 + r) * 64 + n];
        mods[(layer * 17 + r) * 3072 + n0 + n] = v;
      }
      __syncthreads();
    } else {
      const int base = ((task - 192) * 512 + tid) * 8;
#pragma unroll 1
      for (int e = 0; e < 8; ++e) {
        const int ent = base + e;
        const int t = ent >> 5, a = (ent >> 4) & 1, f = ent & 15;
        const float pos = (float)(a ? (t & 63) : (t >> 6));
        const float inv = powf(10000.f, -(float)f / 16.f);
        float sn, cs;
        sincosf(pos * inv, &sn, &cs);
        rope[ent] = make_float2(cs, sn);
      }
    }
  }
}

DI void cvt_tile(const float* __restrict__ src, int ldn, h16* __restrict__ dst, int ldk, int k0, int n0, float* t) {
  const int tid = otid();
  {
    const int r = tid >> 4, c4 = tid & 15;
#pragma unroll
    for (int i = 0; i < 2; ++i) {
      const int k = r + 32 * i;
      const float4 v = *(const float4*)(src + (size_t)(k0 + k) * ldn + n0 + c4 * 4);
      t[k * 65 + c4 * 4 + 0] = v.x; t[k * 65 + c4 * 4 + 1] = v.y; t[k * 65 + c4 * 4 + 2] = v.z; t[k * 65 + c4 * 4 + 3] = v.w;
    }
  }
  __syncthreads();
  {
    const int n = tid >> 3, kc = tid & 7;
    half8 o;
#pragma unroll
    for (int j = 0; j < 8; ++j) o[j] = (h16)t[(kc * 8 + j) * 65 + n];
    *(half8*)(dst + (size_t)(n0 + n) * ldk + k0 + kc * 8) = o;
  }
  __syncthreads();
}

DI void cvt_layer_weights(const Params& P, int layer, int t0, int step, char* smem) {
  h16* winT = (h16*)(P.ws + wbase(layer));
  h16* wbrT = (h16*)(P.ws + wbase(layer) + OFF_WBRT);
  h16* woutT = (h16*)(P.ws + wbase(layer) + OFF_WOUTT);
  for (int t = t0; t < 2112 + 384 + 256; t += step) {
    if (t < 2112) {
      cvt_tile(P.w_in + (size_t)layer * D * IN_COLS, IN_COLS, winT, LDH, (t & 15) * 64, (t >> 4) * 64, (float*)smem);
    } else if (t < 2112 + 384) {
      const int u = t - 2112, br = u >> 7, v = u & 127;
      cvt_tile(P.w_branch + ((size_t)layer * 3 + br) * WB * D, D, wbrT + (size_t)br * D * LDY, LDY, (v & 7) * 64, (v >> 3) * 64, (float*)smem);
    } else {
      const int u = t - 2112 - 384;
      cvt_tile(P.w_out + (size_t)layer * D * D, D, woutT, LDH, (u & 15) * 64, (u >> 4) * 64, (float*)smem);
    }
  }
}

DI void phase_norm(const Params& P, int layer, char* smem) {
  const int tid = otid(), w = tid >> 6, lane = tid & 63;
  if (layer == 0) cvt_layer_weights(P, 0, blockIdx.x, gridDim.x, smem);
  const int gw = blockIdx.x * 8 + w, nw = gridDim.x * 8;
  const float* mods = (const float*)(P.ws + WS_MODS) + (size_t)layer * 17 * 3072;
  const float* ng = P.norm_g + layer * D;
  h16* hb = (h16*)(P.ws + WS_H16);
  for (int row = gw; row < T_ALL; row += nw) {
    const float* src;
    int b;
    if (row < T_LAT) { src = (layer == 0 ? P.x : P.out) + (size_t)row * D; b = row >> 11; }
    else { const int rc = row - T_LAT; src = (layer == 0 ? P.ctx : (const float*)(P.ws + WS_CTXW)) + (size_t)rc * D; b = 16; }
    const float* md = mods + b * 3072;
    float4 xv[4];
    float ss = 0.f;
#pragma unroll
    for (int j = 0; j < 4; ++j) {
      xv[j] = *(const float4*)(src + j * 256 + lane * 4);
      ss += xv[j].x * xv[j].x + xv[j].y * xv[j].y + xv[j].z * xv[j].z + xv[j].w * xv[j].w;
    }
#pragma unroll
    for (int m = 32; m >= 1; m >>= 1) ss += __shfl_xor(ss, m);
    const float rstd = rsqrtf(ss * (1.f / 1024.f) + 1e-6f);
#pragma unroll
    for (int j = 0; j < 4; ++j) {
      const int k = j * 256 + lane * 4;
      const float4 g = *(const float4*)(ng + k);
      const float4 sh = *(const float4*)(md + k);
      const float4 sc = *(const float4*)(md + 1024 + k);
      *(half4*)(hb + (size_t)row * LDH + k) = cvt4(xv[j].x * rstd * g.x * (1.f + sc.x) + sh.x, xv[j].y * rstd * g.y * (1.f + sc.y) + sh.y,
                                                  xv[j].z * rstd * g.z * (1.f + sc.z) + sh.z, xv[j].w * rstd * g.w * (1.f + sc.w) + sh.w);
    }
  }
  float* h2 = (float*)(P.ws + WS_H2);
  const float* w1 = P.fw1 + layer * 33 * 64;
  const float* w2 = P.fw2 + layer * 64 * 64;
  const float f0 = P.ffreq[layer * 128 + lane], f1 = P.ffreq[layer * 128 + 64 + lane];
  const float b1 = P.fb1[layer * 64 + lane], b2 = P.fb2[layer * 64 + lane];
  for (int p = gw; p < SEQ + CTXL; p += nw) {
    const int L = p >= SEQ ? CTXL : SEQ, tau = p >= SEQ ? p - SEQ : p;
    const float tt = (float)tau / (float)(L - 1);
    const float wv = (6.283185307179586f / (float)L) * (float)tau;
    float feat = 0.f;
    if (lane == 0) feat = tt;
    else if (lane <= 16) feat = cosf(wv * (1e-4f + (float)(lane - 1) * ((15.f - 1e-4f) / 15.f)));
    else if (lane <= 32) feat = sinf(wv * (1e-4f + (float)(lane - 17) * ((15.f - 1e-4f) / 15.f)));
    float a1 = b1;
    for (int e = 0; e < 33; ++e) a1 += __shfl(feat, e) * w1[e * 64 + lane];
    const float h1 = sinf(f0 * a1);
    float a2 = b2;
    for (int k = 0; k < 64; ++k) a2 += __shfl(h1, k) * w2[k * 64 + lane];
    h2[(size_t)p * 64 + lane] = sinf(f1 * a2);
  }
}

DI void filt2_task(const Params& P, int layer, int set, int o, int cg16, char* smem) {
  const int tid = otid();
  const int L = set ? CTXL : SEQ, KLEN = set ? KLEN_C : KLEN_L, OFF = set ? KOFF_C : KOFF_L;
  h16* krb = (h16*)(P.ws + (set ? WS_KRC : WS_KRL));
  const float* h2 = (const float*)(P.ws + WS_H2) + (set ? (size_t)SEQ * 64 : 0);
  float* invS = (float*)(P.ws + WS_INVS);
  const int c0 = cg16 * 16;
  float* w3s = (float*)smem;
  float* part = w3s + 2048;
  for (int i = tid; i < 2048; i += 512) {
    const int k = i >> 5, d = (i >> 4) & 1, cc = i & 15;
    w3s[i] = P.fw3[((size_t)layer * 64 + k) * 2048 + (o * 2 + d) * 512 + c0 + cc];
  }
  __syncthreads();
  const int cc = tid & 15, sl = tid >> 4, c = c0 + cc;
  const float b30 = P.fb3[layer * 2048 + (o * 2 + 0) * 512 + c], b31 = P.fb3[layer * 2048 + (o * 2 + 1) * 512 + c];
  const float MIN_DECAY = -3.0701134573253940f, MAX_DECAY = -15.350567286626974f;
  const float delta = fabsf(MIN_DECAY + (float)c * ((MAX_DECAY - MIN_DECAY) / 511.f));
  h16* kr = krb + (size_t)(o * 512 + c) * KLEN;
  const int nper = L >> 5;
  float sum = 0.f;
  for (int tau = sl * nper; tau < (sl + 1) * nper; ++tau) {
    const float4* hr = (const float4*)(h2 + (size_t)tau * 64);
    float v0 = b30, v1 = b31;
#pragma unroll
    for (int kc = 0; kc < 16; ++kc) {
      const float4 hv = hr[kc];
      v0 += hv.x * w3s[(kc * 4 + 0) * 32 + cc] + hv.y * w3s[(kc * 4 + 1) * 32 + cc] + hv.z * w3s[(kc * 4 + 2) * 32 + cc] + hv.w * w3s[(kc * 4 + 3) * 32 + cc];
      v1 += hv.x * w3s[(kc * 4 + 0) * 32 + 16 + cc] + hv.y * w3s[(kc * 4 + 1) * 32 + 16 + cc] + hv.z * w3s[(kc * 4 + 2) * 32 + 16 + cc] + hv.w * w3s[(kc * 4 + 3) * 32 + 16 + cc];
    }
    const float tt = (float)tau / (float)(L - 1);
    const float dec = expf(-tt * delta);
    v0 *= dec; v1 *= dec;
    kr[OFF - tau] = (h16)v0;
    sum += fabsf(v0);
    if (tau >= 1) { kr[OFF + tau] = (h16)v1; sum += fabsf(v1); }
  }
  for (int z = sl; z < 257; z += 32) {
    const int idx = z < 65 ? z : (OFF + L + (z - 65));
    kr[idx] = (h16)0.f;
  }
  part[sl * 16 + cc] = sum;
  __syncthreads();
  if (tid < 16) {
    float tot = 0.f;
    for (int s2 = 0; s2 < 32; ++s2) tot += part[s2 * 16 + tid];
    invS[(set * 2 + o) * 512 + c0 + tid] = 1.f / tot;
  }
  __syncthreads();
}

struct SchedH {
  XcdSched xs;
  DI bool next(int i, Unit2& u) const { const int it = xs.item(i); if (it < 0) return false; u.pm = (it & 31) >> 2; u.pn = (it >> 5) * 4 + (it & 3); return true; }
};
struct EpiH {
  h16* hT;
  DI void operator()(const f32x4 (&acc)[2][2][4][2], const Unit2& u, int wr_, int wc_, int fr_, int fq_) const {
    const int tid2 = otid(), wid2 = tid2 >> 6, wr = wid2 >> 2, wc = wid2 & 3, fr = tid2 & 15, fq = (tid2 >> 4) & 3;
    const bool gate = u.pm >= 6;
    const int tok0 = u.pn * 256;
    const bool isctx = tok0 >= T_LAT;
#pragma unroll
    for (int ai = 0; ai < 2; ++ai)
#pragma unroll
      for (int m = 0; m < 4; ++m) {
        const int col = u.pm * 256 + ai * 128 + wr * 64 + m * 16 + fr;
#pragma unroll
        for (int bj = 0; bj < 2; ++bj)
#pragma unroll
          for (int n = 0; n < 2; ++n) {
            const int grow = tok0 + bj * 128 + wc * 32 + n * 16 + 4 * fq;
            float v0 = acc[ai][bj][m][n][0], v1 = acc[ai][bj][m][n][1], v2 = acc[ai][bj][m][n][2], v3 = acc[ai][bj][m][n][3];
            if (gate) { v0 = silu_f(v0); v1 = silu_f(v1); v2 = silu_f(v2); v3 = silu_f(v3); }
            h16* dst;
            if (!isctx) { const int b = grow >> 11, tt = grow & 2047; dst = hT + ((size_t)(b * 2048 + col) * SEQ + tt); }
            else { const int rc = grow - T_LAT, b = rc >> 8, tt = rc & 255; dst = hT + HTC_OFF + ((size_t)(b * 2048 + col) * CTXL + tt); }
            *(half4*)dst = cvt4(v0, v1, v2, v3);
          }
      }
  }
};
DI void phase_gemm_h(const Params& P, int layer, char* smem) {
  const bool last = layer == DEPTH - 1;
  const int n_mt = last ? 128 : 144;
  {
    const int nfilt = last ? 64 : 128;
    const int G = gridDim.x, first = G - (G >> 1);
    for (int item = (int)blockIdx.x - first; item >= 0 && item < nfilt; item += (G >> 1)) {
      const int id = nfilt - 1 - item;
      filt2_task(P, layer, id >> 6, (id & 63) >> 5, id & 31, smem);
    }
  }
  SchedH S; S.xs.init(n_mt * 8);
  EpiH E; E.hT = (h16*)(P.ws + WS_R1);
  gemm256_stream<false>(smem, (const h16*)(P.ws + wbase(layer)) + (size_t)H_OFF * LDH, LDH, (const h16*)(P.ws + WS_H16), LDH, D, S, E);
}

DI void phase_shortconv(const Params& P, int layer, char* smem) {
  const bool last = layer == DEPTH - 1;
  const int tid = otid(), lane = tid & 63, w = tid >> 6;
  const int gw = blockIdx.x * 8 + w, nw = gridDim.x * 8;
  h16* hT = (h16*)(P.ws + WS_R1);
  const float* cw = P.conv_h + (size_t)layer * 3 * 1536;
  const int nrows_l = NBATCH * 1536;
  const int nrows = last ? nrows_l : 2 * nrows_l;
  for (int r = gw; r < nrows; r += nw) {
    if (r < nrows_l) {
      const int b = r / 1536, col = r % 1536;
      const float w0 = cw[col], w1 = cw[1536 + col], w2 = cw[3072 + col];
      h16* p = hT + (size_t)(b * 2048 + col) * SEQ;
      half8 v[4];
#pragma unroll
      for (int j = 0; j < 4; ++j) v[j] = *(const half8*)(p + j * 512 + lane * 8);
      float prev[4], next[4];
#pragma unroll
      for (int j = 0; j < 4; ++j) {
        const float lastv = (float)v[j][7], firstv = (float)v[j][0];
        float pu = __shfl_up(lastv, 1);
        float nd = __shfl_down(firstv, 1);
        prev[j] = pu; next[j] = nd;
      }
#pragma unroll
      for (int j = 0; j < 4; ++j) {
        const float l63 = (j > 0) ? __shfl((float)v[j > 0 ? j - 1 : 0][7], 63) : 0.f;
        const float f0 = (j < 3) ? __shfl((float)v[j < 3 ? j + 1 : 3][0], 0) : 0.f;
        if (lane == 0) prev[j] = l63;
        if (lane == 63) next[j] = f0;
      }
#pragma unroll
      for (int j = 0; j < 4; ++j) {
        half8 o;
#pragma unroll
        for (int e = 0; e < 8; ++e) {
          const float a = e == 0 ? prev[j] : (float)v[j][e > 0 ? e - 1 : 0];
          const float cc = (float)v[j][e];
          const float d = e == 7 ? next[j] : (float)v[j][e < 7 ? e + 1 : 7];
          o[e] = (h16)(w0 * a + w1 * cc + w2 * d);
        }
        *(half8*)(p + j * 512 + lane * 8) = o;
      }
    } else {
      const int r2 = r - nrows_l;
      const int b = r2 / 1536, col = r2 % 1536;
      const float w0 = cw[col], w1 = cw[1536 + col], w2 = cw[3072 + col];
      h16* p = hT + HTC_OFF + (size_t)(b * 2048 + col) * CTXL;
      const half4 v = *(const half4*)(p + lane * 4);
      float prev = __shfl_up((float)v[3], 1), next = __shfl_down((float)v[0], 1);
      if (lane == 0) prev = 0.f;
      if (lane == 63) next = 0.f;
      half4 o;
      o[0] = (h16)(w0 * prev + w1 * (float)v[0] + w2 * (float)v[1]);
      o[1] = (h16)(w0 * (float)v[0] + w1 * (float)v[1] + w2 * (float)v[2]);
      o[2] = (h16)(w0 * (float)v[1] + w1 * (float)v[2] + w2 * (float)v[3]);
      o[3] = (h16)(w0 * (float)v[2] + w1 * (float)v[3] + w2 * next);
      *(half4*)(p + lane * 4) = o;
    }
  }
}

template <int MODE, int TB>
DI void toeplitz_task(const Params& P, int layer, int set, int cg, int chunk, char* smem) {
  const int tid = otid(), w = tid >> 6, lane = tid & 63;
  const int L = set ? CTXL : SEQ, KLEN = set ? KLEN_C : KLEN_L, OFF = set ? KOFF_C : KOFF_L;
  const h16* krg = (const h16*)(P.ws + (set ? WS_KRC : WS_KRL)) + (size_t)(MODE * 512 + cg * 8) * KLEN;
  h16* krs = (h16*)smem;
  char* stg = smem + 8 * KLEN_L * 2;
  for (int i = tid; i < KLEN; i += 512) *(half8*)(krs + i * 8) = *(const half8*)(krg + i * 8);
  __syncthreads();
  const int c = cg * 8 + w;
  const int bb = lane & 15, kg = lane >> 4;
  const h16* hT = (const h16*)(P.ws + WS_R1) + (set ? HTC_OFF : 0);
  h16* z1T = (h16*)(P.ws + WS_R2) + (set ? Z1C_OFF : 0);
  const h16* Urow = (MODE == 0) ? hT + (size_t)(bb * 2048 + c) * L : z1T + (size_t)(bb * 512 + c) * L;
  const float invs = ((const float*)(P.ws + WS_INVS))[(set * 2 + MODE) * 512 + c];
  const float bias = P.hbias[(layer * 2 + MODE) * 512 + c];
  const int nsteps = (L >> 5) + 1;
  constexpr int GS = TB == 4 ? 2 : 5;
  const int ngroups = (nsteps + GS - 1) / GS;
  const int npass = (TB == 4 || set) ? 1 : 2;
  const h16* krw = krs + w * KLEN;
  for (int pass = 0; pass < npass; ++pass) {
    const int tb = chunk * 512 + pass * 256;
    f32x4 acc[TB][8];
#pragma unroll
    for (int ta = 0; ta < TB; ++ta)
#pragma unroll
      for (int r = 0; r < 8; ++r) acc[ta][r] = f32x4{0.f, 0.f, 0.f, 0.f};
    u32x4 cur[2 * GS], nxt[2 * GS];
    auto load_group = [&](int g, u32x4 (&dst)[2 * GS]) {
#pragma unroll
      for (int q = 0; q < GS; ++q) {
        const int s = -32 + (g * GS + q) * 32 + 8 * kg;
        const int s2 = s + 8;
        const int sc = min(max(s, 0), L - 8), sc2 = min(max(s2, 0), L - 8);
        dst[2 * q] = *(const u32x4*)(Urow + sc);
        dst[2 * q + 1] = *(const u32x4*)(Urow + sc2);
      }
    };
    load_group(0, cur);
    const int abase = OFF - tb - 8 * ((lane & 15) - kg);
    half8 afn[TB];
#pragma unroll
    for (int ta = 0; ta < TB; ++ta) afn[ta] = *(const half8*)(krw + abase - 32 - 128 * ta);
    for (int g = 0; g < ngroups; ++g) {
      load_group(g + 1 < ngroups ? g + 1 : g, nxt);
      __builtin_amdgcn_sched_barrier(0);
#pragma unroll
      for (int q = 0; q < GS; ++q) {
        const int s0 = -32 + (g * GS + q) * 32;
        half8 af[TB];
#pragma unroll
        for (int ta = 0; ta < TB; ++ta) { af[ta] = afn[ta]; afn[ta] = *(const half8*)(krw + abase + s0 + 32 - 128 * ta); }
        unsigned d[8];
        {
          const int sw0 = s0 + 8 * kg, sw1 = sw0 + 8;
          const bool va = (sw0 >= 0) && (sw0 < L), vb = (sw1 >= 0) && (sw1 < L);
#pragma unroll
          for (int e = 0; e < 4; ++e) { d[e] = va ? cur[2 * q][e] : 0u; d[4 + e] = vb ? cur[2 * q + 1][e] : 0u; }
        }
#pragma unroll
        for (int r = 0; r < 8; ++r) {
          u32x4 bw;
#pragma unroll
          for (int e = 0; e < 4; ++e)
            bw[e] = (r & 1) ? __builtin_amdgcn_alignbit(d[(r >> 1) + e + 1 > 7 ? 7 : (r >> 1) + e + 1], d[(r >> 1) + e], 16) : d[(r >> 1) + e];
          const half8 bfr = __builtin_bit_cast(half8, bw);
#pragma unroll
          for (int ta = 0; ta < TB; ++ta) acc[ta][r] = __builtin_amdgcn_mfma_f32_16x16x32_f16(af[ta], bfr, acc[ta][r], 0, 0, 0);
        }
      }
#pragma unroll
      for (int e = 0; e < 2 * GS; ++e) cur[e] = nxt[e];
    }
#pragma unroll
    for (int hf = 0; hf < TB / 2; ++hf) {
    const int tbh = tb + 256 * hf;
#pragma unroll
    for (int ta = 2 * hf; ta < 2 * hf + 2; ++ta) {
      const int t0 = tb + 128 * ta + 32 * kg;
#pragma unroll
      for (int v = 0; v < 4; ++v) {
        const int t = t0 + 8 * v;
        if (MODE == 0) {
          const half8 x1 = *(const half8*)(hT + (size_t)(bb * 2048 + 512 + c) * L + t);
          const half8 uu = *(const half8*)(Urow + t);
          half8 o;
#pragma unroll
          for (int r = 0; r < 8; ++r) o[r] = (h16)((float)x1[r] * (acc[ta][r][v] * invs + (float)uu[r] * bias));
          *(half8*)(z1T + (size_t)(bb * 512 + c) * L + t) = o;
        } else {
          const half8 x2 = *(const half8*)(hT + (size_t)(bb * 2048 + 1024 + c) * L + t);
          const half8 gt = *(const half8*)(hT + (size_t)(bb * 2048 + 1536 + c) * L + t);
          const half8 uu = *(const half8*)(Urow + t);
#pragma unroll
          for (int r = 0; r < 8; ++r) {
            const float y = (float)x2[r] * (acc[ta][r][v] * invs + (float)uu[r] * bias) * (float)gt[r];
            const int tl = t - tbh + r;
            *(h16*)(stg + ((tl * 16 + bb) * 8 + w) * 2) = (h16)y;
          }
        }
      }
    }
    if (MODE == 1) {
      __syncthreads();
      h16* yb = (h16*)(P.ws + WS_YB);
#pragma unroll
      for (int i = 0; i < 8; ++i) {
        const int item = tid + 512 * i;
        const int b = item >> 8, tl = item & 255;
        const size_t tok = set ? (size_t)T_LAT + b * CTXL + tbh + tl : (size_t)b * SEQ + tbh + tl;
        *(half8*)(yb + tok * LDY + cg * 8) = *(const half8*)(stg + (tl * 16 + b) * 16);
      }
      __syncthreads();
    }
    }
  }
  __syncthreads();
}

template <int MODE>
DI void phase_toeplitz(const Params& P, int layer, char* smem) {
  const bool last = layer == DEPTH - 1;
  const int total = last ? 256 : 320;
  for (int item = blockIdx.x; item < total; item += gridDim.x) {
    if (item < 256) {
      const int xj = item >> 3;
      toeplitz_task<MODE, 4>(P, layer, 0, (item & 7) + 8 * (xj >> 2), xj & 3, smem);
    }
    else toeplitz_task<MODE, 2>(P, layer, 1, item - 256, 0, smem);
  }
}

struct SchedAQ {
  XcdSched xs; bool last;
  DI bool next(int i, Unit2& u) const {
    const int it = xs.item(i); if (it < 0) return false;
    int mt, nt;
    if (last && it >= 128 * 13) { mt = 128 + (it - 128 * 13); nt = 10; }
    else { const int g = it / 52, rem = it % 52; nt = rem >> 2; mt = g * 4 + (rem & 3); }
    u.pm = mt; u.pn = nt < 8 ? nt : nt + 8;
    return true;
  }
};
struct EpiAQ {
  h16 *pa, *qb, *kb, *vT, *zs;
  const float *qg, *kg;
  const float2* rope;
  DI void norm_rope(f32x4 (&x)[2][2], const float* gvec, bool do_rope, int t, int fq) const {
    float ss = 0.f;
#pragma unroll
    for (int bj = 0; bj < 2; ++bj)
#pragma unroll
      for (int n = 0; n < 2; ++n)
#pragma unroll
        for (int v = 0; v < 4; ++v) ss += x[bj][n][v] * x[bj][n][v];
    ss += __shfl_xor(ss, 16);
    ss += __shfl_xor(ss, 32);
    const float rstd = rsqrtf(ss * (1.f / 64.f) + 1e-6f);
#pragma unroll
    for (int bj = 0; bj < 2; ++bj)
#pragma unroll
      for (int n = 0; n < 2; ++n) {
        const float4 g = *(const float4*)(gvec + bj * 32 + n * 16 + 4 * fq);
        x[bj][n][0] *= rstd * g.x; x[bj][n][1] *= rstd * g.y; x[bj][n][2] *= rstd * g.z; x[bj][n][3] *= rstd * g.w;
      }
    if (do_rope) {
#pragma unroll
      for (int bj = 0; bj < 2; ++bj) {
        const float4* rp = (const float4*)(rope + ((size_t)t * 2 + bj) * 16 + 4 * fq);
        const float4 ca = rp[0], cb = rp[1];
        const float cs[4] = {ca.x, ca.z, cb.x, cb.z}, sn[4] = {ca.y, ca.w, cb.y, cb.w};
#pragma unroll
        for (int v = 0; v < 4; ++v) {
          const float x1 = x[bj][0][v], x2 = x[bj][1][v];
          x[bj][0][v] = x1 * cs[v] - x2 * sn[v];
          x[bj][1][v] = x2 * cs[v] + x1 * sn[v];
        }
      }
    }
  }
  DI void operator()(const f32x4 (&acc)[2][2][4][2], const Unit2& u, int wr_, int wc_, int fr_, int fq_) const {
    const int tid2 = otid(), wid2 = tid2 >> 6, wr = wid2 >> 2, wc = wid2 & 3, fr = tid2 & 15, fq = (tid2 >> 4) & 3;
    const int row0 = u.pm * 256;
    const bool isctx = row0 >= T_LAT;
    const int pn = u.pn;
#pragma unroll
    for (int ai = 0; ai < 2; ++ai)
#pragma unroll
      for (int m = 0; m < 4; ++m) {
        const int row = row0 + ai * 128 + wr * 64 + m * 16 + fr;
        int b, t;
        if (!isctx) { b = row >> 11; t = row & 2047; } else { b = (row - T_LAT) >> 8; t = (row - T_LAT) & 255; }
        f32x4 x[2][2];
#pragma unroll
        for (int bj = 0; bj < 2; ++bj)
#pragma unroll
          for (int n = 0; n < 2; ++n) x[bj][n] = acc[ai][bj][m][n];
        if (pn < 8) {
#pragma unroll
          for (int bj = 0; bj < 2; ++bj)
#pragma unroll
            for (int n = 0; n < 2; ++n) {
              f32x4 v = x[bj][n];
              if (pn >= 6) { v[0] = silu_f(v[0]); v[1] = silu_f(v[1]); v[2] = silu_f(v[2]); v[3] = silu_f(v[3]); }
              *(half4*)(pa + (size_t)row * 2048 + pn * 256 + wc * 64 + bj * 32 + n * 16 + 4 * fq) = cvt4(v[0], v[1], v[2], v[3]);
            }
        } else if (pn < 18) {
          const int head = (pn - 16) * 4 + wc;
          norm_rope(x, qg, !isctx, t, fq);
#pragma unroll
          for (int bj = 0; bj < 2; ++bj)
#pragma unroll
            for (int n = 0; n < 2; ++n)
              *(half4*)(qb + (size_t)row * 512 + head * 64 + bj * 32 + n * 16 + 4 * fq) = cvt4(x[bj][n][0], x[bj][n][1], x[bj][n][2], x[bj][n][3]);
        } else if (pn == 18) {
          const int key = isctx ? t : CTXL + t;
          if (wc < 2) {
            norm_rope(x, kg, !isctx, t, fq);
#pragma unroll
            for (int bj = 0; bj < 2; ++bj)
#pragma unroll
              for (int n = 0; n < 2; ++n)
                *(half4*)(kb + ((size_t)(b * 2 + wc) * SKV + key) * 64 + bj * 32 + n * 16 + 4 * fq) = cvt4(x[bj][n][0], x[bj][n][1], x[bj][n][2], x[bj][n][3]);
          } else {
#pragma unroll
            for (int bj = 0; bj < 2; ++bj)
#pragma unroll
              for (int n = 0; n < 2; ++n)
#pragma unroll
                for (int v = 0; v < 4; ++v) vT[((size_t)(b * 2 + (wc - 2)) * 64 + bj * 32 + n * 16 + 4 * fq + v) * SKV + key] = (h16)x[bj][n][v];
          }
        } else {
#pragma unroll
          for (int bj = 0; bj < 2; ++bj)
#pragma unroll
            for (int n = 0; n < 2; ++n)
              *(half4*)(zs + (size_t)row * 512 + (pn - 19) * 256 + wc * 64 + bj * 32 + n * 16 + 4 * fq) =
                  cvt4(silu_f(x[bj][n][0]), silu_f(x[bj][n][1]), silu_f(x[bj][n][2]), silu_f(x[bj][n][3]));
        }
      }
  }
};
DI void phase_gemm_aq(const Params& P, int layer, char* smem) {
  const bool last = layer == DEPTH - 1;
  SchedAQ S; S.last = last; S.xs.init(128 * 13 + (last ? 16 : 16 * 13));
  EpiAQ E;
  E.pa = (h16*)(P.ws + WS_R1); E.qb = (h16*)(P.ws + WS_Q); E.kb = (h16*)(P.ws + WS_K); E.vT = (h16*)(P.ws + WS_VT); E.zs = (h16*)(P.ws + WS_ZS);
  E.qg = P.qg + layer * 64; E.kg = P.kg + layer * 64; E.rope = (const float2*)(P.ws + WS_ROPE);
  if (!last) {
    const int G = gridDim.x;
    if ((G & 7) == 0) {
      const int nxb = G >> 3, per = (128 * 13 + 16 * 13 + 7) >> 3, nlong = per - (per / nxb) * nxb;
      const int j = blockIdx.x >> 3, xcd = blockIdx.x & 7;
      if (j >= nlong) cvt_layer_weights(P, layer + 1, (j - nlong) * 8 + xcd, (nxb - nlong) * 8, smem);
    } else cvt_layer_weights(P, layer + 1, blockIdx.x, G, smem);
  }
  gemm256_stream<true>(smem, (const h16*)(P.ws + WS_H16), LDH, (const h16*)(P.ws + wbase(layer)), LDH, D, S, E);
}

DI void attn_task(const Params& P, int set, int b, int kvh, int qt, char* smem) {
  const int tid = otid(), w = tid >> 6, lane = tid & 63, r32 = lane & 31, hh = lane >> 5;
  const int head = kvh * 4 + (w & 3), qsub = w >> 2;
  const int nkeys = set ? CTXL : SKV;
  const size_t row0 = (set ? (size_t)T_LAT + b * CTXL : (size_t)b * SEQ) + qt * 128 + qsub * 64 + r32;
  const h16* qb = (const h16*)(P.ws + WS_Q);
  h16* yc = (h16*)(P.ws + WS_YC);
  const h16* zs = (const h16*)(P.ws + WS_ZS);
  const h16* kg = (const h16*)(P.ws + WS_K) + (size_t)(b * 2 + kvh) * SKV * 64;
  const h16* vg = (const h16*)(P.ws + WS_VT) + (size_t)(b * 2 + kvh) * 64 * SKV;
  half8 qf[2][4];
#pragma unroll
  for (int qi = 0; qi < 2; ++qi)
#pragma unroll
    for (int ds = 0; ds < 4; ++ds) qf[qi][ds] = *(const half8*)(qb + (row0 + 32 * qi) * 512 + head * 64 + 16 * ds + 8 * hh);
  const int srow = tid >> 3, sch = tid & 7, ssw = (srow >> 1) & 7;
  const int k_wr = srow * 128 + ((sch ^ ssw) * 16);
  const int u = sch >> 1, od = sch & 1;
  const int v_wr0 = 8192 + srow * 128 + (((2 * u) ^ ssw) * 16) + 8 * od;
  const int v_wr1 = 8192 + srow * 128 + (((2 * u + 1) ^ ssw) * 16) + 8 * od;
  const int sw = (r32 >> 1) & 7;
  const int ntile = nkeys >> 6;
  half8 kreg = *(const half8*)(kg + (size_t)srow * 64 + sch * 8);
  half8 vreg = *(const half8*)(vg + (size_t)srow * SKV + sch * 8);
  {
    char* s = smem;
    *(half8*)(s + k_wr) = kreg;
    half4 lo, hi;
    lo[0] = vreg[0]; lo[1] = vreg[1]; lo[2] = vreg[2]; lo[3] = vreg[3];
    hi[0] = vreg[4]; hi[1] = vreg[5]; hi[2] = vreg[6]; hi[3] = vreg[7];
    *(half4*)(s + v_wr0) = lo;
    *(half4*)(s + v_wr1) = hi;
  }
  __syncthreads();
  f32x16 o[2][2];
#pragma unroll
  for (int qi = 0; qi < 2; ++qi)
#pragma unroll
    for (int v = 0; v < 16; ++v) { o[qi][0][v] = 0.f; o[qi][1][v] = 0.f; }
  float m_run[2] = {-1e30f, -1e30f}, l_run[2] = {0.f, 0.f};
  const float cscale = 0.125f * 1.4426950408889634f;
  asm volatile("" : "+v"(qf[0][0]), "+v"(qf[0][1]), "+v"(qf[0][2]), "+v"(qf[0][3]), "+v"(qf[1][0]), "+v"(qf[1][1]), "+v"(qf[1][2]), "+v"(qf[1][3]));
#pragma unroll 1
  for (int kt = 0; kt < ntile; ++kt) {
    if (kt + 1 < ntile) {
      kreg = *(const half8*)(kg + (size_t)((kt + 1) * 64 + srow) * 64 + sch * 8);
      vreg = *(const half8*)(vg + (size_t)srow * SKV + (kt + 1) * 64 + sch * 8);
    }
    const char* s = smem + (kt & 1) * 16384;
    f32x16 sc[2][2];
#pragma unroll
    for (int qi = 0; qi < 2; ++qi)
#pragma unroll
      for (int v = 0; v < 16; ++v) { sc[qi][0][v] = 0.f; sc[qi][1][v] = 0.f; }
#pragma unroll
    for (int ds = 0; ds < 4; ++ds) {
      const int co = ((2 * ds + hh) ^ sw) * 16;
      const half8 k0 = *(const half8*)(s + r32 * 128 + co);
      const half8 k1 = *(const half8*)(s + (32 + r32) * 128 + co);
#pragma unroll
      for (int qi = 0; qi < 2; ++qi) {
        sc[qi][0] = __builtin_amdgcn_mfma_f32_32x32x16_f16(k0, qf[qi][ds], sc[qi][0], 0, 0, 0);
        sc[qi][1] = __builtin_amdgcn_mfma_f32_32x32x16_f16(k1, qf[qi][ds], sc[qi][1], 0, 0, 0);
      }
    }
#pragma unroll
    for (int qi = 0; qi < 2; ++qi) {
      float mx = sc[qi][0][0];
#pragma unroll
      for (int v = 0; v < 16; ++v) { mx = fmaxf(mx, sc[qi][0][v]); mx = fmaxf(mx, sc[qi][1][v]); }
      mx = fmaxf(mx, __shfl_xor(mx, 32));
      const float m_new = fmaxf(m_run[qi], mx * cscale);
      const float alpha = __builtin_amdgcn_exp2f(m_run[qi] - m_new);
      m_run[qi] = m_new;
      float ps = 0.f;
#pragma unroll
      for (int v = 0; v < 16; ++v) {
        sc[qi][0][v] = __builtin_amdgcn_exp2f(sc[qi][0][v] * cscale - m_new); ps += sc[qi][0][v];
        sc[qi][1][v] = __builtin_amdgcn_exp2f(sc[qi][1][v] * cscale - m_new); ps += sc[qi][1][v];
      }
      l_run[qi] = l_run[qi] * alpha + ps;
#pragma unroll
      for (int v = 0; v < 16; ++v) { o[qi][0][v] *= alpha; o[qi][1][v] *= alpha; }
    }
#pragma unroll
    for (int uu = 0; uu < 4; ++uu) {
      const int co = ((2 * uu + hh) ^ sw) * 16;
      const half8 v0 = *(const half8*)(s + 8192 + r32 * 128 + co);
      const half8 v1 = *(const half8*)(s + 8192 + (32 + r32) * 128 + co);
#pragma unroll
      for (int qi = 0; qi < 2; ++qi) {
        half8 pf;
#pragma unroll
        for (int j = 0; j < 8; ++j) pf[j] = (h16)((uu < 2) ? sc[qi][0][8 * (uu & 1) + j] : sc[qi][1][8 * (uu & 1) + j]);
        o[qi][0] = __builtin_amdgcn_mfma_f32_32x32x16_f16(v0, pf, o[qi][0], 0, 0, 0);
        o[qi][1] = __builtin_amdgcn_mfma_f32_32x32x16_f16(v1, pf, o[qi][1], 0, 0, 0);
      }
    }
    if (kt + 1 < ntile) {
      char* s2 = smem + ((kt + 1) & 1) * 16384;
      *(half8*)(s2 + k_wr) = kreg;
      half4 lo, hi;
      lo[0] = vreg[0]; lo[1] = vreg[1]; lo[2] = vreg[2]; lo[3] = vreg[3];
      hi[0] = vreg[4]; hi[1] = vreg[5]; hi[2] = vreg[6]; hi[3] = vreg[7];
      *(half4*)(s2 + v_wr0) = lo;
      *(half4*)(s2 + v_wr1) = hi;
    }
    __syncthreads();
  }
#pragma unroll
  for (int qi = 0; qi < 2; ++qi) {
    const float ltot = l_run[qi] + __shfl_xor(l_run[qi], 32);
    const float inv = 1.f / ltot;
    const size_t row = row0 + 32 * qi;
#pragma unroll
    for (int db = 0; db < 2; ++db)
#pragma unroll
      for (int g = 0; g < 4; ++g) {
        const size_t off = row * 512 + head * 64 + db * 32 + 8 * g + 4 * hh;
        const half4 z = *(const half4*)(zs + off);
        const f32x16& oo = o[qi][db];
        *(half4*)(yc + row * LDY + head * 64 + db * 32 + 8 * g + 4 * hh) = cvt4(oo[4 * g] * inv * (float)z[0], oo[4 * g + 1] * inv * (float)z[1], oo[4 * g + 2] * inv * (float)z[2], oo[4 * g + 3] * inv * (float)z[3]);
      }
  }
}

DI void phase_attn(const Params& P, int layer, char* smem) {
  const bool last = layer == DEPTH - 1;
  const int n_lat = NBATCH * 2 * 16;
  const int total = n_lat + (last ? 0 : NBATCH * 2 * 2);
  for (int item = blockIdx.x; item < total; item += gridDim.x) {
    if (item < n_lat) attn_task(P, 0, item >> 5, (item >> 4) & 1, item & 15, smem);
    else { const int u = item - n_lat; attn_task(P, 1, u >> 2, (u >> 1) & 1, u & 1, smem); }
  }
  const int tid = otid(), lane = tid & 63, w = tid >> 6;
  const int gw = blockIdx.x * 8 + w, nw = gridDim.x * 8;
  const h16* pa = (const h16*)(P.ws + WS_R1);
  h16* ya = (h16*)(P.ws + WS_R2);
  const int nitems = (last ? T_LAT : T_ALL) / 8;
  const float* cw = P.conv_a + (size_t)layer * 3 * 512 + lane * 8;
  float w0[8], w1[8], w2[8];
#pragma unroll
  for (int e = 0; e < 8; ++e) { w0[e] = cw[e]; w1[e] = cw[512 + e]; w2[e] = cw[1024 + e]; }
  for (int it = gw; it < nitems; it += nw) {
    const int tk0 = it * 8;
    int t0, L;
    if (tk0 < T_LAT) { t0 = tk0 & 2047; L = SEQ; } else { t0 = (tk0 - T_LAT) & 255; L = CTXL; }
    float up[8], uc[8], un[8];
    auto load_u = [&](int dt, float (&dst)[8]) {
      const int t = t0 + dt;
      if (t < 0 || t >= L) {
#pragma unroll
        for (int e = 0; e < 8; ++e) dst[e] = 0.f;
      } else {
        const h16* rp = pa + (size_t)(tk0 + dt) * 2048 + lane * 8;
        const half8 xa = *(const half8*)rp, ca = *(const half8*)(rp + 1024);
#pragma unroll
        for (int e = 0; e < 8; ++e) dst[e] = (float)xa[e] * (float)ca[e];
      }
    };
    load_u(-1, up);
    load_u(0, uc);
#pragma unroll 1
    for (int dt = 0; dt < 8; ++dt) {
      load_u(dt + 1, un);
      const h16* rp = pa + (size_t)(tk0 + dt) * 2048 + lane * 8;
      const half8 ba = *(const half8*)(rp + 512), za = *(const half8*)(rp + 1536);
      half8 o;
#pragma unroll
      for (int e = 0; e < 8; ++e) o[e] = (h16)((float)ba[e] * (w0[e] * up[e] + w1[e] * uc[e] + w2[e] * un[e]) * (float)za[e]);
      *(half8*)(ya + (size_t)(tk0 + dt) * LDY + lane * 8) = o;
#pragma unroll
      for (int e = 0; e < 8; ++e) { up[e] = uc[e]; uc[e] = un[e]; }
    }
  }
}

template <int MB>
DI void merge_tile(const Params& P, int layer, size_t row0, int nt, char* smem) {
  const h16* hb = (const h16*)(P.ws + WS_H16);
  const h16* winT = (const h16*)(P.ws + wbase(layer));
  const h16* wbrT = (const h16*)(P.ws + wbase(layer) + OFF_WBRT);
  h16* mg = (h16*)(P.ws + WS_R1);
  f32x16 macc[MB][2];
  zero_acc<MB>(macc);
#pragma unroll 1
  for (int n = 0; n < 3; ++n) {
    const h16* yn = (const h16*)(P.ws + (n == 0 ? WS_R2 : (n == 1 ? WS_YB : WS_YC)));
    f32x16 pa2[MB][2];
    half8 gpk[MB][2][2];
    zero_acc<MB>(pa2);
    gemm_kloop<MB, true>(pa2, hb + row0 * LDH, LDH, winT + (size_t)(G_OFF + n * 1024 + nt * 256) * LDH, LDH, D, smem);
#pragma unroll
    for (int mb = 0; mb < MB; ++mb)
#pragma unroll
      for (int nb = 0; nb < 2; ++nb)
#pragma unroll
        for (int v = 0; v < 16; ++v) gpk[mb][nb][v >> 3][v & 7] = (h16)sigmoid_f(pa2[mb][nb][v]);
    zero_acc<MB>(pa2);
    gemm_kloop<MB, true>(pa2, yn + row0 * LDY, LDY, wbrT + (size_t)(n * 1024 + nt * 256) * LDY, LDY, WB, smem);
#pragma unroll
    for (int mb = 0; mb < MB; ++mb)
#pragma unroll
      for (int nb = 0; nb < 2; ++nb)
#pragma unroll
        for (int v = 0; v < 16; ++v) macc[mb][nb][v] += (float)gpk[mb][nb][v >> 3][v & 7] * pa2[mb][nb][v];
  }
  const int tid = otid(), lane = tid & 63, w = tid >> 6, wr = w >> 2, wc = w & 3, r32 = lane & 31, hh = lane >> 5;
#pragma unroll
  for (int mb = 0; mb < MB; ++mb) {
    const size_t row = row0 + wr * 32 * MB + mb * 32 + r32;
#pragma unroll
    for (int nb = 0; nb < 2; ++nb)
#pragma unroll
      for (int g = 0; g < 4; ++g)
        *(half4*)(mg + row * LDH + nt * 256 + wc * 64 + nb * 32 + 8 * g + 4 * hh) =
            cvt4(macc[mb][nb][4 * g], macc[mb][nb][4 * g + 1], macc[mb][nb][4 * g + 2], macc[mb][nb][4 * g + 3]);
  }
}
DI void split_rounds(int total, int& nfull, int& nhalf) {
  const int G = gridDim.x;
  nfull = (total / G) * G;
  const int rem = total - nfull;
  if (rem > 0 && 2 * rem <= G) nhalf = 2 * rem; else { nfull = total; nhalf = 0; }
}
DI void phase_merge(const Params& P, int layer, char* smem) {
  const bool last = layer == DEPTH - 1;
  const int total = (last ? T_LAT : T_ALL) / 128 * 4;
  int nfull, nhalf;
  split_rounds(total, nfull, nhalf);
  for_items_xcd(nfull, [&](int item) {
    const int mt = (item >> 5) * 8 + (item & 7), nt = (item & 31) >> 3;
    merge_tile<2>(P, layer, (size_t)mt * 128, nt, smem);
  });
  for_items_xcd(nhalf, [&](int h) {
    const int item = nfull + (h >> 1);
    const int mt = (item >> 5) * 8 + (item & 7), nt = (item & 31) >> 3;
    merge_tile<1>(P, layer, (size_t)mt * 128 + (h & 1) * 64, nt, smem);
  });
}

template <int MB>
DI void out_tile(const Params& P, int layer, int row0, int nt, char* smem) {
  const h16* mg = (const h16*)(P.ws + WS_R1);
  const h16* woutT = (const h16*)(P.ws + wbase(layer) + OFF_WOUTT);
  const float* mods = (const float*)(P.ws + WS_MODS) + (size_t)layer * 17 * 3072;
  float* ctxw = (float*)(P.ws + WS_CTXW);
  f32x16 acc[MB][2];
  zero_acc<MB>(acc);
  gemm_kloop<MB, true>(acc, mg + (size_t)row0 * LDH, LDH, woutT + (size_t)(nt * 256) * LDH, LDH, D, smem);
  const int tid = otid(), lane = tid & 63, w = tid >> 6, wr = w >> 2, wc = w & 3, r32 = lane & 31, hh = lane >> 5;
#pragma unroll
  for (int mb = 0; mb < MB; ++mb) {
    const int row = row0 + wr * 32 * MB + mb * 32 + r32;
    const float* src; float* dst; int b;
    if (row < T_LAT) { b = row >> 11; src = (layer == 0 ? P.x : P.out) + (size_t)row * D; dst = P.out + (size_t)row * D; }
    else { const int rc = row - T_LAT; b = 16; src = (layer == 0 ? P.ctx : ctxw) + (size_t)rc * D; dst = ctxw + (size_t)rc * D; }
    const float* gt = mods + b * 3072 + 2048;
#pragma unroll
    for (int nb = 0; nb < 2; ++nb)
#pragma unroll
      for (int g = 0; g < 4; ++g) {
        const int col = nt * 256 + wc * 64 + nb * 32 + 8 * g + 4 * hh;
        const float4 xo = *(const float4*)(src + col);
        const float4 gv = *(const float4*)(gt + col);
        float4 r;
        r.x = xo.x + gv.x * acc[mb][nb][4 * g]; r.y = xo.y + gv.y * acc[mb][nb][4 * g + 1];
        r.z = xo.z + gv.z * acc[mb][nb][4 * g + 2]; r.w = xo.w + gv.w * acc[mb][nb][4 * g + 3];
        *(float4*)(dst + col) = r;
      }
  }
}
DI void phase_out(const Params& P, int layer, char* smem) {
  const bool last = layer == DEPTH - 1;
  const int total = (last ? T_LAT : T_ALL) / 128 * 4;
  int nfull, nhalf;
  split_rounds(total, nfull, nhalf);
  for_items_xcd(nfull, [&](int item) {
    const int mt = (item >> 5) * 8 + (item & 7), nt = (item & 31) >> 3;
    out_tile<2>(P, layer, mt * 128, nt, smem);
  });
  for_items_xcd(nhalf, [&](int h) {
    const int item = nfull + (h >> 1);
    const int mt = (item >> 5) * 8 + (item & 7), nt = (item & 31) >> 3;
    out_tile<1>(P, layer, mt * 128 + (h & 1) * 64, nt, smem);
  });
}

#define XB_TMO      128
#define XB_XCNT(j)  (256  + 64 * (j))
#define XB_XSUB(j)  (1280 + 64 * (j))
#define XB_XGEN(j)  (2304 + 64 * (j))
#define XB_TOP      3328
#define XB_TOPGEN   3392
#define XCD_BAR_WORDS 3456
#define XB_SPIN_CAP (1u << 20)
#define LAS __attribute__((address_space(3)))
DI unsigned xb_ld(unsigned* p) { return __hip_atomic_load(p, __ATOMIC_RELAXED, __HIP_MEMORY_SCOPE_AGENT); }
DI unsigned xb_add(unsigned* p, unsigned v) { return __hip_atomic_fetch_add(p, v, __ATOMIC_RELAXED, __HIP_MEMORY_SCOPE_AGENT); }
DI unsigned xb_xcc_id() { return (unsigned)__builtin_amdgcn_s_getreg((3 << 11) | 20) & 0xFu; }
#define XB_SPIN(cond, bar) do { unsigned _sp = 0; while (cond) { __builtin_amdgcn_s_sleep(1); \
    if ((++_sp & 255u) == 0u) { if (xb_ld(&(bar)[XB_TMO])) break; if (_sp > XB_SPIN_CAP) { atomicAdd(&(bar)[XB_TMO], 1u); break; } } } } while (0)
struct XcdBarrier { unsigned* bar; unsigned x; volatile LAS unsigned* st; };
DI XcdBarrier xcd_barrier_post(unsigned* bar, volatile LAS unsigned* st) {
  XcdBarrier b; b.bar = bar; b.x = xb_xcc_id(); b.st = st;
  if (threadIdx.x == 0) (void)xb_add(&bar[XB_XCNT(b.x)], 1u);
  return b;
}
DI void xcd_barrier_complete(unsigned* bar, unsigned x, unsigned& nloc, unsigned& nx) {
  const unsigned G = gridDim.x;
  unsigned sum, cnt, mine, sp = 0u;
  for (;;) {
    sum = 0u; cnt = 0u; mine = 0u;
#pragma unroll
    for (unsigned j = 0; j < 16; ++j) { const unsigned c = xb_ld(&bar[XB_XCNT(j)]); sum += c; cnt += (c > 0u) ? 1u : 0u; mine = (j == x) ? c : mine; }
    if (sum == G) break;
    __builtin_amdgcn_s_sleep(1);
    if ((++sp & 255u) == 0u) { if (xb_ld(&bar[XB_TMO])) break; if (sp > XB_SPIN_CAP) { atomicAdd(&bar[XB_TMO], 1u); break; } }
  }
  nloc = mine > 0u ? mine : 1u; nx = cnt > 0u ? cnt : 1u;
}
DI void xcd_barrier(const XcdBarrier& b) {
  asm volatile("s_waitcnt vmcnt(0)" ::: "memory");
  __syncthreads();
  if (threadIdx.x == 0) {
    unsigned* bar = b.bar;
    asm volatile("" : "+s"(bar));
    __builtin_amdgcn_s_waitcnt(0);
    unsigned nloc = b.st[0], nx = b.st[1];
    if (nloc == 0u) { xcd_barrier_complete(bar, b.x, nloc, nx); b.st[0] = nloc; b.st[1] = nx; }
    const unsigned old = xb_add(&bar[XB_XSUB(b.x)], 1u);
    const unsigned gen = old / nloc;
    if (old + 1u == (gen + 1u) * nloc) {
      __builtin_amdgcn_fence(__ATOMIC_RELEASE, "agent");
      asm volatile("s_waitcnt vmcnt(0)" ::: "memory");
      const unsigned og = xb_add(&bar[XB_TOP], 1u);
      const unsigned tg = og / nx;
      if (og + 1u == (tg + 1u) * nx) xb_add(&bar[XB_TOPGEN], 1u);
      else XB_SPIN(xb_ld(&bar[XB_TOPGEN]) == tg, bar);
      __builtin_amdgcn_fence(__ATOMIC_ACQUIRE, "agent");
      xb_add(&bar[XB_XGEN(b.x)], 1u);
      asm volatile("s_waitcnt vmcnt(0)" ::: "memory");
    } else {
      XB_SPIN(xb_ld(&bar[XB_XGEN(b.x)]) == gen, bar);
      __builtin_amdgcn_fence(__ATOMIC_ACQUIRE, "agent");
      asm volatile("s_waitcnt vmcnt(0)" ::: "memory");
    }
  }
  __syncthreads();
}

__global__ void __launch_bounds__(512) mega_kernel(Params P) {
  extern __shared__ __attribute__((aligned(16))) char smem[];
  volatile LAS unsigned* xst = (volatile LAS unsigned*)(smem + LDS_BYTES);
  if (threadIdx.x == 0) { xst[0] = 0u; xst[1] = 0u; }
  __syncthreads();
  const XcdBarrier xb = xcd_barrier_post((unsigned*)(P.ws + WS_BAR), xst);
  for (int ph = P.ph_lo; ph < P.ph_hi; ++ph) {
    if (ph == 0) phase_prep(P, smem);
    else {
      const int layer = (ph - 1) / NPH_LAYER, k = (ph - 1) % NPH_LAYER;
#ifndef PROBE_REP
#define PROBE_REP -1
#endif
      const int nrep = (k == PROBE_REP) ? 2 : 1;
      for (int rep = 0; rep < nrep; ++rep) {
      switch (k) {
        case 0: { int lo = layer; asm volatile("" : "+s"(lo)); phase_norm(P, lo, smem); } break;
        case 1: { int lo = layer; asm volatile("" : "+s"(lo)); phase_gemm_h(P, lo, smem); } break;
        case 2: { int lo = layer; asm volatile("" : "+s"(lo)); phase_shortconv(P, lo, smem); } break;
        case 3: { int lo = layer; asm volatile("" : "+s"(lo)); phase_toeplitz<0>(P, lo, smem); } break;
        case 4: { int lo = layer; asm volatile("" : "+s"(lo)); phase_toeplitz<1>(P, lo, smem); } break;
        case 5: { int lo = layer; asm volatile("" : "+s"(lo)); phase_gemm_aq(P, lo, smem); } break;
        case 6: { int lo = layer; asm volatile("" : "+s"(lo)); phase_attn(P, lo, smem); } break;
        case 7: { int lo = layer; asm volatile("" : "+s"(lo)); phase_merge(P, lo, smem); } break;
        default: { int lo = layer; asm volatile("" : "+s"(lo)); phase_out(P, lo, smem); } break;
      }
      if (rep + 1 < nrep) cg::this_grid().sync();
      }
    }
    if (ph + 1 < P.ph_hi) {
      if (ph == P.ph_lo) cg::this_grid().sync();
      else xcd_barrier(xb);
    }
  }
}

extern "C" void kernel_launch(void* const* d_in, const int* in_sizes, int n_in, void* d_out, int out_size, void* d_ws, size_t ws_size,
                              hipStream_t stream) {
  static int grid = 0;
  if (grid == 0) {
    int dev = 0, cus = 0, per_cu = 0;
    hipGetDevice(&dev);
    hipDeviceGetAttribute(&cus, hipDeviceAttributeMultiprocessorCount, dev);
    if (hipFuncSetAttribute((const void*)mega_kernel, hipFuncAttributeMaxDynamicSharedMemorySize, LDS_BYTES + 16) != hipSuccess) {
      fprintf(stderr, "hipFuncSetAttribute failed\n");
      grid = -1;
      return;
    }
    hipOccupancyMaxActiveBlocksPerMultiprocessor(&per_cu, (const void*)mega_kernel, 512, LDS_BYTES + 16);
    if (per_cu < 1) per_cu = 1;
    grid = cus * per_cu;
    if (ws_size < WS_END || n_in != 22) { fprintf(stderr, "workspace too small: %zu < %zu\n", ws_size, (size_t)WS_END); grid = -1; }
  }
  if (grid < 0) return;
  Params p{};
  const float** f = (const float**)&p;
  for (int i = 0; i < 22; ++i) f[i] = (const float*)d_in[i];
  p.out = (float*)d_out;
  p.ws = (char*)d_ws;
#if PER_PHASE_LAUNCH
  for (int ph = 0; ph < NPHASES; ++ph) {
    p.ph_lo = ph; p.ph_hi = ph + 1;
    hipLaunchKernelGGL(mega_kernel, dim3(grid), dim3(512), LDS_BYTES + 16, stream, p);
  }
#else
  p.ph_lo = 0; p.ph_hi = NPHASES;
  if (hipMemsetAsync((char*)d_ws + WS_BAR, 0, XCD_BAR_WORDS * 4, stream) != hipSuccess) { fprintf(stderr, "memset of barrier word failed\n"); return; }
  void* args[] = {&p};
  hipError_t e = hipLaunchCooperativeKernel((const void*)mega_kernel, dim3(grid), dim3(512), args, LDS_BYTES + 16, stream);
  if (e != hipSuccess) fprintf(stderr, "cooperative launch failed: %s (grid %d)\n", hipGetErrorString(e), grid);
#endif
}
```

```cpp
#include <hip/hip_runtime.h>
#include <hip/hip_cooperative_groups.h>
#include <cstdio>
namespace cg = cooperative_groups;

#ifndef PER_PHASE_LAUNCH
#define PER_PHASE_LAUNCH 0
#endif

typedef _Float16 h16;
typedef _Float16 half8 __attribute__((ext_vector_type(8)));
typedef _Float16 half4 __attribute__((ext_vector_type(4)));
typedef float f32x16 __attribute__((ext_vector_type(16)));
typedef float f32x4 __attribute__((ext_vector_type(4)));
typedef unsigned u32x4 __attribute__((ext_vector_type(4)));
#define DI __device__ __forceinline__

constexpr int D = 1024, NBATCH = 16, SEQ = 2048, CTXL = 256, DEPTH = 4, WB = 512;
constexpr int T_LAT = NBATCH * SEQ, T_CTX = NBATCH * CTXL, T_ALL = T_LAT + T_CTX;
constexpr int IN_COLS = 8448, H_OFF = 2048, C_OFF = 4096, K_OFF = 4608, Z_OFF = 4864, G_OFF = 5376;
constexpr int SKV = CTXL + SEQ;
constexpr int KLEN_L = 2 * SEQ + 256, KOFF_L = SEQ + 64;
constexpr int KLEN_C = 2 * CTXL + 256, KOFF_C = CTXL + 64;
constexpr int LDH = 1088, LDY = 576;
constexpr int NPH_LAYER = 9;
constexpr int NPHASES = 1 + DEPTH * NPH_LAYER;
constexpr int LDS_BYTES = 3 * 49152;

constexpr size_t al(size_t x) { return (x + 255) & ~size_t(255); }
constexpr size_t WS_CTXW = 0;
constexpr size_t WS_MODS = WS_CTXW + al((size_t)T_CTX * D * 4);
constexpr size_t WS_ROPE = WS_MODS + al((size_t)DEPTH * 17 * 3072 * 4);
constexpr size_t WS_WINT = WS_ROPE + al((size_t)SEQ * 32 * 8);
constexpr size_t WS_WBRT = WS_WINT + al((size_t)IN_COLS * LDH * 2);
constexpr size_t WS_WOUTT = WS_WBRT + al((size_t)3 * D * LDY * 2);
constexpr size_t WS_H2 = WS_WOUTT + al((size_t)D * LDH * 2);
constexpr size_t WS_KRL = WS_H2 + al((size_t)(SEQ + CTXL) * 64 * 4);
constexpr size_t WS_KRC = WS_KRL + al((size_t)2 * WB * KLEN_L * 2);
constexpr size_t WS_INVS = WS_KRC + al((size_t)2 * WB * KLEN_C * 2);
constexpr size_t WS_H16 = WS_INVS + al((size_t)2 * 2 * WB * 4);
constexpr size_t WS_R1 = WS_H16 + al((size_t)T_ALL * LDH * 2);
constexpr size_t WS_R2 = WS_R1 + al((size_t)T_ALL * 2048 * 2);
constexpr size_t WS_YB = WS_R2 + al((size_t)T_ALL * LDY * 2);
constexpr size_t WS_Q = WS_YB + al((size_t)T_ALL * LDY * 2);
constexpr size_t WS_K = WS_Q + al((size_t)T_ALL * WB * 2);
constexpr size_t WS_VT = WS_K + al((size_t)NBATCH * 2 * SKV * 64 * 2);
constexpr size_t WS_ZS = WS_VT + al((size_t)NBATCH * 2 * SKV * 64 * 2);
constexpr size_t WS_YC = WS_ZS + al((size_t)T_ALL * WB * 2);
constexpr size_t WS_BAR = WS_YC + al((size_t)T_ALL * LDY * 2);
constexpr size_t WS_W1 = WS_BAR + 16384;
constexpr size_t WS_END = WS_W1 + (WS_H2 - WS_WINT);
constexpr size_t OFF_WBRT = WS_WBRT - WS_WINT, OFF_WOUTT = WS_WOUTT - WS_WINT;
constexpr size_t HTC_OFF = (size_t)NBATCH * 2048 * SEQ;
constexpr size_t Z1C_OFF = (size_t)NBATCH * WB * SEQ;

struct Params {
  const float *x, *c, *ctx, *c_ctx, *norm_g, *w_mod, *b_mod, *w_in, *conv_a, *conv_h, *fw1, *fb1, *fw2, *fb2, *fw3, *fb3,
      *ffreq, *hbias, *qg, *kg, *w_branch, *w_out;
  float* out;
  char* ws;
  int ph_lo, ph_hi;
};

DI size_t wbase(int layer) { return (layer & 1) ? WS_W1 : WS_WINT; }
DI float silu_f(float x) { return x / (1.f + __expf(-x)); }
DI float sigmoid_f(float x) { return 1.f / (1.f + __expf(-x)); }
DI half4 cvt4(float a, float b, float c, float d) { half4 r; r[0] = (h16)a; r[1] = (h16)b; r[2] = (h16)c; r[3] = (h16)d; return r; }
DI void wait_vm0() { asm volatile("s_waitcnt vmcnt(0)" ::: "memory"); }
DI int otid() { int t = threadIdx.x; asm volatile("" : "+v"(t)); return t; }

template <int MB, bool SWAP>
DI void gemm_kloop(f32x16 (&acc)[MB][2], const h16* __restrict__ A, int lda, const h16* __restrict__ B, int ldb, int K, char* lds) {
  constexpr int A_BYTES = 64 * MB * 128, B_BYTES = 256 * 128, STAGE = A_BYTES + B_BYTES;
  static_assert(3 * STAGE <= LDS_BYTES, "ring does not fit");
  const int tid = otid(), w = tid >> 6, lane = tid & 63;
  const int wr = w >> 2, wc = w & 3;
  const int lrow = w * 8 + (lane >> 3), pch = lane & 7;
  const int gch = pch ^ ((lrow >> 1) & 7);
  const unsigned voa = (unsigned)(lrow * lda + gch * 8) * 2u, vob = (unsigned)(lrow * ldb + gch * 8) * 2u;
  const int lofs = lrow * 128 + pch * 16;
  const int r32 = lane & 31, hh = lane >> 5, sw = (r32 >> 1) & 7;
  const int a_rd = (wr * 32 * MB + r32) * 128;
  const int b_rd = A_BYTES + (wc * 64 + r32) * 128;
  const int nk = K >> 6;
  constexpr int NP = MB + 4;
  auto piece = [&](int p, int kt, int buf) {
    char* s = lds + buf * STAGE;
    if (p < MB) __builtin_amdgcn_global_load_lds((const unsigned*)((const char*)(A + (size_t)p * 64 * lda + kt * 64) + voa), (unsigned*)(s + p * 8192 + lofs), 16, 0, 0);
    else __builtin_amdgcn_global_load_lds((const unsigned*)((const char*)(B + (size_t)(p - MB) * 64 * ldb + kt * 64) + vob), (unsigned*)(s + A_BYTES + (p - MB) * 8192 + lofs), 16, 0, 0);
  };
  wait_vm0();
#pragma unroll
  for (int p = 0; p < NP; ++p) piece(p, 0, 0);
#pragma unroll
  for (int p = 0; p < NP; ++p) piece(p, 1, 1);
  int cur = 0;
  for (int kt = 0; kt < nk; ++kt) {
    if (kt + 1 < nk) { if (MB == 2) asm volatile("s_waitcnt vmcnt(6)" ::: "memory"); else asm volatile("s_waitcnt vmcnt(5)" ::: "memory"); }
    else wait_vm0();
    __syncthreads();
    const char* s = lds + cur * STAGE;
    const int nbuf = cur == 0 ? 2 : cur - 1;
    const bool more = kt + 2 < nk;
    half8 af[2][MB], bf[2][2];
#pragma unroll
    for (int mb = 0; mb < MB; ++mb) af[0][mb] = *(const half8*)(s + a_rd + mb * 4096 + (((0 + hh) ^ sw) * 16));
#pragma unroll
    for (int nb = 0; nb < 2; ++nb) bf[0][nb] = *(const half8*)(s + b_rd + nb * 4096 + (((0 + hh) ^ sw) * 16));
#pragma unroll
    for (int ks = 0; ks < 4; ++ks) {
      if (ks < 3) {
#pragma unroll
        for (int mb = 0; mb < MB; ++mb) af[(ks + 1) & 1][mb] = *(const half8*)(s + a_rd + mb * 4096 + (((2 * (ks + 1) + hh) ^ sw) * 16));
#pragma unroll
        for (int nb = 0; nb < 2; ++nb) bf[(ks + 1) & 1][nb] = *(const half8*)(s + b_rd + nb * 4096 + (((2 * (ks + 1) + hh) ^ sw) * 16));
      }
      if (more) {
        if (2 * ks < NP) piece(2 * ks, kt + 2, nbuf);
        if (2 * ks + 1 < NP) piece(2 * ks + 1, kt + 2, nbuf);
      }
      __builtin_amdgcn_sched_barrier(0);
      __builtin_amdgcn_s_setprio(1);
#pragma unroll
      for (int mb = 0; mb < MB; ++mb)
#pragma unroll
        for (int nb = 0; nb < 2; ++nb)
          acc[mb][nb] = SWAP ? __builtin_amdgcn_mfma_f32_32x32x16_f16(bf[ks & 1][nb], af[ks & 1][mb], acc[mb][nb], 0, 0, 0)
                             : __builtin_amdgcn_mfma_f32_32x32x16_f16(af[ks & 1][mb], bf[ks & 1][nb], acc[mb][nb], 0, 0, 0);
      __builtin_amdgcn_s_setprio(0);
      __builtin_amdgcn_sched_barrier(0);
    }
    cur = cur == 2 ? 0 : cur + 1;
  }
  __syncthreads();
}

DI int lds_byte16(int r, int c) { const int st = (r >> 4) * 2 + (c >> 5), rr = r & 15, cc = c & 31, ob = rr * 64 + cc * 2; return st * 1024 + (ob ^ (((ob >> 9) & 1) << 5)); }
DI void stage_rc16(int b, int& R, int& C) { const int st = b / 1024, sb = b % 1024, swz = sb ^ (((sb >> 9) & 1) << 5); R = (st >> 1) * 16 + swz / 64; C = (st & 1) * 32 + (swz % 64) / 2; }
struct Unit2 { int pm, pn; };
template <bool HEADPERM, class Sched, class Epi>
DI void gemm256_stream(char* lds, const h16* __restrict__ Ab, int lda, const h16* __restrict__ Bb, int ldb, int K, const Sched& S, const Epi& E) {
  constexpr int HTB = 128 * 64 * 2;
  const int tid = otid(), wid = __builtin_amdgcn_readfirstlane(tid >> 6), lane = tid & 63, wr = wid >> 2, wc = wid & 3, fr = lane & 15, fq = lane >> 4;
  const int nt = K / 64;
  unsigned voffA[2], voffB0[2], voffB1[2];
#pragma unroll
  for (int i = 0; i < 2; ++i) {
    int R, C;
    stage_rc16(tid * 16 + i * 8192, R, C);
    voffA[i] = (unsigned)(R * lda + C) * 2u;
    if (HEADPERM) {
      const int rb = (R >> 5) * 64 + (R & 31);
      voffB0[i] = (unsigned)(rb * ldb + C) * 2u;
      voffB1[i] = (unsigned)((rb + 32) * ldb + C) * 2u;
    } else {
      voffB0[i] = (unsigned)(R * ldb + C) * 2u;
      voffB1[i] = (unsigned)((R + 128) * ldb + C) * 2u;
    }
  }
  const size_t kstep = 128;
  const size_t hstepA = (size_t)128 * lda * 2;
  const size_t tstepA = 2 * hstepA, tstepB = (size_t)256 * ldb * 2;
  const unsigned ldsw = (unsigned)wid * 1024u;
  const int aoff = lds_byte16(wr * 64 + fr, fq * 8), boff = lds_byte16(wc * 32 + fr, fq * 8);
#define G8_SA(b, h) (((b) * 2 + (h)) * HTB)
#define G8_SB(b, h) ((4 + (b) * 2 + (h)) * HTB)
#define G8_STAGE(bufoff, gbase, voff) do { _Pragma("unroll") for (int _i = 0; _i < 2; ++_i) \
    __builtin_amdgcn_global_load_lds((const unsigned*)((const char*)(gbase) + (voff)[_i]), (unsigned*)(lds + (bufoff) + ldsw + _i * 8192 + lane * 16), 16, 0, 0); } while (0)
#define G8_LDA(dst, b, h) do { _Pragma("unroll") for (int m = 0; m < 4; ++m) _Pragma("unroll") for (int k = 0; k < 2; ++k) dst[m][k] = *(const half8*)(lds + G8_SA(b, h) + aoff + m * 2048 + k * 1024); } while (0)
#define G8_LDB(dst, b, h) do { _Pragma("unroll") for (int n = 0; n < 2; ++n) _Pragma("unroll") for (int k = 0; k < 2; ++k) dst[n][k] = *(const half8*)(lds + G8_SB(b, h) + boff + n * 2048 + k * 1024); } while (0)
#define G8_MMA(ai, bj, At, Bt) do { __builtin_amdgcn_s_setprio(1); _Pragma("unroll") for (int m = 0; m < 4; ++m) _Pragma("unroll") for (int n = 0; n < 2; ++n) _Pragma("unroll") for (int k = 0; k < 2; ++k) \
    acc[ai][bj][m][n] = __builtin_amdgcn_mfma_f32_16x16x32_f16(Bt[n][k], At[m][k], acc[ai][bj][m][n], 0, 0, 0); __builtin_amdgcn_s_setprio(0); } while (0)
#define G8_WAIT_V(n) asm volatile("s_waitcnt vmcnt(" #n ")" ::: "memory")
#define G8_WAIT_L(n) asm volatile("s_waitcnt lgkmcnt(" #n ")" ::: "memory")
#define G8_BAR __builtin_amdgcn_s_barrier()
#define G8_SCHED __builtin_amdgcn_sched_barrier(0)
  Unit2 cur, nxt;
  int ui = 0;
  if (!S.next(0, cur)) return;
  f32x4 acc[2][2][4][2];
#pragma unroll
  for (int a = 0; a < 2; ++a)
#pragma unroll
    for (int b = 0; b < 2; ++b)
#pragma unroll
      for (int m = 0; m < 4; ++m)
#pragma unroll
        for (int n = 0; n < 2; ++n) acc[a][b][m][n] = f32x4{0.f, 0.f, 0.f, 0.f};
  half8 At[4][2], B0[2][2], B1[2][2];
  const char* cA = (const char*)Ab + (size_t)cur.pm * tstepA;
  const char* cB = (const char*)Bb + (size_t)cur.pn * tstepB;
  G8_STAGE(G8_SB(0, 0), cB, voffB0); G8_STAGE(G8_SA(0, 0), cA, voffA); G8_STAGE(G8_SB(0, 1), cB, voffB1); G8_STAGE(G8_SA(0, 1), cA + hstepA, voffA);
  if (wr == 1) G8_BAR;
  G8_WAIT_V(4); G8_BAR;
  G8_STAGE(G8_SB(1, 0), cB + kstep, voffB0); G8_STAGE(G8_SA(1, 0), cA + kstep, voffA); G8_STAGE(G8_SB(1, 1), cB + kstep, voffB1);
  G8_WAIT_V(6); G8_BAR;
  for (;;) {
    const bool has_next = S.next(ui + 1, nxt);
    const char* nA = has_next ? (const char*)Ab + (size_t)nxt.pm * tstepA : cA;
    const char* nB = has_next ? (const char*)Bb + (size_t)nxt.pn * tstepB : cB;
    for (int t = 0; t < nt; t += 2) {
      const bool lastk = (t == nt - 2);
      const char* a1 = cA + (size_t)(t + 1) * kstep;
      const char* a2 = lastk ? nA : cA + (size_t)(t + 2) * kstep;
      const char* b2 = lastk ? nB : cB + (size_t)(t + 2) * kstep;
      const char* a3 = a2 + kstep;
      const char* b3 = b2 + kstep;
      G8_LDB(B0, 0, 0); G8_SCHED; G8_LDA(At, 0, 0); G8_STAGE(G8_SA(1, 1), a1 + hstepA, voffA);
      G8_WAIT_L(8); G8_BAR; G8_WAIT_L(0); G8_MMA(0, 0, At, B0); G8_BAR; G8_SCHED;
      G8_LDB(B1, 0, 1); G8_STAGE(G8_SB(0, 0), b2, voffB0);
      G8_BAR; G8_WAIT_L(0); G8_MMA(0, 1, At, B1); G8_BAR;
      G8_LDA(At, 0, 1); G8_STAGE(G8_SA(0, 0), a2, voffA);
      G8_BAR; G8_WAIT_L(0); G8_MMA(1, 0, At, B0); G8_BAR; G8_SCHED;
      G8_STAGE(G8_SB(0, 1), b2, voffB1);
      G8_WAIT_V(6); G8_BAR; G8_MMA(1, 1, At, B1); G8_BAR;
      G8_LDB(B0, 1, 0); G8_SCHED; G8_LDA(At, 1, 0); G8_STAGE(G8_SA(0, 1), a2 + hstepA, voffA);
      G8_WAIT_L(8); G8_BAR; G8_WAIT_L(0); G8_MMA(0, 0, At, B0); G8_BAR; G8_SCHED;
      G8_LDB(B1, 1, 1); G8_STAGE(G8_SB(1, 0), b3, voffB0);
      G8_BAR; G8_WAIT_L(0); G8_MMA(0, 1, At, B1); G8_BAR;
      G8_LDA(At, 1, 1); G8_STAGE(G8_SA(1, 0), a3, voffA);
      G8_BAR; G8_WAIT_L(0); G8_MMA(1, 0, At, B0); G8_BAR; G8_SCHED;
      G8_STAGE(G8_SB(1, 1), b3, voffB1);
      G8_WAIT_V(6); G8_BAR; G8_MMA(1, 1, At, B1); G8_BAR;
    }
    E(acc, cur, wr, wc, fr, fq);
    if (!has_next) break;
#pragma unroll
    for (int a = 0; a < 2; ++a)
#pragma unroll
      for (int b = 0; b < 2; ++b)
#pragma unroll
        for (int m = 0; m < 4; ++m)
#pragma unroll
          for (int n = 0; n < 2; ++n) acc[a][b][m][n] = f32x4{0.f, 0.f, 0.f, 0.f};
    cur = nxt; cA = nA; cB = nB; ++ui;
  }
  G8_WAIT_V(0);
  if (wr == 0) G8_BAR;
  G8_BAR;
#undef G8_SA
#undef G8_SB
#undef G8_STAGE
#undef G8_LDA
#undef G8_LDB
#undef G8_MMA
#undef G8_WAIT_V
#undef G8_WAIT_L
#undef G8_BAR
#undef G8_SCHED
}
struct XcdSched {
  int total, per, nxb, xcd, j;
  DI void init(int total_) { total = total_; const int G = gridDim.x; if (G & 7) { per = total; nxb = G; xcd = 0; j = blockIdx.x; } else { per = (total + 7) >> 3; nxb = G >> 3; xcd = blockIdx.x & 7; j = blockIdx.x >> 3; } }
  DI int item(int i) const { const int li = j + i * nxb; if (li >= per) return -1; const int lin = xcd * per + li; return lin < total ? lin : -1; }
};

template <class F>
DI void for_items_xcd(int total, F f) {
  const int G = gridDim.x;
  if (G & 7) { for (int it = blockIdx.x; it < total; it += G) f(it); return; }
  const int nxb = G >> 3, xcd = blockIdx.x & 7, j = blockIdx.x >> 3, per = (total + 7) >> 3;
  for (int i = j; i < per; i += nxb) { const int lin = xcd * per + i; if (lin < total) f(lin); }
}

template <int MB>
DI void zero_acc(f32x16 (&acc)[MB][2]) {
#pragma unroll
  for (int mb = 0; mb < MB; ++mb)
#pragma unroll
    for (int nb = 0; nb < 2; ++nb)
#pragma unroll
      for (int v = 0; v < 16; ++v) acc[mb][nb][v] = 0.f;
}

DI void phase_prep(const Params& P, char* smem) {
  const int tid = otid();
  float* mods = (float*)(P.ws + WS_MODS);
  float2* rope = (float2*)(P.ws + WS_ROPE);
  for (int task = blockIdx.x; task < 208; task += gridDim.x) {
    if (task < 192) {
      const int layer = task / 48, n0 = (task % 48) * 64;
      float* s = (float*)smem;
      float* red = s + 17 * 1024;
      for (int i = tid; i < 17 * 1024; i += 512) {
        const int r = i >> 10, k = i & 1023;
        const float v = (r < 16) ? P.c[r * 1024 + k] : P.c_ctx[k];
        s[i] = silu_f(v);
      }
      __syncthreads();
      const int nl = tid & 63, ks = tid >> 6;
      float acc[17];
#pragma unroll
      for (int r = 0; r < 17; ++r) acc[r] = 0.f;
      const float* wp = P.w_mod + ((size_t)layer * 1024 + ks * 128) * 3072 + n0 + nl;
      for (int k = 0; k < 128; ++k) {
        const float wv = wp[(size_t)k * 3072];
#pragma unroll
        for (int r = 0; r < 17; ++r) acc[r] += s[r * 1024 + ks * 128 + k] * wv;
      }
#pragma unroll
      for (int r = 0; r < 17; ++r) red[(ks * 17 + r) * 64 + nl] = acc[r];
      __syncthreads();
      for (int o = tid; o < 17 * 64; o += 512) {
        const int r = o >> 6, n = o & 63;
        float v = P.b_mod[layer * 3072 + n0 + n];
#pragma unroll
        for (int k2 = 0; k2 < 8; ++k2) v += red[(k2 * 17 + r) * 64 + n];
        mods[(layer * 17 + r) * 3072 + n0 + n] = v;
      }
      __syncthreads();
    } else {
      const int base = ((task - 192) * 512 + tid) * 8;
#pragma unroll 1
      for (int e = 0; e < 8; ++e) {
        const int ent = base + e;
        const int t = ent >> 5, a = (ent >> 4) & 1, f = ent & 15;
        const float pos = (float)(a ? (t & 63) : (t >> 6));
        const float inv = powf(10000.f, -(float)f / 16.f);
        float sn, cs;
        sincosf(pos * inv, &sn, &cs);
        rope[ent] = make_float2(cs, sn);
      }
    }
  }
}

DI void cvt_tile(const float* __restrict__ src, int ldn, h16* __restrict__ dst, int ldk, int k0, int n0, float* t) {
  const int tid = otid();
  {
    const int r = tid >> 4, c4 = tid & 15;
#pragma unroll
    for (int i = 0; i < 2; ++i) {
      const int k = r + 32 * i;
      const float4 v = *(const float4*)(src + (size_t)(k0 + k) * ldn + n0 + c4 * 4);
      t[k * 65 + c4 * 4 + 0] = v.x; t[k * 65 + c4 * 4 + 1] = v.y; t[k * 65 + c4 * 4 + 2] = v.z; t[k * 65 + c4 * 4 + 3] = v.w;
    }
  }
  __syncthreads();
  {
    const int n = tid >> 3, kc = tid & 7;
    half8 o;
#pragma unroll
    for (int j = 0; j < 8; ++j) o[j] = (h16)t[(kc * 8 + j) * 65 + n];
    *(half8*)(dst + (size_t)(n0 + n) * ldk + k0 + kc * 8) = o;
  }
  __syncthreads();
}

DI void cvt_layer_weights(const Params& P, int layer, int t0, int step, char* smem) {
  h16* winT = (h16*)(P.ws + wbase(layer));
  h16* wbrT = (h16*)(P.ws + wbase(layer) + OFF_WBRT);
  h16* woutT = (h16*)(P.ws + wbase(layer) + OFF_WOUTT);
  for (int t = t0; t < 2112 + 384 + 256; t += step) {
    if (t < 2112) {
      cvt_tile(P.w_in + (size_t)layer * D * IN_COLS, IN_COLS, winT, LDH, (t & 15) * 64, (t >> 4) * 64, (float*)smem);
    } else if (t < 2112 + 384) {
      const int u = t - 2112, br = u >> 7, v = u & 127;
      cvt_tile(P.w_branch + ((size_t)layer * 3 + br) * WB * D, D, wbrT + (size_t)br * D * LDY, LDY, (v & 7) * 64, (v >> 3) * 64, (float*)smem);
    } else {
      const int u = t - 2112 - 384;
      cvt_tile(P.w_out + (size_t)layer * D * D, D, woutT, LDH, (u & 15) * 64, (u >> 4) * 64, (float*)smem);
    }
  }
}

DI void phase_norm(const Params& P, int layer, char* smem) {
  const int tid = otid(), w = tid >> 6, lane = tid & 63;
  if (layer == 0) cvt_layer_weights(P, 0, blockIdx.x, gridDim.x, smem);
  const int gw = blockIdx.x * 8 + w, nw = gridDim.x * 8;
  const float* mods = (const float*)(P.ws + WS_MODS) + (size_t)layer * 17 * 3072;
  const float* ng = P.norm_g + layer * D;
  h16* hb = (h16*)(P.ws + WS_H16);
  for (int row = gw; row < T_ALL; row += nw) {
    const float* src;
    int b;
    if (row < T_LAT) { src = (layer == 0 ? P.x : P.out) + (size_t)row * D; b = row >> 11; }
    else { const int rc = row - T_LAT; src = (layer == 0 ? P.ctx : (const float*)(P.ws + WS_CTXW)) + (size_t)rc * D; b = 16; }
    const float* md = mods + b * 3072;
    float4 xv[4];
    float ss = 0.f;
#pragma unroll
    for (int j = 0; j < 4; ++j) {
      xv[j] = *(const float4*)(src + j * 256 + lane * 4);
      ss += xv[j].x * xv[j].x + xv[j].y * xv[j].y + xv[j].z * xv[j].z + xv[j].w * xv[j].w;
    }
#pragma unroll
    for (int m = 32; m >= 1; m >>= 1) ss += __shfl_xor(ss, m);
    const float rstd = rsqrtf(ss * (1.f / 1024.f) + 1e-6f);
#pragma unroll
    for (int j = 0; j < 4; ++j) {
      const int k = j * 256 + lane * 4;
      const float4 g = *(const float4*)(ng + k);
      const float4 sh = *(const float4*)(md + k);
      const float4 sc = *(const float4*)(md + 1024 + k);
      *(half4*)(hb + (size_t)row * LDH + k) = cvt4(xv[j].x * rstd * g.x * (1.f + sc.x) + sh.x, xv[j].y * rstd * g.y * (1.f + sc.y) + sh.y,
                                                  xv[j].z * rstd * g.z * (1.f + sc.z) + sh.z, xv[j].w * rstd * g.w * (1.f + sc.w) + sh.w);
    }
  }
  float* h2 = (float*)(P.ws + WS_H2);
  const float* w1 = P.fw1 + layer * 33 * 64;
  const float* w2 = P.fw2 + layer * 64 * 64;
  const float f0 = P.ffreq[layer * 128 + lane], f1 = P.ffreq[layer * 128 + 64 + lane];
  const float b1 = P.fb1[layer * 64 + lane], b2 = P.fb2[layer * 64 + lane];
  for (int p = gw; p < SEQ + CTXL; p += nw) {
    const int L = p >= SEQ ? CTXL : SEQ, tau = p >= SEQ ? p - SEQ : p;
    const float tt = (float)tau / (float)(L - 1);
    const float wv = (6.283185307179586f / (float)L) * (float)tau;
    float feat = 0.f;
    if (lane == 0) feat = tt;
    else if (lane <= 16) feat = cosf(wv * (1e-4f + (float)(lane - 1) * ((15.f - 1e-4f) / 15.f)));
    else if (lane <= 32) feat = sinf(wv * (1e-4f + (float)(lane - 17) * ((15.f - 1e-4f) / 15.f)));
    float a1 = b1;
    for (int e = 0; e < 33; ++e) a1 += __shfl(feat, e) * w1[e * 64 + lane];
    const float h1 = sinf(f0 * a1);
    float a2 = b2;
    for (int k = 0; k < 64; ++k) a2 += __shfl(h1, k) * w2[k * 64 + lane];
    h2[(size_t)p * 64 + lane] = sinf(f1 * a2);
  }
}

DI void filt2_task(const Params& P, int layer, int set, int o, int cg16, char* smem) {
  const int tid = otid();
  const int L = set ? CTXL : SEQ, KLEN = set ? KLEN_C : KLEN_L, OFF = set ? KOFF_C : KOFF_L;
  h16* krb = (h16*)(P.ws + (set ? WS_KRC : WS_KRL));
  const float* h2 = (const float*)(P.ws + WS_H2) + (set ? (size_t)SEQ * 64 : 0);
  float* invS = (float*)(P.ws + WS_INVS);
  const int c0 = cg16 * 16;
  float* w3s = (float*)smem;
  float* part = w3s + 2048;
  for (int i = tid; i < 2048; i += 512) {
    const int k = i >> 5, d = (i >> 4) & 1, cc = i & 15;
    w3s[i] = P.fw3[((size_t)layer * 64 + k) * 2048 + (o * 2 + d) * 512 + c0 + cc];
  }
  __syncthreads();
  const int cc = tid & 15, sl = tid >> 4, c = c0 + cc;
  const float b30 = P.fb3[layer * 2048 + (o * 2 + 0) * 512 + c], b31 = P.fb3[layer * 2048 + (o * 2 + 1) * 512 + c];
  const float MIN_DECAY = -3.0701134573253940f, MAX_DECAY = -15.350567286626974f;
  const float delta = fabsf(MIN_DECAY + (float)c * ((MAX_DECAY - MIN_DECAY) / 511.f));
  h16* kr = krb + (size_t)(o * 512 + c) * KLEN;
  const int nper = L >> 5;
  float sum = 0.f;
  for (int tau = sl * nper; tau < (sl + 1) * nper; ++tau) {
    const float4* hr = (const float4*)(h2 + (size_t)tau * 64);
    float v0 = b30, v1 = b31;
#pragma unroll
    for (int kc = 0; kc < 16; ++kc) {
      const float4 hv = hr[kc];
      v0 += hv.x * w3s[(kc * 4 + 0) * 32 + cc] + hv.y * w3s[(kc * 4 + 1) * 32 + cc] + hv.z * w3s[(kc * 4 + 2) * 32 + cc] + hv.w * w3s[(kc * 4 + 3) * 32 + cc];
      v1 += hv.x * w3s[(kc * 4 + 0) * 32 + 16 + cc] + hv.y * w3s[(kc * 4 + 1) * 32 + 16 + cc] + hv.z * w3s[(kc * 4 + 2) * 32 + 16 + cc] + hv.w * w3s[(kc * 4 + 3) * 32 + 16 + cc];
    }
    const float tt = (float)tau / (float)(L - 1);
    const float dec = expf(-tt * delta);
    v0 *= dec; v1 *= dec;
    kr[OFF - tau] = (h16)v0;
    sum += fabsf(v0);
    if (tau >= 1) { kr[OFF + tau] = (h16)v1; sum += fabsf(v1); }
  }
  for (int z = sl; z < 257; z += 32) {
    const int idx = z < 65 ? z : (OFF + L + (z - 65));
    kr[idx] = (h16)0.f;
  }
  part[sl * 16 + cc] = sum;
  __syncthreads();
  if (tid < 16) {
    float tot = 0.f;
    for (int s2 = 0; s2 < 32; ++s2) tot += part[s2 * 16 + tid];
    invS[(set * 2 + o) * 512 + c0 + tid] = 1.f / tot;
  }
  __syncthreads();
}

struct SchedH {
  XcdSched xs;
  DI bool next(int i, Unit2& u) const { const int it = xs.item(i); if (it < 0) return false; u.pm = (it & 31) >> 2; u.pn = (it >> 5) * 4 + (it & 3); return true; }
};
struct EpiH {
  h16* hT;
  DI void operator()(const f32x4 (&acc)[2][2][4][2], const Unit2& u, int wr_, int wc_, int fr_, int fq_) const {
    const int tid2 = otid(), wid2 = tid2 >> 6, wr = wid2 >> 2, wc = wid2 & 3, fr = tid2 & 15, fq = (tid2 >> 4) & 3;
    const bool gate = u.pm >= 6;
    const int tok0 = u.pn * 256;
    const bool isctx = tok0 >= T_LAT;
#pragma unroll
    for (int ai = 0; ai < 2; ++ai)
#pragma unroll
      for (int m = 0; m < 4; ++m) {
        const int col = u.pm * 256 + ai * 128 + wr * 64 + m * 16 + fr;
#pragma unroll
        for (int bj = 0; bj < 2; ++bj)
#pragma unroll
          for (int n = 0; n < 2; ++n) {
            const int grow = tok0 + bj * 128 + wc * 32 + n * 16 + 4 * fq;
            float v0 = acc[ai][bj][m][n][0], v1 = acc[ai][bj][m][n][1], v2 = acc[ai][bj][m][n][2], v3 = acc[ai][bj][m][n][3];
            if (gate) { v0 = silu_f(v0); v1 = silu_f(v1); v2 = silu_f(v2); v3 = silu_f(v3); }
            h16* dst;
            if (!isctx) { const int b = grow >> 11, tt = grow & 2047; dst = hT + ((size_t)(b * 2048 + col) * SEQ + tt); }
            else { const int rc = grow - T_LAT, b = rc >> 8, tt = rc & 255; dst = hT + HTC_OFF + ((size_t)(b * 2048 + col) * CTXL + tt); }
            *(half4*)dst = cvt4(v0, v1, v2, v3);
          }
      }
  }
};
DI void phase_gemm_h(const Params& P, int layer, char* smem) {
  const bool last = layer == DEPTH - 1;
  const int n_mt = last ? 128 : 144;
  {
    const int nfilt = last ? 64 : 128;
    const int G = gridDim.x, first = G - (G >> 1);
    for (int item = (int)blockIdx.x - first; item >= 0 && item < nfilt; item += (G >> 1)) {
      const int id = nfilt - 1 - item;
      filt2_task(P, layer, id >> 6, (id & 63) >> 5, id & 31, smem);
    }
  }
  SchedH S; S.xs.init(n_mt * 8);
  EpiH E; E.hT = (h16*)(P.ws + WS_R1);
  gemm256_stream<false>(smem, (const h16*)(P.ws + wbase(layer)) + (size_t)H_OFF * LDH, LDH, (const h16*)(P.ws + WS_H16), LDH, D, S, E);
}

DI void phase_shortconv(const Params& P, int layer, char* smem) {
  const bool last = layer == DEPTH - 1;
  const int tid = otid(), lane = tid & 63, w = tid >> 6;
  const int gw = blockIdx.x * 8 + w, nw = gridDim.x * 8;
  h16* hT = (h16*)(P.ws + WS_R1);
  const float* cw = P.conv_h + (size_t)layer * 3 * 1536;
  const int nrows_l = NBATCH * 1536;
  const int nrows = last ? nrows_l : 2 * nrows_l;
  for (int r = gw; r < nrows; r += nw) {
    if (r < nrows_l) {
      const int b = r / 1536, col = r % 1536;
      const float w0 = cw[col], w1 = cw[1536 + col], w2 = cw[3072 + col];
      h16* p = hT + (size_t)(b * 2048 + col) * SEQ;
      half8 v[4];
#pragma unroll
      for (int j = 0; j < 4; ++j) v[j] = *(const half8*)(p + j * 512 + lane * 8);
      float prev[4], next[4];
#pragma unroll
      for (int j = 0; j < 4; ++j) {
        const float lastv = (float)v[j][7], firstv = (float)v[j][0];
        float pu = __shfl_up(lastv, 1);
        float nd = __shfl_down(firstv, 1);
        prev[j] = pu; next[j] = nd;
      }
#pragma unroll
      for (int j = 0; j < 4; ++j) {
        const float l63 = (j > 0) ? __shfl((float)v[j > 0 ? j - 1 : 0][7], 63) : 0.f;
        const float f0 = (j < 3) ? __shfl((float)v[j < 3 ? j + 1 : 3][0], 0) : 0.f;
        if (lane == 0) prev[j] = l63;
        if (lane == 63) next[j] = f0;
      }
#pragma unroll
      for (int j = 0; j < 4; ++j) {
        half8 o;
#pragma unroll
        for (int e = 0; e < 8; ++e) {
          const float a = e == 0 ? prev[j] : (float)v[j][e > 0 ? e - 1 : 0];
          const float cc = (float)v[j][e];
          const float d = e == 7 ? next[j] : (float)v[j][e < 7 ? e + 1 : 7];
          o[e] = (h16)(w0 * a + w1 * cc + w2 * d);
        }
        *(half8*)(p + j * 512 + lane * 8) = o;
      }
    } else {
      const int r2 = r - nrows_l;
      const int b = r2 / 1536, col = r2 % 1536;
      const float w0 = cw[col], w1 = cw[1536 + col], w2 = cw[3072 + col];
      h16* p = hT + HTC_OFF + (size_t)(b * 2048 + col) * CTXL;
      const half4 v = *(const half4*)(p + lane * 4);
      float prev = __shfl_up((float)v[3], 1), next = __shfl_down((float)v[0], 1);
      if (lane == 0) prev = 0.f;
      if (lane == 63) next = 0.f;
      half4 o;
      o[0] = (h16)(w0 * prev + w1 * (float)v[0] + w2 * (float)v[1]);
      o[1] = (h16)(w0 * (float)v[0] + w1 * (float)v[1] + w2 * (float)v[2]);
      o[2] = (h16)(w0 * (float)v[1] + w1 * (float)v[2] + w2 * (float)v[3]);
      o[3] = (h16)(w0 * (float)v[2] + w1 * (float)v[3] + w2 * next);
      *(half4*)(p + lane * 4) = o;
    }
  }
}

template <int MODE, int TB>
DI void toeplitz_task(const Params& P, int layer, int set, int cg, int chunk, char* smem) {
  const int tid = otid(), w = tid >> 6, lane = tid & 63;
  const int L = set ? CTXL : SEQ, KLEN = set ? KLEN_C : KLEN_L, OFF = set ? KOFF_C : KOFF_L;
  const h16* krg = (const h16*)(P.ws + (set ? WS_KRC : WS_KRL)) + (size_t)(MODE * 512 + cg * 8) * KLEN;
  h16* krs = (h16*)smem;
  char* stg = smem + 8 * KLEN_L * 2;
  for (int i = tid; i < KLEN; i += 512) *(half8*)(krs + i * 8) = *(const half8*)(krg + i * 8);
  __syncthreads();
  const int c = cg * 8 + w;
  const int bb = lane & 15, kg = lane >> 4;
  const h16* hT = (const h16*)(P.ws + WS_R1) + (set ? HTC_OFF : 0);
  h16* z1T = (h16*)(P.ws + WS_R2) + (set ? Z1C_OFF : 0);
  const h16* Urow = (MODE == 0) ? hT + (size_t)(bb * 2048 + c) * L : z1T + (size_t)(bb * 512 + c) * L;
  const float invs = ((const float*)(P.ws + WS_INVS))[(set * 2 + MODE) * 512 + c];
  const float bias = P.hbias[(layer * 2 + MODE) * 512 + c];
  const int nsteps = (L >> 5) + 1;
  constexpr int GS = TB == 4 ? 2 : 5;
  const int ngroups = (nsteps + GS - 1) / GS;
  const int npass = (TB == 4 || set) ? 1 : 2;
  const h16* krw = krs + w * KLEN;
  for (int pass = 0; pass < npass; ++pass) {
    const int tb = chunk * 512 + pass * 256;
    f32x4 acc[TB][8];
#pragma unroll
    for (int ta = 0; ta < TB; ++ta)
#pragma unroll
      for (int r = 0; r < 8; ++r) acc[ta][r] = f32x4{0.f, 0.f, 0.f, 0.f};
    u32x4 cur[2 * GS], nxt[2 * GS];
    auto load_group = [&](int g, u32x4 (&dst)[2 * GS]) {
#pragma unroll
      for (int q = 0; q < GS; ++q) {
        const int s = -32 + (g * GS + q) * 32 + 8 * kg;
        const int s2 = s + 8;
        const int sc = min(max(s, 0), L - 8), sc2 = min(max(s2, 0), L - 8);
        dst[2 * q] = *(const u32x4*)(Urow + sc);
        dst[2 * q + 1] = *(const u32x4*)(Urow + sc2);
      }
    };
    load_group(0, cur);
    const int abase = OFF - tb - 8 * ((lane & 15) - kg);
    half8 afn[TB];
#pragma unroll
    for (int ta = 0; ta < TB; ++ta) afn[ta] = *(const half8*)(krw + abase - 32 - 128 * ta);
    for (int g = 0; g < ngroups; ++g) {
      load_group(g + 1 < ngroups ? g + 1 : g, nxt);
      __builtin_amdgcn_sched_barrier(0);
#pragma unroll
      for (int q = 0; q < GS; ++q) {
        const int s0 = -32 + (g * GS + q) * 32;
        half8 af[TB];
#pragma unroll
        for (int ta = 0; ta < TB; ++ta) { af[ta] = afn[ta]; afn[ta] = *(const half8*)(krw + abase + s0 + 32 - 128 * ta); }
        unsigned d[8];
        {
          const int sw0 = s0 + 8 * kg, sw1 = sw0 + 8;
          const bool va = (sw0 >= 0) && (sw0 < L), vb = (sw1 >= 0) && (sw1 < L);
#pragma unroll
          for (int e = 0; e < 4; ++e) { d[e] = va ? cur[2 * q][e] : 0u; d[4 + e] = vb ? cur[2 * q + 1][e] : 0u; }
        }
        __builtin_amdgcn_s_setprio(1);
#pragma unroll
        for (int r = 0; r < 8; ++r) {
          u32x4 bw;
#pragma unroll
          for (int e = 0; e < 4; ++e)
            bw[e] = (r & 1) ? __builtin_amdgcn_alignbit(d[(r >> 1) + e + 1 > 7 ? 7 : (r >> 1) + e + 1], d[(r >> 1) + e], 16) : d[(r >> 1) + e];
          const half8 bfr = __builtin_bit_cast(half8, bw);
#pragma unroll
          for (int ta = 0; ta < TB; ++ta) acc[ta][r] = __builtin_amdgcn_mfma_f32_16x16x32_f16(af[ta], bfr, acc[ta][r], 0, 0, 0);
        }
        __builtin_amdgcn_s_setprio(0);
      }
#pragma unroll
      for (int e = 0; e < 2 * GS; ++e) cur[e] = nxt[e];
    }
#pragma unroll
    for (int hf = 0; hf < TB / 2; ++hf) {
    const int tbh = tb + 256 * hf;
#pragma unroll
    for (int ta = 2 * hf; ta < 2 * hf + 2; ++ta) {
      const int t0 = tb + 128 * ta + 32 * kg;
#pragma unroll
      for (int v = 0; v < 4; ++v) {
        const int t = t0 + 8 * v;
        if (MODE == 0) {
          const half8 x1 = *(const half8*)(hT + (size_t)(bb * 2048 + 512 + c) * L + t);
          const half8 uu = *(const half8*)(Urow + t);
          half8 o;
#pragma unroll
          for (int r = 0; r < 8; ++r) o[r] = (h16)((float)x1[r] * (acc[ta][r][v] * invs + (float)uu[r] * bias));
          *(half8*)(z1T + (size_t)(bb * 512 + c) * L + t) = o;
        } else {
          const half8 x2 = *(const half8*)(hT + (size_t)(bb * 2048 + 1024 + c) * L + t);
          const half8 gt = *(const half8*)(hT + (size_t)(bb * 2048 + 1536 + c) * L + t);
          const half8 uu = *(const half8*)(Urow + t);
#pragma unroll
          for (int r = 0; r < 8; ++r) {
            const float y = (float)x2[r] * (acc[ta][r][v] * invs + (float)uu[r] * bias) * (float)gt[r];
            const int tl = t - tbh + r;
            *(h16*)(stg + ((tl * 16 + bb) * 8 + w) * 2) = (h16)y;
          }
        }
      }
    }
    if (MODE == 1) {
      __syncthreads();
      h16* yb = (h16*)(P.ws + WS_YB);
#pragma unroll
      for (int i = 0; i < 8; ++i) {
        const int item = tid + 512 * i;
        const int b = item >> 8, tl = item & 255;
        const size_t tok = set ? (size_t)T_LAT + b * CTXL + tbh + tl : (size_t)b * SEQ + tbh + tl;
        *(half8*)(yb + tok * LDY + cg * 8) = *(const half8*)(stg + (tl * 16 + b) * 16);
      }
      __syncthreads();
    }
    }
  }
  __syncthreads();
}

template <int MODE>
DI void phase_toeplitz(const Params& P, int layer, char* smem) {
  const bool last = layer == DEPTH - 1;
  const int total = last ? 256 : 320;
  for (int item = blockIdx.x; item < total; item += gridDim.x) {
    if (item < 256) {
      const int xj = item >> 3;
      toeplitz_task<MODE, 4>(P, layer, 0, (item & 7) + 8 * (xj >> 2), xj & 3, smem);
    }
    else toeplitz_task<MODE, 2>(P, layer, 1, item - 256, 0, smem);
  }
}

struct SchedAQ {
  XcdSched xs; bool last;
  DI bool next(int i, Unit2& u) const {
    const int it = xs.item(i); if (it < 0) return false;
    int mt, nt;
    if (last && it >= 128 * 13) { mt = 128 + (it - 128 * 13); nt = 10; }
    else { const int g = it / 52, rem = it % 52; nt = rem >> 2; mt = g * 4 + (rem & 3); }
    u.pm = mt; u.pn = nt < 8 ? nt : nt + 8;
    return true;
  }
};
struct EpiAQ {
  h16 *pa, *qb, *kb, *vT, *zs;
  const float *qg, *kg;
  const float2* rope;
  DI void norm_rope(f32x4 (&x)[2][2], const float* gvec, bool do_rope, int t, int fq) const {
    float ss = 0.f;
#pragma unroll
    for (int bj = 0; bj < 2; ++bj)
#pragma unroll
      for (int n = 0; n < 2; ++n)
#pragma unroll
        for (int v = 0; v < 4; ++v) ss += x[bj][n][v] * x[bj][n][v];
    ss += __shfl_xor(ss, 16);
    ss += __shfl_xor(ss, 32);
    const float rstd = rsqrtf(ss * (1.f / 64.f) + 1e-6f);
#pragma unroll
    for (int bj = 0; bj < 2; ++bj)
#pragma unroll
      for (int n = 0; n < 2; ++n) {
        const float4 g = *(const float4*)(gvec + bj * 32 + n * 16 + 4 * fq);
        x[bj][n][0] *= rstd * g.x; x[bj][n][1] *= rstd * g.y; x[bj][n][2] *= rstd * g.z; x[bj][n][3] *= rstd * g.w;
      }
    if (do_rope) {
#pragma unroll
      for (int bj = 0; bj < 2; ++bj) {
        const float4* rp = (const float4*)(rope + ((size_t)t * 2 + bj) * 16 + 4 * fq);
        const float4 ca = rp[0], cb = rp[1];
        const float cs[4] = {ca.x, ca.z, cb.x, cb.z}, sn[4] = {ca.y, ca.w, cb.y, cb.w};
#pragma unroll
        for (int v = 0; v < 4; ++v) {
          const float x1 = x[bj][0][v], x2 = x[bj][1][v];
          x[bj][0][v] = x1 * cs[v] - x2 * sn[v];
          x[bj][1][v] = x2 * cs[v] + x1 * sn[v];
        }
      }
    }
  }
  DI void operator()(const f32x4 (&acc)[2][2][4][2], const Unit2& u, int wr_, int wc_, int fr_, int fq_) const {
    const int tid2 = otid(), wid2 = tid2 >> 6, wr = wid2 >> 2, wc = wid2 & 3, fr = tid2 & 15, fq = (tid2 >> 4) & 3;
    const int row0 = u.pm * 256;
    const bool isctx = row0 >= T_LAT;
    const int pn = u.pn;
#pragma unroll
    for (int ai = 0; ai < 2; ++ai)
#pragma unroll
      for (int m = 0; m < 4; ++m) {
        const int row = row0 + ai * 128 + wr * 64 + m * 16 + fr;
        int b, t;
        if (!isctx) { b = row >> 11; t = row & 2047; } else { b = (row - T_LAT) >> 8; t = (row - T_LAT) & 255; }
        f32x4 x[2][2];
#pragma unroll
        for (int bj = 0; bj < 2; ++bj)
#pragma unroll
          for (int n = 0; n < 2; ++n) x[bj][n] = acc[ai][bj][m][n];
        if (pn < 8) {
#pragma unroll
          for (int bj = 0; bj < 2; ++bj)
#pragma unroll
            for (int n = 0; n < 2; ++n) {
              f32x4 v = x[bj][n];
              if (pn >= 6) { v[0] = silu_f(v[0]); v[1] = silu_f(v[1]); v[2] = silu_f(v[2]); v[3] = silu_f(v[3]); }
              *(half4*)(pa + (size_t)row * 2048 + pn * 256 + wc * 64 + bj * 32 + n * 16 + 4 * fq) = cvt4(v[0], v[1], v[2], v[3]);
            }
        } else if (pn < 18) {
          const int head = (pn - 16) * 4 + wc;
          norm_rope(x, qg, !isctx, t, fq);
#pragma unroll
          for (int bj = 0; bj < 2; ++bj)
#pragma unroll
            for (int n = 0; n < 2; ++n)
              *(half4*)(qb + (size_t)row * 512 + head * 64 + bj * 32 + n * 16 + 4 * fq) = cvt4(x[bj][n][0], x[bj][n][1], x[bj][n][2], x[bj][n][3]);
        } else if (pn == 18) {
          const int key = isctx ? t : CTXL + t;
          if (wc < 2) {
            norm_rope(x, kg, !isctx, t, fq);
#pragma unroll
            for (int bj = 0; bj < 2; ++bj)
#pragma unroll
              for (int n = 0; n < 2; ++n)
                *(half4*)(kb + ((size_t)(b * 2 + wc) * SKV + key) * 64 + bj * 32 + n * 16 + 4 * fq) = cvt4(x[bj][n][0], x[bj][n][1], x[bj][n][2], x[bj][n][3]);
          } else {
#pragma unroll
            for (int bj = 0; bj < 2; ++bj)
#pragma unroll
              for (int n = 0; n < 2; ++n)
#pragma unroll
                for (int v = 0; v < 4; ++v) vT[((size_t)(b * 2 + (wc - 2)) * 64 + bj * 32 + n * 16 + 4 * fq + v) * SKV + key] = (h16)x[bj][n][v];
          }
        } else {
#pragma unroll
          for (int bj = 0; bj < 2; ++bj)
#pragma unroll
            for (int n = 0; n < 2; ++n)
              *(half4*)(zs + (size_t)row * 512 + (pn - 19) * 256 + wc * 64 + bj * 32 + n * 16 + 4 * fq) =
                  cvt4(silu_f(x[bj][n][0]), silu_f(x[bj][n][1]), silu_f(x[bj][n][2]), silu_f(x[bj][n][3]));
        }
      }
  }
};
DI void phase_gemm_aq(const Params& P, int layer, char* smem) {
  const bool last = layer == DEPTH - 1;
  SchedAQ S; S.last = last; S.xs.init(128 * 13 + (last ? 16 : 16 * 13));
  EpiAQ E;
  E.pa = (h16*)(P.ws + WS_R1); E.qb = (h16*)(P.ws + WS_Q); E.kb = (h16*)(P.ws + WS_K); E.vT = (h16*)(P.ws + WS_VT); E.zs = (h16*)(P.ws + WS_ZS);
  E.qg = P.qg + layer * 64; E.kg = P.kg + layer * 64; E.rope = (const float2*)(P.ws + WS_ROPE);
  if (!last) {
    const int G = gridDim.x;
    if ((G & 7) == 0) {
      const int nxb = G >> 3, per = (128 * 13 + 16 * 13 + 7) >> 3, nlong = per - (per / nxb) * nxb;
      const int j = blockIdx.x >> 3, xcd = blockIdx.x & 7;
      if (j >= nlong) cvt_layer_weights(P, layer + 1, (j - nlong) * 8 + xcd, (nxb - nlong) * 8, smem);
    } else cvt_layer_weights(P, layer + 1, blockIdx.x, G, smem);
  }
  gemm256_stream<true>(smem, (const h16*)(P.ws + WS_H16), LDH, (const h16*)(P.ws + wbase(layer)), LDH, D, S, E);
}

DI void attn_task(const Params& P, int set, int b, int kvh, int qt, char* smem) {
  const int tid = otid(), w = tid >> 6, lane = tid & 63, r32 = lane & 31, hh = lane >> 5;
  const int head = kvh * 4 + (w & 3), qsub = w >> 2;
  const int nkeys = set ? CTXL : SKV;
  const size_t row0 = (set ? (size_t)T_LAT + b * CTXL : (size_t)b * SEQ) + qt * 128 + qsub * 64 + r32;
  const h16* qb = (const h16*)(P.ws + WS_Q);
  h16* yc = (h16*)(P.ws + WS_YC);
  const h16* zs = (const h16*)(P.ws + WS_ZS);
  const h16* kg = (const h16*)(P.ws + WS_K) + (size_t)(b * 2 + kvh) * SKV * 64;
  const h16* vg = (const h16*)(P.ws + WS_VT) + (size_t)(b * 2 + kvh) * 64 * SKV;
  half8 qf[2][4];
#pragma unroll
  for (int qi = 0; qi < 2; ++qi)
#pragma unroll
    for (int ds = 0; ds < 4; ++ds) qf[qi][ds] = *(const half8*)(qb + (row0 + 32 * qi) * 512 + head * 64 + 16 * ds + 8 * hh);
  const int srow = tid >> 3, sch = tid & 7, ssw = (srow >> 1) & 7;
  const int k_wr = srow * 128 + ((sch ^ ssw) * 16);
  const int u = sch >> 1, od = sch & 1;
  const int v_wr0 = 8192 + srow * 128 + (((2 * u) ^ ssw) * 16) + 8 * od;
  const int v_wr1 = 8192 + srow * 128 + (((2 * u + 1) ^ ssw) * 16) + 8 * od;
  const int sw = (r32 >> 1) & 7;
  const int ntile = nkeys >> 6;
  half8 kreg = *(const half8*)(kg + (size_t)srow * 64 + sch * 8);
  half8 vreg = *(const half8*)(vg + (size_t)srow * SKV + sch * 8);
  {
    char* s = smem;
    *(half8*)(s + k_wr) = kreg;
    half4 lo, hi;
    lo[0] = vreg[0]; lo[1] = vreg[1]; lo[2] = vreg[2]; lo[3] = vreg[3];
    hi[0] = vreg[4]; hi[1] = vreg[5]; hi[2] = vreg[6]; hi[3] = vreg[7];
    *(half4*)(s + v_wr0) = lo;
    *(half4*)(s + v_wr1) = hi;
  }
  __syncthreads();
  f32x16 o[2][2];
#pragma unroll
  for (int qi = 0; qi < 2; ++qi)
#pragma unroll
    for (int v = 0; v < 16; ++v) { o[qi][0][v] = 0.f; o[qi][1][v] = 0.f; }
  float m_run[2] = {-1e30f, -1e30f}, l_run[2] = {0.f, 0.f};
  const float cscale = 0.125f * 1.4426950408889634f;
  asm volatile("" : "+v"(qf[0][0]), "+v"(qf[0][1]), "+v"(qf[0][2]), "+v"(qf[0][3]), "+v"(qf[1][0]), "+v"(qf[1][1]), "+v"(qf[1][2]), "+v"(qf[1][3]));
#pragma unroll 1
  for (int kt = 0; kt < ntile; ++kt) {
    if (kt + 1 < ntile) {
      kreg = *(const half8*)(kg + (size_t)((kt + 1) * 64 + srow) * 64 + sch * 8);
      vreg = *(const half8*)(vg + (size_t)srow * SKV + (kt + 1) * 64 + sch * 8);
    }
    const char* s = smem + (kt & 1) * 16384;
    f32x16 sc[2][2];
#pragma unroll
    for (int qi = 0; qi < 2; ++qi)
#pragma unroll
      for (int v = 0; v < 16; ++v) { sc[qi][0][v] = 0.f; sc[qi][1][v] = 0.f; }
#pragma unroll
    for (int ds = 0; ds < 4; ++ds) {
      const int co = ((2 * ds + hh) ^ sw) * 16;
      const half8 k0 = *(const half8*)(s + r32 * 128 + co);
      const half8 k1 = *(const half8*)(s + (32 + r32) * 128 + co);
#pragma unroll
      for (int qi = 0; qi < 2; ++qi) {
        sc[qi][0] = __builtin_amdgcn_mfma_f32_32x32x16_f16(k0, qf[qi][ds], sc[qi][0], 0, 0, 0);
        sc[qi][1] = __builtin_amdgcn_mfma_f32_32x32x16_f16(k1, qf[qi][ds], sc[qi][1], 0, 0, 0);
      }
    }
#pragma unroll
    for (int qi = 0; qi < 2; ++qi) {
      float mx = sc[qi][0][0];
#pragma unroll
      for (int v = 0; v < 16; ++v) { mx = fmaxf(mx, sc[qi][0][v]); mx = fmaxf(mx, sc[qi][1][v]); }
      mx = fmaxf(mx, __shfl_xor(mx, 32));
      const float m_new = fmaxf(m_run[qi], mx * cscale);
      const float alpha = __builtin_amdgcn_exp2f(m_run[qi] - m_new);
      m_run[qi] = m_new;
      float ps = 0.f;
#pragma unroll
      for (int v = 0; v < 16; ++v) {
        sc[qi][0][v] = __builtin_amdgcn_exp2f(sc[qi][0][v] * cscale - m_new); ps += sc[qi][0][v];
        sc[qi][1][v] = __builtin_amdgcn_exp2f(sc[qi][1][v] * cscale - m_new); ps += sc[qi][1][v];
      }
      l_run[qi] = l_run[qi] * alpha + ps;
#pragma unroll
      for (int v = 0; v < 16; ++v) { o[qi][0][v] *= alpha; o[qi][1][v] *= alpha; }
    }
#pragma unroll
    for (int uu = 0; uu < 4; ++uu) {
      const int co = ((2 * uu + hh) ^ sw) * 16;
      const half8 v0 = *(const half8*)(s + 8192 + r32 * 128 + co);
      const half8 v1 = *(const half8*)(s + 8192 + (32 + r32) * 128 + co);
#pragma unroll
      for (int qi = 0; qi < 2; ++qi) {
        half8 pf;
#pragma unroll
        for (int j = 0; j < 8; ++j) pf[j] = (h16)((uu < 2) ? sc[qi][0][8 * (uu & 1) + j] : sc[qi][1][8 * (uu & 1) + j]);
        o[qi][0] = __builtin_amdgcn_mfma_f32_32x32x16_f16(v0, pf, o[qi][0], 0, 0, 0);
        o[qi][1] = __builtin_amdgcn_mfma_f32_32x32x16_f16(v1, pf, o[qi][1], 0, 0, 0);
      }
    }
    if (kt + 1 < ntile) {
      char* s2 = smem + ((kt + 1) & 1) * 16384;
      *(half8*)(s2 + k_wr) = kreg;
      half4 lo, hi;
      lo[0] = vreg[0]; lo[1] = vreg[1]; lo[2] = vreg[2]; lo[3] = vreg[3];
      hi[0] = vreg[4]; hi[1] = vreg[5]; hi[2] = vreg[6]; hi[3] = vreg[7];
      *(half4*)(s2 + v_wr0) = lo;
      *(half4*)(s2 + v_wr1) = hi;
    }
    __syncthreads();
  }
#pragma unroll
  for (int qi = 0; qi < 2; ++qi) {
    const float ltot = l_run[qi] + __shfl_xor(l_run[qi], 32);
    const float inv = 1.f / ltot;
    const size_t row = row0 + 32 * qi;
#pragma unroll
    for (int db = 0; db < 2; ++db)
#pragma unroll
      for (int g = 0; g < 4; ++g) {
        const size_t off = row * 512 + head * 64 + db * 32 + 8 * g + 4 * hh;
        const half4 z = *(const half4*)(zs + off);
        const f32x16& oo = o[qi][db];
        *(half4*)(yc + row * LDY + head * 64 + db * 32 + 8 * g + 4 * hh) = cvt4(oo[4 * g] * inv * (float)z[0], oo[4 * g + 1] * inv * (float)z[1], oo[4 * g + 2] * inv * (float)z[2], oo[4 * g + 3] * inv * (float)z[3]);
      }
  }
}

DI void phase_attn(const Params& P, int layer, char* smem) {
  const bool last = layer == DEPTH - 1;
  const int n_lat = NBATCH * 2 * 16;
  const int total = n_lat + (last ? 0 : NBATCH * 2 * 2);
  for (int item = blockIdx.x; item < total; item += gridDim.x) {
    if (item < n_lat) attn_task(P, 0, item >> 5, (item >> 4) & 1, item & 15, smem);
    else { const int u = item - n_lat; attn_task(P, 1, u >> 2, (u >> 1) & 1, u & 1, smem); }
  }
  const int tid = otid(), lane = tid & 63, w = tid >> 6;
  const int gw = blockIdx.x * 8 + w, nw = gridDim.x * 8;
  const h16* pa = (const h16*)(P.ws + WS_R1);
  h16* ya = (h16*)(P.ws + WS_R2);
  const int nitems = (last ? T_LAT : T_ALL) / 8;
  const float* cw = P.conv_a + (size_t)layer * 3 * 512 + lane * 8;
  float w0[8], w1[8], w2[8];
#pragma unroll
  for (int e = 0; e < 8; ++e) { w0[e] = cw[e]; w1[e] = cw[512 + e]; w2[e] = cw[1024 + e]; }
  for (int it = gw; it < nitems; it += nw) {
    const int tk0 = it * 8;
    int t0, L;
    if (tk0 < T_LAT) { t0 = tk0 & 2047; L = SEQ; } else { t0 = (tk0 - T_LAT) & 255; L = CTXL; }
    float up[8], uc[8], un[8];
    auto load_u = [&](int dt, float (&dst)[8]) {
      const int t = t0 + dt;
      if (t < 0 || t >= L) {
#pragma unroll
        for (int e = 0; e < 8; ++e) dst[e] = 0.f;
      } else {
        const h16* rp = pa + (size_t)(tk0 + dt) * 2048 + lane * 8;
        const half8 xa = *(const half8*)rp, ca = *(const half8*)(rp + 1024);
#pragma unroll
        for (int e = 0; e < 8; ++e) dst[e] = (float)xa[e] * (float)ca[e];
      }
    };
    load_u(-1, up);
    load_u(0, uc);
#pragma unroll 1
    for (int dt = 0; dt < 8; ++dt) {
      load_u(dt + 1, un);
      const h16* rp = pa + (size_t)(tk0 + dt) * 2048 + lane * 8;
      const half8 ba = *(const half8*)(rp + 512), za = *(const half8*)(rp + 1536);
      half8 o;
#pragma unroll
      for (int e = 0; e < 8; ++e) o[e] = (h16)((float)ba[e] * (w0[e] * up[e] + w1[e] * uc[e] + w2[e] * un[e]) * (float)za[e]);
      *(half8*)(ya + (size_t)(tk0 + dt) * LDY + lane * 8) = o;
#pragma unroll
      for (int e = 0; e < 8; ++e) { up[e] = uc[e]; uc[e] = un[e]; }
    }
  }
}

template <int MB>
DI void merge_tile(const Params& P, int layer, size_t row0, int nt, char* smem) {
  const h16* hb = (const h16*)(P.ws + WS_H16);
  const h16* winT = (const h16*)(P.ws + wbase(layer));
  const h16* wbrT = (const h16*)(P.ws + wbase(layer) + OFF_WBRT);
  h16* mg = (h16*)(P.ws + WS_R1);
  f32x16 macc[MB][2];
  zero_acc<MB>(macc);
#pragma unroll 1
  for (int n = 0; n < 3; ++n) {
    const h16* yn = (const h16*)(P.ws + (n == 0 ? WS_R2 : (n == 1 ? WS_YB : WS_YC)));
    f32x16 pa2[MB][2];
    half8 gpk[MB][2][2];
    zero_acc<MB>(pa2);
    gemm_kloop<MB, true>(pa2, hb + row0 * LDH, LDH, winT + (size_t)(G_OFF + n * 1024 + nt * 256) * LDH, LDH, D, smem);
#pragma unroll
    for (int mb = 0; mb < MB; ++mb)
#pragma unroll
      for (int nb = 0; nb < 2; ++nb)
#pragma unroll
        for (int v = 0; v < 16; ++v) gpk[mb][nb][v >> 3][v & 7] = (h16)sigmoid_f(pa2[mb][nb][v]);
    zero_acc<MB>(pa2);
    gemm_kloop<MB, true>(pa2, yn + row0 * LDY, LDY, wbrT + (size_t)(n * 1024 + nt * 256) * LDY, LDY, WB, smem);
#pragma unroll
    for (int mb = 0; mb < MB; ++mb)
#pragma unroll
      for (int nb = 0; nb < 2; ++nb)
#pragma unroll
        for (int v = 0; v < 16; ++v) macc[mb][nb][v] += (float)gpk[mb][nb][v >> 3][v & 7] * pa2[mb][nb][v];
  }
  const int tid = otid(), lane = tid & 63, w = tid >> 6, wr = w >> 2, wc = w & 3, r32 = lane & 31, hh = lane >> 5;
#pragma unroll
  for (int mb = 0; mb < MB; ++mb) {
    const size_t row = row0 + wr * 32 * MB + mb * 32 + r32;
#pragma unroll
    for (int nb = 0; nb < 2; ++nb)
#pragma unroll
      for (int g = 0; g < 4; ++g)
        *(half4*)(mg + row * LDH + nt * 256 + wc * 64 + nb * 32 + 8 * g + 4 * hh) =
            cvt4(macc[mb][nb][4 * g], macc[mb][nb][4 * g + 1], macc[mb][nb][4 * g + 2], macc[mb][nb][4 * g + 3]);
  }
}
DI void split_rounds(int total, int& nfull, int& nhalf) {
  const int G = gridDim.x;
  nfull = (total / G) * G;
  const int rem = total - nfull;
  if (rem > 0 && 2 * rem <= G) nhalf = 2 * rem; else { nfull = total; nhalf = 0; }
}
DI void phase_merge(const Params& P, int layer, char* smem) {
  const bool last = layer == DEPTH - 1;
  const int total = (last ? T_LAT : T_ALL) / 128 * 4;
  int nfull, nhalf;
  split_rounds(total, nfull, nhalf);
  for_items_xcd(nfull, [&](int item) {
    const int mt = (item >> 5) * 8 + (item & 7), nt = (item & 31) >> 3;
    merge_tile<2>(P, layer, (size_t)mt * 128, nt, smem);
  });
  for_items_xcd(nhalf, [&](int h) {
    const int item = nfull + (h >> 1);
    const int mt = (item >> 5) * 8 + (item & 7), nt = (item & 31) >> 3;
    merge_tile<1>(P, layer, (size_t)mt * 128 + (h & 1) * 64, nt, smem);
  });
}

template <int MB>
DI void out_tile(const Params& P, int layer, int row0, int nt, char* smem) {
  const h16* mg = (const h16*)(P.ws + WS_R1);
  const h16* woutT = (const h16*)(P.ws + wbase(layer) + OFF_WOUTT);
  const float* mods = (const float*)(P.ws + WS_MODS) + (size_t)layer * 17 * 3072;
  float* ctxw = (float*)(P.ws + WS_CTXW);
  f32x16 acc[MB][2];
  zero_acc<MB>(acc);
  gemm_kloop<MB, true>(acc, mg + (size_t)row0 * LDH, LDH, woutT + (size_t)(nt * 256) * LDH, LDH, D, smem);
  const int tid = otid(), lane = tid & 63, w = tid >> 6, wr = w >> 2, wc = w & 3, r32 = lane & 31, hh = lane >> 5;
#pragma unroll
  for (int mb = 0; mb < MB; ++mb) {
    const int row = row0 + wr * 32 * MB + mb * 32 + r32;
    const float* src; float* dst; int b;
    if (row < T_LAT) { b = row >> 11; src = (layer == 0 ? P.x : P.out) + (size_t)row * D; dst = P.out + (size_t)row * D; }
    else { const int rc = row - T_LAT; b = 16; src = (layer == 0 ? P.ctx : ctxw) + (size_t)rc * D; dst = ctxw + (size_t)rc * D; }
    const float* gt = mods + b * 3072 + 2048;
#pragma unroll
    for (int nb = 0; nb < 2; ++nb)
#pragma unroll
      for (int g = 0; g < 4; ++g) {
        const int col = nt * 256 + wc * 64 + nb * 32 + 8 * g + 4 * hh;
        const float4 xo = *(const float4*)(src + col);
        const float4 gv = *(const float4*)(gt + col);
        float4 r;
        r.x = xo.x + gv.x * acc[mb][nb][4 * g]; r.y = xo.y + gv.y * acc[mb][nb][4 * g + 1];
        r.z = xo.z + gv.z * acc[mb][nb][4 * g + 2]; r.w = xo.w + gv.w * acc[mb][nb][4 * g + 3];
        *(float4*)(dst + col) = r;
      }
  }
}
DI void phase_out(const Params& P, int layer, char* smem) {
  const bool last = layer == DEPTH - 1;
  const int total = (last ? T_LAT : T_ALL) / 128 * 4;
  int nfull, nhalf;
  split_rounds(total, nfull, nhalf);
  for_items_xcd(nfull, [&](int item) {
    const int mt = (item >> 5) * 8 + (item & 7), nt = (item & 31) >> 3;
    out_tile<2>(P, layer, mt * 128, nt, smem);
  });
  for_items_xcd(nhalf, [&](int h) {
    const int item = nfull + (h >> 1);
    const int mt = (item >> 5) * 8 + (item & 7), nt = (item & 31) >> 3;
    out_tile<1>(P, layer, mt * 128 + (h & 1) * 64, nt, smem);
  });
}

#define XB_TMO      128
#define XB_XCNT(j)  (256  + 64 * (j))
#define XB_XSUB(j)  (1280 + 64 * (j))
#define XB_XGEN(j)  (2304 + 64 * (j))
#define XB_TOP      3328
#define XB_TOPGEN   3392
#define XCD_BAR_WORDS 3456
#define XB_SPIN_CAP (1u << 20)
#define LAS __attribute__((address_space(3)))
DI unsigned xb_ld(unsigned* p) { return __hip_atomic_load(p, __ATOMIC_RELAXED, __HIP_MEMORY_SCOPE_AGENT); }
DI unsigned xb_add(unsigned* p, unsigned v) { return __hip_atomic_fetch_add(p, v, __ATOMIC_RELAXED, __HIP_MEMORY_SCOPE_AGENT); }
DI unsigned xb_xcc_id() { return (unsigned)__builtin_amdgcn_s_getreg((3 << 11) | 20) & 0xFu; }
#define XB_SPIN(cond, bar) do { unsigned _sp = 0; while (cond) { __builtin_amdgcn_s_sleep(1); \
    if ((++_sp & 255u) == 0u) { if (xb_ld(&(bar)[XB_TMO])) break; if (_sp > XB_SPIN_CAP) { atomicAdd(&(bar)[XB_TMO], 1u); break; } } } } while (0)
struct XcdBarrier { unsigned* bar; unsigned x; volatile LAS unsigned* st; };
DI XcdBarrier xcd_barrier_post(unsigned* bar, volatile LAS unsigned* st) {
  XcdBarrier b; b.bar = bar; b.x = xb_xcc_id(); b.st = st;
  if (threadIdx.x == 0) (void)xb_add(&bar[XB_XCNT(b.x)], 1u);
  return b;
}
DI void xcd_barrier_complete(unsigned* bar, unsigned x, unsigned& nloc, unsigned& nx) {
  const unsigned G = gridDim.x;
  unsigned sum, cnt, mine, sp = 0u;
  for (;;) {
    sum = 0u; cnt = 0u; mine = 0u;
#pragma unroll
    for (unsigned j = 0; j < 16; ++j) { const unsigned c = xb_ld(&bar[XB_XCNT(j)]); sum += c; cnt += (c > 0u) ? 1u : 0u; mine = (j == x) ? c : mine; }
    if (sum == G) break;
    __builtin_amdgcn_s_sleep(1);
    if ((++sp & 255u) == 0u) { if (xb_ld(&bar[XB_TMO])) break; if (sp > XB_SPIN_CAP) { atomicAdd(&bar[XB_TMO], 1u); break; } }
  }
  nloc = mine > 0u ? mine : 1u; nx = cnt > 0u ? cnt : 1u;
}
DI void xcd_barrier(const XcdBarrier& b) {
  asm volatile("s_waitcnt vmcnt(0)" ::: "memory");
  __syncthreads();
  if (threadIdx.x == 0) {
    unsigned* bar = b.bar;
    asm volatile("" : "+s"(bar));
    __builtin_amdgcn_s_waitcnt(0);
    unsigned nloc = b.st[0], nx = b.st[1];
    if (nloc == 0u) { xcd_barrier_complete(bar, b.x, nloc, nx); b.st[0] = nloc; b.st[1] = nx; }
    const unsigned old = xb_add(&bar[XB_XSUB(b.x)], 1u);
    const unsigned gen = old / nloc;
    if (old + 1u == (gen + 1u) * nloc) {
      __builtin_amdgcn_fence(__ATOMIC_RELEASE, "agent");
      asm volatile("s_waitcnt vmcnt(0)" ::: "memory");
      const unsigned og = xb_add(&bar[XB_TOP], 1u);
      const unsigned tg = og / nx;
      if (og + 1u == (tg + 1u) * nx) xb_add(&bar[XB_TOPGEN], 1u);
      else XB_SPIN(xb_ld(&bar[XB_TOPGEN]) == tg, bar);
      __builtin_amdgcn_fence(__ATOMIC_ACQUIRE, "agent");
      xb_add(&bar[XB_XGEN(b.x)], 1u);
      asm volatile("s_waitcnt vmcnt(0)" ::: "memory");
    } else {
      XB_SPIN(xb_ld(&bar[XB_XGEN(b.x)]) == gen, bar);
      __builtin_amdgcn_fence(__ATOMIC_ACQUIRE, "agent");
      asm volatile("s_waitcnt vmcnt(0)" ::: "memory");
    }
  }
  __syncthreads();
}

__global__ void __launch_bounds__(512) mega_kernel(Params P) {
  extern __shared__ __attribute__((aligned(16))) char smem[];
  volatile LAS unsigned* xst = (volatile LAS unsigned*)(smem + LDS_BYTES);
  if (threadIdx.x == 0) { xst[0] = 0u; xst[1] = 0u; }
  __syncthreads();
  const XcdBarrier xb = xcd_barrier_post((unsigned*)(P.ws + WS_BAR), xst);
  for (int ph = P.ph_lo; ph < P.ph_hi; ++ph) {
    if (ph == 0) phase_prep(P, smem);
    else {
      const int layer = (ph - 1) / NPH_LAYER, k = (ph - 1) % NPH_LAYER;
#ifndef PROBE_REP
#define PROBE_REP -1
#endif
      const int nrep = (k == PROBE_REP) ? 2 : 1;
      for (int rep = 0; rep < nrep; ++rep) {
      switch (k) {
        case 0: { int lo = layer; asm volatile("" : "+s"(lo)); phase_norm(P, lo, smem); } break;
        case 1: { int lo = layer; asm volatile("" : "+s"(lo)); phase_gemm_h(P, lo, smem); } break;
        case 2: { int lo = layer; asm volatile("" : "+s"(lo)); phase_shortconv(P, lo, smem); } break;
        case 3: { int lo = layer; asm volatile("" : "+s"(lo)); phase_toeplitz<0>(P, lo, smem); } break;
        case 4: { int lo = layer; asm volatile("" : "+s"(lo)); phase_toeplitz<1>(P, lo, smem); } break;
        case 5: { int lo = layer; asm volatile("" : "+s"(lo)); phase_gemm_aq(P, lo, smem); } break;
        case 6: { int lo = layer; asm volatile("" : "+s"(lo)); phase_attn(P, lo, smem); } break;
        case 7: { int lo = layer; asm volatile("" : "+s"(lo)); phase_merge(P, lo, smem); } break;
        default: { int lo = layer; asm volatile("" : "+s"(lo)); phase_out(P, lo, smem); } break;
      }
      if (rep + 1 < nrep) cg::this_grid().sync();
      }
    }
    if (ph + 1 < P.ph_hi) {
      if (ph == P.ph_lo) cg::this_grid().sync();
      else xcd_barrier(xb);
    }
  }
}

extern "C" void kernel_launch(void* const* d_in, const int* in_sizes, int n_in, void* d_out, int out_size, void* d_ws, size_t ws_size,
                              hipStream_t stream) {
  static int grid = 0;
  if (grid == 0) {
    int dev = 0, cus = 0, per_cu = 0;
    hipGetDevice(&dev);
    hipDeviceGetAttribute(&cus, hipDeviceAttributeMultiprocessorCount, dev);
    if (hipFuncSetAttribute((const void*)mega_kernel, hipFuncAttributeMaxDynamicSharedMemorySize, LDS_BYTES + 16) != hipSuccess) {
      fprintf(stderr, "hipFuncSetAttribute failed\n");
      grid = -1;
      return;
    }
    hipOccupancyMaxActiveBlocksPerMultiprocessor(&per_cu, (const void*)mega_kernel, 512, LDS_BYTES + 16);
    if (per_cu < 1) per_cu = 1;
    grid = cus * per_cu;
    if (ws_size < WS_END || n_in != 22) { fprintf(stderr, "workspace too small: %zu < %zu\n", ws_size, (size_t)WS_END); grid = -1; }
  }
  if (grid < 0) return;
  Params p{};
  const float** f = (const float**)&p;
  for (int i = 0; i < 22; ++i) f[i] = (const float*)d_in[i];
  p.out = (float*)d_out;
  p.ws = (char*)d_ws;
#if PER_PHASE_LAUNCH
  for (int ph = 0; ph < NPHASES; ++ph) {
    p.ph_lo = ph; p.ph_hi = ph + 1;
    hipLaunchKernelGGL(mega_kernel, dim3(grid), dim3(512), LDS_BYTES + 16, stream, p);
  }
#else
  p.ph_lo = 0; p.ph_hi = NPHASES;
  if (hipMemsetAsync((char*)d_ws + WS_BAR, 0, XCD_BAR_WORDS * 4, stream) != hipSuccess) { fprintf(stderr, "memset of barrier word failed\n"); return; }
  void* args[] = {&p};
  hipError_t e = hipLaunchCooperativeKernel((const void*)mega_kernel, dim3(grid), dim3(512), args, LDS_BYTES + 16, stream);
  if (e != hipSuccess) fprintf(stderr, "cooperative launch failed: %s (grid %d)\n", hipGetErrorString(e), grid);
#endif
}
```
